# Optimizing an MI355X kernel written in HIP

```python
import math
import jax
import jax.numpy as jnp
from jax import lax
import numpy as np

D_MODEL = 1024
BATCH = 16
SEQ = 4096
DEPTH = 1

CHUNK = 64
GLA_HEADS = 4
GLA_DK = 64
GLA_DV = 128
GLA_GATE_RANK = 16
GLA_TAU = 16.0
ATT_HEADS = 8
ATT_DH = 64
IDX_HEADS = 8
IDX_DH = 32
TOPK_MAX = 256
Q_BLOCK = CHUNK
REL_BUCKETS = 32
REL_MAX_DIST = 128
N_GROUPS = 4
EXPERTS_PER_GROUP = 8
N_EXPERTS = N_GROUPS * EXPERTS_PER_GROUP
EXPERT_TOPK = 2
D_EXPERT = 128
EPS = 1e-6

GLA_QK_W = GLA_HEADS * GLA_DK
GLA_V_W = GLA_HEADS * GLA_DV
ATT_W = ATT_HEADS * ATT_DH
IDX_Q_W = IDX_HEADS * IDX_DH
SPLITS = (GLA_QK_W, GLA_QK_W, GLA_V_W, GLA_V_W, GLA_GATE_RANK, ATT_W, ATT_W, ATT_W, IDX_Q_W, IDX_DH, IDX_HEADS, D_MODEL, D_MODEL)
D_IN = 2 * GLA_QK_W + 2 * GLA_V_W + GLA_GATE_RANK + 3 * ATT_W + IDX_Q_W + IDX_DH + IDX_HEADS + 2 * D_MODEL

kernel_name = 'hybrid_gla_dsa_hmoe_block'


def rms_norm(x, g):
    xf = x.astype(jnp.float32)
    y = xf * lax.rsqrt(jnp.mean(xf * xf, axis=-1, keepdims=True) + EPS)
    return (y * g.astype(jnp.float32)).astype(x.dtype)


def gla_mixer(q, k, v, r, a_lr, w_alpha2, b_alpha, g_out):
    b, t, _ = q.shape
    nc = t // CHUNK
    f32 = jnp.float32
    q = q.reshape(b, nc, CHUNK, GLA_HEADS, GLA_DK).astype(f32) * (GLA_DK ** -0.5)
    k = k.reshape(b, nc, CHUNK, GLA_HEADS, GLA_DK)
    v = v.reshape(b, nc, CHUNK, GLA_HEADS, GLA_DV)
    log_a = jax.nn.log_sigmoid((a_lr @ w_alpha2 + b_alpha).astype(f32)) / GLA_TAU
    log_a = log_a.reshape(b, nc, CHUNK, GLA_HEADS, GLA_DK)
    cum = jnp.cumsum(log_a, axis=2)
    total = cum[:, :, -1]
    k_dec = (k.astype(f32) * jnp.exp(total[:, :, None] - cum)).astype(k.dtype)
    u = jnp.einsum('bnchd,bnche->nbhde', k_dec, v).astype(f32)

    def step(s, inp):
        dec, u_c = inp
        s = s * dec[..., None] + u_c
        return s, s

    s0 = jnp.zeros((b, GLA_HEADS, GLA_DK, GLA_DV), f32)
    _, states = lax.scan(step, s0, (jnp.exp(total).transpose(1, 0, 2, 3), u))
    o = jnp.einsum('bnchd,nbhde->bnche', q, states)
    o = rms_norm(o, g_out)
    o = o.reshape(b, t, GLA_V_W) * jax.nn.silu(r.astype(f32))
    return o.astype(r.dtype)


def t5_bucket(rel):
    half = REL_BUCKETS // 2
    exact = half // 2
    n = jnp.abs(rel)
    nf = jnp.maximum(n, 1).astype(jnp.float32)
    large = exact + (jnp.log(nf / exact) / math.log(REL_MAX_DIST / exact) * (half - exact)).astype(jnp.int32)
    large = jnp.minimum(large, half - 1)
    return jnp.where(rel > 0, half, 0) + jnp.where(n < exact, n, large)


def dsa_mixer(q, k, v, q_idx, k_idx, w_idx, rel_bias):
    b, t = q.shape[:2]
    k_top = min(TOPK_MAX, t // 4)
    nb = t // Q_BLOCK
    key_pos = jnp.arange(t)
    k_idx_f = k_idx.astype(jnp.float32)

    def to_blocks(a):
        return a.reshape(b, nb, Q_BLOCK, *a.shape[2:]).swapaxes(0, 1)

    def block(args):
        qb, qib, wb, i = args
        s = jnp.einsum('bqhd,bsd->bqhs', qib.astype(jnp.float32), k_idx_f)
        score = jnp.einsum('bqhs,bqh->bqs', jax.nn.relu(s), wb.astype(jnp.float32))
        admissible = key_pos < (i + 1) * Q_BLOCK
        score = jnp.where(admissible[None, None, :], score, -jnp.inf)
        top_val, top_idx = lax.top_k(score, k_top)
        valid = jnp.isfinite(top_val)
        k_sel = jax.vmap(lambda kk, ii: kk[ii])(k, top_idx)
        v_sel = jax.vmap(lambda vv, ii: vv[ii])(v, top_idx)
        logits = jnp.einsum('bqhd,bqkhd->bqhk', qb, k_sel).astype(jnp.float32) * (ATT_DH ** -0.5)
        q_pos = i * Q_BLOCK + jnp.arange(Q_BLOCK)
        bias = rel_bias[t5_bucket(top_idx - q_pos[None, :, None])]
        logits = logits + bias.astype(jnp.float32).transpose(0, 1, 3, 2)
        logits = jnp.where(valid[:, :, None, :], logits, -jnp.inf)
        p = jax.nn.softmax(logits, axis=-1)
        return jnp.einsum('bqhk,bqkhd->bqhd', p.astype(v.dtype), v_sel)

    out = lax.map(block, (to_blocks(q), to_blocks(q_idx), to_blocks(w_idx), jnp.arange(nb)))
    return out.swapaxes(0, 1).reshape(b, t, ATT_W)


def hier_moe(h, w_rg, b_rg, w_re, b_re, w_gate, w_up, w_down):
    b, t, d = h.shape
    f32 = jnp.float32
    xf = h.reshape(b * t, d)
    g_logits = (xf @ w_rg + b_rg).astype(f32)
    g_sel = jnp.argmax(g_logits, axis=-1)
    g_w = jnp.take_along_axis(jax.nn.softmax(g_logits, axis=-1), g_sel[:, None], axis=-1)
    e_logits = (xf @ w_re + b_re).astype(f32).reshape(-1, N_GROUPS, EXPERTS_PER_GROUP)
    e_in_group = jnp.take_along_axis(e_logits, g_sel[:, None, None], axis=1)[:, 0]
    top_v, top_i = lax.top_k(e_in_group, EXPERT_TOPK)
    top_w = jax.nn.softmax(top_v, axis=-1) * g_w
    within = jnp.sum(jax.nn.one_hot(top_i, EXPERTS_PER_GROUP, dtype=f32) * top_w[..., None], axis=1)
    combine = (jax.nn.one_hot(g_sel, N_GROUPS, dtype=f32)[:, :, None] * within[:, None, :]).reshape(-1, N_EXPERTS)
    y = jnp.zeros((b * t, d), f32)
    for e in range(N_EXPERTS):
        hid = jax.nn.silu(xf @ w_gate[e]) * (xf @ w_up[e])
        y = y + combine[:, e:e + 1] * (hid @ w_down[e]).astype(f32)
    return y.astype(h.dtype).reshape(b, t, d)


def setup_inputs(seed: int = 0) -> dict:
    key = jax.random.key(seed)
    ks = jax.random.split(key, 20)
    f32 = jnp.float32

    def nrm(k, shape, scale):
        return jax.random.normal(k, shape, f32) * scale

    def gain(k, shape):
        return 1.0 + 0.02 * jax.random.normal(k, shape, f32)

    L = DEPTH
    return {
        'x': nrm(ks[0], (BATCH, SEQ, D_MODEL), 1.0),
        'g_mix': gain(ks[1], (L, D_MODEL)),
        'w_in': nrm(ks[2], (L, D_MODEL, D_IN), D_MODEL ** -0.5),
        'w_alpha2': nrm(ks[3], (L, GLA_GATE_RANK, GLA_QK_W), GLA_GATE_RANK ** -0.5),
        'b_alpha': nrm(ks[4], (L, GLA_QK_W), 0.1),
        'g_gla': gain(ks[5], (L, GLA_DV)),
        'w_br_gla': nrm(ks[6], (L, GLA_V_W, D_MODEL), GLA_V_W ** -0.5),
        'g_q': gain(ks[7], (L, ATT_DH)),
        'g_k': gain(ks[8], (L, ATT_DH)),
        'rel_bias': nrm(ks[9], (REL_BUCKETS, ATT_HEADS), 0.3),
        'w_br_att': nrm(ks[10], (L, ATT_W, D_MODEL), ATT_W ** -0.5),
        'w_out': nrm(ks[11], (L, D_MODEL, D_MODEL), D_MODEL ** -0.5),
        'g_ffn': gain(ks[12], (L, D_MODEL)),
        'w_rg': nrm(ks[13], (L, D_MODEL, N_GROUPS), D_MODEL ** -0.5),
        'b_rg': nrm(ks[14], (L, N_GROUPS), 0.01),
        'w_re': nrm(ks[15], (L, D_MODEL, N_EXPERTS), D_MODEL ** -0.5),
        'b_re': nrm(ks[16], (L, N_EXPERTS), 0.01),
        'w_gate': nrm(ks[17], (L, N_EXPERTS, D_MODEL, D_EXPERT), D_MODEL ** -0.5),
        'w_up': nrm(ks[18], (L, N_EXPERTS, D_MODEL, D_EXPERT), D_MODEL ** -0.5),
        'w_down': nrm(ks[19], (L, N_EXPERTS, D_EXPERT, D_MODEL), D_EXPERT ** -0.5),
    }


def reference(x, g_mix, w_in, w_alpha2, b_alpha, g_gla, w_br_gla, g_q, g_k, rel_bias, w_br_att, w_out, g_ffn, w_rg, b_rg, w_re, b_re, w_gate, w_up, w_down):
    b, t, _ = x.shape
    split_points = [int(p) for p in np.cumsum(SPLITS)[:-1]]
    for l in range(DEPTH):
        hn = rms_norm(x, g_mix[l])
        proj = hn @ w_in[l]
        (qa, ka, va, ra, alr, qb, kb, vb, qi, ki, wi, gate_a, gate_b) = jnp.split(proj, split_points, axis=-1)
        ya = gla_mixer(qa, ka, va, ra, alr, w_alpha2[l], b_alpha[l], g_gla[l]) @ w_br_gla[l]
        qb = rms_norm(qb.reshape(b, t, ATT_HEADS, ATT_DH), g_q[l])
        kb = rms_norm(kb.reshape(b, t, ATT_HEADS, ATT_DH), g_k[l])
        vb = vb.reshape(b, t, ATT_HEADS, ATT_DH)
        qi = qi.reshape(b, t, IDX_HEADS, IDX_DH)
        wi = wi * (IDX_HEADS ** -0.5 * IDX_DH ** -0.5)
        yb = dsa_mixer(qb, kb, vb, qi, ki, wi, rel_bias) @ w_br_att[l]
        mixed = jax.nn.sigmoid(gate_a) * ya + jax.nn.sigmoid(gate_b) * yb
        x = x + mixed @ w_out[l]
        x = x + hier_moe(rms_norm(x, g_ffn[l]), w_rg[l], b_rg[l], w_re[l], b_re[l], w_gate[l], w_up[l], w_down[l])
    return x
```

```cpp
#include <hip/hip_runtime.h>
#include <cstdio>
#include <cstdint>
#include <cmath>
#define MK_SPLIT 0
namespace pg8 {
#define PG8_LAS __attribute__((address_space(3)))
typedef unsigned short bf16_t;
typedef short bf16x8 __attribute__((ext_vector_type(8)));
typedef float f32x4 __attribute__((ext_vector_type(4)));
typedef unsigned u32x4 __attribute__((ext_vector_type(4)));
typedef int i32x4 __attribute__((ext_vector_type(4)));
constexpr int BM = 256, BK = 64, HALF = 128, HTB = HALF * BK * 2  , STAGE_BYTES = 8 * HTB, NXCD = 8, WGM = 8;

__host__ __device__ __forceinline__ int lds_byte(int r, int c) { const int st = (r >> 4) * 2 + (c >> 5), rr = r & 15, cc = c & 31, ob = rr * 64 + cc * 2; return st * 1024 + (ob ^ (((ob >> 9) & 1) << 5)); }
__host__ __device__ __forceinline__ void stage_rc(int b, int& R, int& C) { const int st = b / 1024, sb = b % 1024, swz = sb ^ (((sb >> 9) & 1) << 5); R = (st >> 1) * 16 + swz / 64; C = (st & 1) * 32 + (swz % 64) / 2; }
__host__ __device__ __forceinline__ int perm32(int rho) { const int n = rho >> 4, i = rho & 15; return 8 * (i >> 2) + 4 * n + (i & 3); }

struct Unit { int pm, pn, sel; };
struct Gemm { const bf16_t* A; const bf16_t* Bt; int lda, ldb, K; int nomma = 0; };

__host__ __device__ __forceinline__ void tile_of(int wgid, int nM, int nN, int& pm, int& pn) {
    const int nwg = nM * nN;
    { const int q = nwg / NXCD, r = nwg % NXCD, xcd = wgid % NXCD, off = wgid / NXCD; wgid = (xcd < r ? xcd * (q + 1) : r * (q + 1) + (xcd - r) * q) + off; }
    const int nig = WGM * nN, gid = wgid / nig, fm = gid * WGM, gsz = (nM - fm) < WGM ? (nM - fm) : WGM;
    pm = fm + ((wgid % nig) % gsz); pn = (wgid % nig) / gsz;
}
struct StaticOrder {
    static constexpr bool GATHER = false, SPLITB = false;
    int nM, nN, nwg, G, c;
    __host__ __device__ void init(int M, int N, int G_, int c_) { nM = M / BM; nN = N / BM; nwg = nM * nN; G = G_; c = c_; }
    __host__ __device__ bool next(int i, Unit& u) const {
        const long L = (long)i * G + c; if (L >= nwg) return false;
        tile_of((int)L, nM, nN, u.pm, u.pn); u.sel = 0; return true;
    }
    __device__ __forceinline__ const char* baseA(const Gemm& g, const Unit& u) const { return (const char*)g.A + (size_t)u.pm * BM * g.lda * 2; }
    __device__ __forceinline__ const char* baseB(const Gemm& g, const Unit& u) const { return (const char*)g.Bt + (size_t)u.pn * BM * g.ldb * 2; }
};

typedef float f32x2_t __attribute__((ext_vector_type(2))); typedef __bf16 bf16x2_t __attribute__((ext_vector_type(2)));
__device__ __forceinline__ unsigned cvt_pk_bf16(float lo, float hi) { const f32x2_t v = {lo, hi}; const bf16x2_t b = __builtin_convertvector(v, bf16x2_t); return __builtin_bit_cast(unsigned, b); }

template <class Epi, class Sched, bool I8 = false>
__device__ __forceinline__ void gemm_phase(PG8_LAS unsigned char* lds, const Gemm g, const Sched& S, const Epi& E) {
    const int tid = threadIdx.x, wid = __builtin_amdgcn_readfirstlane(tid >> 6), lane = tid & 63, wr = wid >> 2, wc = wid & 3, fr = lane & 15, fq = lane >> 4;
    const int K = g.K, nt = K / BK;
    unsigned voffA[2][2], voffN[2][2], voffB[2]; int RA_[2], CA_[2];
#pragma unroll
    for (int i = 0; i < 2; ++i) { int R, C; stage_rc(tid * 16 + i * 8192, R, C); const int Rb = Epi::PERM ? ((R & ~31) + perm32(R & 31)) : R; RA_[i] = R; CA_[i] = C;
        voffB[i] = (unsigned)(Rb * g.ldb + C) * 2u;
#pragma unroll
        for (int h = 0; h < 2; ++h) { voffA[h][i] = (unsigned)((R + h * HALF) * g.lda + C) * 2u; voffN[h][i] = voffA[h][i]; } }
    const size_t kstep = (size_t)(BK * 2);
    const size_t hstepB = (size_t)HALF * g.ldb * 2;
    const unsigned ldsw = (unsigned)wid * 1024u;
    const int aoff = lds_byte(wr * 64 + fr, fq * 8), boff = lds_byte(wc * 32 + fr, fq * 8);
#define PG8_SA(b, h) (((b) * 2 + (h)) * HTB)
#define PG8_SB(b, h) ((4 + (b) * 2 + (h)) * HTB)
#define PG8_STAGE(bufoff, gbase, voff) do { _Pragma("unroll") for (int _i = 0; _i < 2; ++_i) \
        __builtin_amdgcn_global_load_lds((const unsigned*)((const char*)(gbase) + (voff)[_i]), (PG8_LAS unsigned*)(lds + (bufoff) + ldsw + _i * 8192), 16, 0, 0); } while (0)
#define PG8_LDA(dst, b, h) do { _Pragma("unroll") for (int m = 0; m < 4; ++m) _Pragma("unroll") for (int k = 0; k < 2; ++k) dst[m][k] = *(const PG8_LAS bf16x8*)(lds + PG8_SA(b, h) + aoff + m * 2048 + k * 1024); } while (0)
#define PG8_LDB(dst, b, h) do { _Pragma("unroll") for (int n = 0; n < 2; ++n) _Pragma("unroll") for (int k = 0; k < 2; ++k) dst[n][k] = *(const PG8_LAS bf16x8*)(lds + PG8_SB(b, h) + boff + n * 2048 + k * 1024); } while (0)
#ifdef PROBE_NOMMA
#define PG8_MMA_GUARD if (!g.nomma)
#else
#define PG8_MMA_GUARD
#endif
#define PG8_MMA(ai, bj, At, Bt) PG8_MMA_GUARD do { __builtin_amdgcn_s_setprio(1); _Pragma("unroll") for (int m = 0; m < 4; ++m) _Pragma("unroll") for (int n = 0; n < 2; ++n) _Pragma("unroll") for (int k = 0; k < 2; ++k) { \
        if constexpr (I8) acc[ai][bj][m][n] = __builtin_bit_cast(f32x4, __builtin_amdgcn_mfma_i32_16x16x64_i8(__builtin_bit_cast(i32x4, Bt[n][k]), __builtin_bit_cast(i32x4, At[m][k]), __builtin_bit_cast(i32x4, acc[ai][bj][m][n]), 0, 0, 0)); \
        else acc[ai][bj][m][n] = __builtin_amdgcn_mfma_f32_16x16x32_bf16(Bt[n][k], At[m][k], acc[ai][bj][m][n], 0, 0, 0); } __builtin_amdgcn_s_setprio(0); } while (0)
#define PG8_WAIT_V(n) asm volatile("s_waitcnt vmcnt(" #n ")" ::: "memory")
#define PG8_WAIT_L(n) asm volatile("s_waitcnt lgkmcnt(" #n ")" ::: "memory")
#define PG8_WAIT_VE() PG8_WAIT_V(8)
#define PG8_BAR __builtin_amdgcn_s_barrier()
#define PG8_SCHED __builtin_amdgcn_sched_barrier(0)
#define PG8_GATHER(dst, u) do { if constexpr (Sched::GATHER) { _Pragma("unroll") for (int _h = 0; _h < 2; ++_h) _Pragma("unroll") for (int _i = 0; _i < 2; ++_i) \
        dst[_h][_i] = (unsigned)S.row(u, _h * HALF + RA_[_i]) * (unsigned)(g.lda * 2) + (unsigned)(CA_[_i] * 2); } } while (0)
    Unit cur, nxt, nn; int ui = 0, en = 0;
    if (!S.next(0, cur)) return;
    bool has_next = S.next(1, nxt);
    f32x4 acc[2][2][4][2];
#pragma unroll
    for (int a = 0; a < 2; ++a)
#pragma unroll
        for (int b = 0; b < 2; ++b)
#pragma unroll
            for (int m = 0; m < 4; ++m)
#pragma unroll
                for (int n = 0; n < 2; ++n) acc[a][b][m][n] = (f32x4){0.f, 0.f, 0.f, 0.f};
    bf16x8 At[4][2], B0[2][2], B1[2][2];
    const char* cA = S.baseA(g, cur); const char* cB = S.baseB(g, cur);
    PG8_GATHER(voffA, cur);
    if constexpr (Sched::GATHER) { if (has_next) { PG8_GATHER(voffN, nxt); } else {
#pragma unroll
        for (int h = 0; h < 2; ++h)
#pragma unroll
            for (int i = 0; i < 2; ++i) voffN[h][i] = voffA[h][i]; } }
    PG8_STAGE(PG8_SB(0, 0), cB, voffB); PG8_STAGE(PG8_SB(0, 1), cB + hstepB, voffB); PG8_STAGE(PG8_SA(0, 0), cA, voffA[0]); PG8_STAGE(PG8_SA(0, 1), cA, voffA[1]);
    if (wr == 1) PG8_BAR;
    PG8_WAIT_V(2); PG8_BAR;
    PG8_STAGE(PG8_SB(1, 0), cB + kstep, voffB); PG8_STAGE(PG8_SA(1, 0), cA + kstep, voffA[0]); PG8_STAGE(PG8_SB(1, 1), cB + hstepB + kstep, voffB);
    PG8_WAIT_V(6); PG8_BAR;
    for (;;) {
        const char* nA = has_next ? S.baseA(g, nxt) : cA; const char* nB = has_next ? S.baseB(g, nxt) : cB;
        const char* cB2 = cB; if constexpr (Sched::SPLITB) cB2 = S.baseB2(g, cur);
        for (int t = 0; t < nt; t += 2) {
            const bool last = (t == nt - 2);
            const char* a1 = cA + (size_t)(t + 1) * kstep;
            const char* a2 = last ? nA : cA + (size_t)(t + 2) * kstep;
            const char* b2 = last ? nB : (Sched::SPLITB ? cB2 + (size_t)t * kstep : cB + (size_t)(t + 2) * kstep);
            const char* a3 = a2 + kstep; const char* b3 = b2 + kstep;
            unsigned v2[2][2];
#pragma unroll
            for (int h = 0; h < 2; ++h)
#pragma unroll
                for (int i = 0; i < 2; ++i) v2[h][i] = (Sched::GATHER && last) ? voffN[h][i] : voffA[h][i];
            PG8_LDB(B0, 0, 0); PG8_LDB(B1, 0, 1); PG8_SCHED; PG8_LDA(At, 0, 0); PG8_STAGE(PG8_SA(1, 1), a1, voffA[1]);
            PG8_WAIT_VE(); PG8_WAIT_L(0); PG8_BAR; PG8_MMA(0, 0, At, B0); PG8_MMA(0, 1, At, B1); PG8_BAR; PG8_SCHED;
            PG8_LDA(At, 0, 1); PG8_STAGE(PG8_SB(0, 0), b2, voffB); PG8_STAGE(PG8_SB(0, 1), b2 + hstepB, voffB); PG8_STAGE(PG8_SA(0, 0), a2, v2[0]);
            PG8_WAIT_VE(); PG8_WAIT_L(0); PG8_BAR; PG8_MMA(1, 0, At, B0); PG8_MMA(1, 1, At, B1); PG8_BAR; PG8_SCHED;
            PG8_LDB(B0, 1, 0); PG8_LDB(B1, 1, 1); PG8_SCHED; PG8_LDA(At, 1, 0); PG8_STAGE(PG8_SA(0, 1), a2, v2[1]);
            PG8_WAIT_V(8); PG8_WAIT_L(0); PG8_BAR; PG8_MMA(0, 0, At, B0); PG8_MMA(0, 1, At, B1); PG8_BAR; PG8_SCHED;
            PG8_LDA(At, 1, 1); PG8_STAGE(PG8_SB(1, 0), b3, voffB); PG8_STAGE(PG8_SB(1, 1), b3 + hstepB, voffB); PG8_STAGE(PG8_SA(1, 0), a3, v2[0]);
            PG8_WAIT_V(8); PG8_WAIT_L(0); PG8_BAR; PG8_MMA(1, 0, At, B0); PG8_MMA(1, 1, At, B1); PG8_BAR; PG8_SCHED;
        }
        const bool has_nn = has_next && S.next(ui + 2, nn);
        int trow[2][2];
        if constexpr (Sched::GATHER) { if (has_nn) {
#pragma unroll
            for (int h = 0; h < 2; ++h)
#pragma unroll
                for (int i = 0; i < 2; ++i) trow[h][i] = S.row(nn, h * HALF + RA_[i]); } }
        if (wr == 0) PG8_BAR;
        en = __builtin_amdgcn_readfirstlane(E(acc, cur, wr, wc, fr, fq));
        if (!has_next) break;
#pragma unroll
        for (int a = 0; a < 2; ++a)
#pragma unroll
            for (int b = 0; b < 2; ++b)
#pragma unroll
                for (int m = 0; m < 4; ++m)
#pragma unroll
                    for (int n = 0; n < 2; ++n) acc[a][b][m][n] = (f32x4){0.f, 0.f, 0.f, 0.f};
        cur = nxt; cA = nA; cB = nB; ++ui; nxt = nn; has_next = has_nn;
        if constexpr (Sched::GATHER) {
#pragma unroll
            for (int h = 0; h < 2; ++h)
#pragma unroll
                for (int i = 0; i < 2; ++i) { voffA[h][i] = voffN[h][i]; if (has_nn) voffN[h][i] = (unsigned)trow[h][i] * (unsigned)(g.lda * 2) + (unsigned)(CA_[i] * 2); } }
        if (wr == 1) PG8_BAR;
    }
    PG8_WAIT_V(0);
    PG8_BAR;
#undef PG8_SA
#undef PG8_SB
#undef PG8_STAGE
#undef PG8_LDA
#undef PG8_LDB
#undef PG8_MMA
#undef PG8_WAIT_V
#undef PG8_WAIT_L
#undef PG8_WAIT_VE
#undef PG8_BAR
#undef PG8_SCHED
#undef PG8_GATHER
}
}
constexpr int NWAVES = 8;
constexpr int BATCH = 16, SEQ = 4096, D = 1024, M = BATCH * SEQ;
constexpr int CH = 64, NCH = SEQ / CH, NCHUNK = M / CH;
constexpr int NP = 5632;
constexpr float EPS = 1e-6f;
constexpr float LOG2E = 1.4426950408889634f;
constexpr int L_QA = 0, L_KA = 256, L_VA = 512, L_RA = 1024, L_ALR = 1536, L_QB = 1552, L_KB = 2064, L_VB = 2576, L_QI = 3088, L_KI = 3344, L_WI = 3376, L_GA = 3384, L_GB = 4408, D_IN = 5432;
constexpr int NEXP = 32, DEXP = 128, NCLASS = 112;

constexpr size_t MiB = 1u << 20;
constexpr size_t WS_CTL = 0, CTL_ZERO_BYTES = 1 * MiB;
constexpr size_t WS_WIN = 2 * MiB;
constexpr size_t WS_WA = 13 * MiB;
constexpr size_t WS_WB = 14 * MiB;
constexpr size_t WS_WO = 15 * MiB;
constexpr size_t WS_WGU = 17 * MiB;
constexpr size_t WS_WD = 33 * MiB;
constexpr size_t WS_META = 41 * MiB;
constexpr size_t WS_WR = 43 * MiB;
constexpr size_t WS_MRS = 44 * MiB;
constexpr size_t WS_TOK = 42 * MiB;
constexpr size_t WS_R0 = 48 * MiB;
constexpr size_t WS_HN = WS_R0, WS_KDT = WS_R0, WS_MASK = WS_R0 + 32 * MiB, WS_MIXED = WS_R0;
constexpr size_t WS_QA = 176 * MiB, WS_KA = 208 * MiB, WS_VA = 240 * MiB, WS_RA = 304 * MiB, WS_QB = 368 * MiB, WS_KB = 432 * MiB, WS_VB = 496 * MiB, WS_QI = 560 * MiB;
constexpr size_t WS_KI = 592 * MiB, WS_WI = 596 * MiB, WS_ALR = 598 * MiB, WS_DEC = 602 * MiB;
constexpr size_t WS_GA = 608 * MiB, WS_GB = 736 * MiB, WS_OCAT = 864 * MiB, WS_END = 992 * MiB;
constexpr size_t WS_HN8 = 672 * MiB;
constexpr size_t WS_WIN8 = 800 * MiB;
constexpr size_t WS_RS8 = 808 * MiB, WS_CS8 = 809 * MiB;
constexpr size_t WS_WGU8 = 812 * MiB, WS_CSU = 820 * MiB;
constexpr size_t WS_XB8 = WS_R0, WS_XS8 = WS_R0 + 64 * MiB;
constexpr size_t WS_WO8 = 821 * MiB, WS_CSO = 822 * MiB;
constexpr size_t WS_MIX8 = 368 * MiB, WS_MS8 = 432 * MiB;
constexpr size_t WS_SLOT1 = 824 * MiB, WS_SLOT2 = 826 * MiB;
constexpr size_t WS_H2 = 176 * MiB;
constexpr size_t WS_HID = 304 * MiB;
constexpr int CW_TMO = 0, CW_CODE = 1;
constexpr int CW_BAR = 4096;
constexpr int CW_XRANK = 9216;
constexpr int CW_ATTQ = 8448;
constexpr int CW_CMAX = 16384;
constexpr int CW_ROWMAX2 = 131072;
constexpr int CW_PCNT = 196608;
constexpr int CW_ROWMAX = 65536;
constexpr int CW_CLS = 8192;

constexpr int RING_OFF = 0, RING_BYTES = 131072;
constexpr int LDSCTL_OFF = RING_BYTES, MISC_OFF = LDSCTL_OFF + 320;
constexpr int XTRA_OFF = RING_BYTES + 1024;
constexpr int LDS_BYTES = 147456;

#define GAS __attribute__((address_space(1)))
#define LAS __attribute__((address_space(3)))
typedef unsigned short bf16;
typedef unsigned v4u __attribute__((ext_vector_type(4)));
typedef unsigned v2u __attribute__((ext_vector_type(2)));
typedef float f32x4 __attribute__((ext_vector_type(4)));
typedef float f32x16 __attribute__((ext_vector_type(16)));
typedef short bf16x8 __attribute__((ext_vector_type(8)));
typedef GAS unsigned gu32;
#define RLX_AGENT __ATOMIC_RELAXED, __HIP_MEMORY_SCOPE_AGENT
#define LDS_WAIT() asm volatile("s_waitcnt lgkmcnt(0)" ::: "memory")
#define VM_WAIT() asm volatile("s_waitcnt vmcnt(0)" ::: "memory")
__device__ __forceinline__ unsigned f2bf(float f) { unsigned u = __builtin_bit_cast(unsigned, f); return (u + 0x7fffu + ((u >> 16) & 1u)) >> 16; }
__device__ __forceinline__ unsigned pk2(float lo, float hi) { return f2bf(lo) | (f2bf(hi) << 16); }
__device__ __forceinline__ float bf2f(unsigned short b) { return __builtin_bit_cast(float, ((unsigned)b) << 16); }
__device__ __forceinline__ float bflo(unsigned w) { return __builtin_bit_cast(float, w << 16); }
__device__ __forceinline__ float bfhi(unsigned w) { return __builtin_bit_cast(float, w & 0xffff0000u); }
__device__ __forceinline__ float fast_exp2(float x) { return __builtin_amdgcn_exp2f(x); }
__device__ __forceinline__ float sigmoidf_(float x) { return __builtin_amdgcn_rcpf(1.0f + __builtin_amdgcn_exp2f(-x * LOG2E)); }
__device__ __forceinline__ float siluf_(float x) { return x * sigmoidf_(x); }

#define XB_TMO      128
#define XB_XCNT(j)  (256  + 64 * (j))
#define XB_XSUB(j)  (1280 + 64 * (j))
#define XB_XGEN(j)  (2304 + 64 * (j))
#define XB_TOP      3328
#define XB_TOPGEN   3392
#define XCD_BAR_WORDS 3456
#define XB_SPIN_CAP (1u << 18)
__device__ __forceinline__ unsigned xb_ld(unsigned* p)              { return __hip_atomic_load(p, __ATOMIC_RELAXED, __HIP_MEMORY_SCOPE_AGENT); }
__device__ __forceinline__ unsigned xb_add(unsigned* p, unsigned v) { return __hip_atomic_fetch_add(p, v, __ATOMIC_RELAXED, __HIP_MEMORY_SCOPE_AGENT); }
__device__ __forceinline__ unsigned xb_xcc_id() { return (unsigned)__builtin_amdgcn_s_getreg((3 << 11) | 20) & 0xFu; }
#define XB_SPIN(cond, bar) do { unsigned _sp = 0; while (cond) { __builtin_amdgcn_s_sleep(1); \
    if ((++_sp & 255u) == 0u) { if (xb_ld(&(bar)[XB_TMO])) break; if (_sp > XB_SPIN_CAP) { atomicAdd(&(bar)[XB_TMO], 1u); break; } } } } while (0)
struct XcdBarrier { unsigned* bar; unsigned x; volatile LAS unsigned* st; };
__device__ __forceinline__ XcdBarrier xcd_barrier_post(unsigned* bar, volatile LAS unsigned* st) {
    XcdBarrier b; b.bar = bar; b.x = xb_xcc_id(); b.st = st;
    if (threadIdx.x == 0) (void)xb_add(&bar[XB_XCNT(b.x)], 1u);
    return b;
}
__device__ __forceinline__ void xcd_barrier_complete(unsigned* bar, unsigned x, unsigned& nloc, unsigned& nx) {
    const unsigned G = gridDim.x * gridDim.y * gridDim.z;
    unsigned sum, cnt, mine, sp = 0u;
    for (;;) {
        sum = 0u; cnt = 0u; mine = 0u;
#pragma unroll
        for (unsigned j = 0; j < 16; ++j) { const unsigned c = xb_ld(&bar[XB_XCNT(j)]); sum += c; cnt += (c > 0u) ? 1u : 0u; mine = (j == x) ? c : mine; }
        if (sum == G) break;
        __builtin_amdgcn_s_sleep(1);
        if ((++sp & 255u) == 0u) { if (xb_ld(&bar[XB_TMO])) break; if (sp > XB_SPIN_CAP) { atomicAdd(&bar[XB_TMO], 1u); break; } }
    }
    nloc = mine > 0u ? mine : 1u; nx = cnt > 0u ? cnt : 1u;
}
__device__ __forceinline__ void xcd_barrier(const XcdBarrier& b) {
    asm volatile("s_waitcnt vmcnt(0)" ::: "memory");
    __syncthreads();
    if (threadIdx.x == 0) {
        unsigned* bar = b.bar;
        __builtin_amdgcn_s_waitcnt(0);
        unsigned nloc = b.st[0], nx = b.st[1];
        if (nloc == 0u) { xcd_barrier_complete(bar, b.x, nloc, nx); b.st[0] = nloc; b.st[1] = nx; }
        const unsigned old = xb_add(&bar[XB_XSUB(b.x)], 1u);
        const unsigned gen = old / nloc;
        if (old + 1u == (gen + 1u) * nloc) {
            __builtin_amdgcn_fence(__ATOMIC_RELEASE, "agent");
            asm volatile("s_waitcnt vmcnt(0)" ::: "memory");
            const unsigned og = xb_add(&bar[XB_TOP], 1u);
            const unsigned tg = og / nx;
            if (og + 1u == (tg + 1u) * nx) xb_add(&bar[XB_TOPGEN], 1u);
            else XB_SPIN(xb_ld(&bar[XB_TOPGEN]) == tg, bar);
            __builtin_amdgcn_fence(__ATOMIC_ACQUIRE, "agent");
            xb_add(&bar[XB_XGEN(b.x)], 1u);
            asm volatile("s_waitcnt vmcnt(0)" ::: "memory");
        } else {
            XB_SPIN(xb_ld(&bar[XB_XGEN(b.x)]) == gen, bar);
            __builtin_amdgcn_fence(__ATOMIC_ACQUIRE, "agent");
            asm volatile("s_waitcnt vmcnt(0)" ::: "memory");
        }
    }
    __syncthreads();
}

struct Args { const float* in[20]; float* out; unsigned char* ws; int ph_lo, ph_hi, flag, pad; };
struct Frame {
    LAS unsigned char* lds;
    volatile LAS unsigned* MISC;
    gu32* ctl;
    int tid, lane, wave;
    int vcu, G;
    float* out; unsigned char* ws;
};
#define IN_X 0
#define IN_GMIX 1
#define IN_WIN 2
#define IN_WA2 3
#define IN_BA 4
#define IN_GGLA 5
#define IN_WBRG 6
#define IN_GQ 7
#define IN_GK 8
#define IN_RELB 9
#define IN_WBRA 10
#define IN_WOUT 11
#define IN_GFFN 12
#define IN_WRG 13
#define IN_BRG 14
#define IN_WRE 15
#define IN_BRE 16
#define IN_WGATE 17
#define IN_WUP 18
#define IN_WDOWN 19
#define WSP(T, off) ((T*)(F.ws + (off)))

__device__ __forceinline__ float wave_sum(float v) {
#pragma unroll
    for (int o = 1; o < 64; o <<= 1) v += __shfl_xor(v, o);
    return v;
}
__device__ __forceinline__ float wave_max(float v) {
#pragma unroll
    for (int o = 1; o < 64; o <<= 1) v = fmaxf(v, __shfl_xor(v, o));
    return v;
}
__device__ __forceinline__ void win_map(int p, int& c, float& s) {
    const int tile = p >> 8, j = p & 255; s = 1.f;
    if (tile == 0) { c = L_QA + j; s = 0.125f; }
    else if (tile == 1) c = L_KA + j;
    else if (tile < 4) c = L_VA + (p - 512);
    else if (tile < 6) c = L_RA + (p - 1024);
    else if (tile < 10) {
        const int pl = (p - 1536) & 511, t2 = pl >> 8, jj = pl & 255, bj = jj >> 7, wc = (jj >> 5) & 3, x = jj & 31;
        c = (tile < 8 ? L_QB : L_KB) + t2 * 256 + 64 * wc + 32 * bj + x;
    }
    else if (tile < 12) c = L_VB + (p - 2560);
    else if (tile == 12) c = L_QI + j;
    else if (tile == 13) { if (j < 32) c = L_KI + j; else if (j < 40) { c = L_WI + (j - 32); s = 0.0625f; } else if (j < 56) c = L_ALR + (j - 40); else c = -1; }
    else {
        const int pl = (p - 3584) & 1023, t4 = pl >> 8, jj = pl & 255, bj = jj >> 7, wc = (jj >> 5) & 3, fq = (jj >> 3) & 3, j2 = jj & 7;
        c = (tile < 18 ? L_GA : L_GB) + t4 * 256 + 64 * wc + 16 * fq + 8 * bj + j2;
    }
}
#ifndef G1_NBF
#define G1_NBF 0
#endif
__host__ __device__ __forceinline__ int g1_tile(int set, int j) {
#if G1_NBF == 8
    return set ? (j < 4 ? j + 2 : (j < 6 ? j + 6 : j + 8)) : (j < 2 ? j : (j < 6 ? j + 4 : j + 6));
#elif G1_NBF == 2
    return set ? (j < 12 ? j : j + 2) : 12 + j;
#else
    return j;
#endif
}
__device__ __forceinline__ bool win_is8(int tile) {
#if G1_NBF == 8
    return (tile >= 2 && tile < 6) || tile == 10 || tile == 11 || tile >= 14;
#elif G1_NBF == 2
    return tile != 12 && tile != 13;
#else
    return true;
#endif
}
template <int MAP>
__device__ __forceinline__ void p0_transpose_item(const float* W, int K, int N, bf16* WT, int row_off, int nrows, LAS float* scr, int item, int lane, const float* ksc = nullptr, gu32* cmax = nullptr) {
    const int nblk = nrows / 32, kb = item / nblk, nb = item % nblk, k0 = 64 * kb, n0 = 32 * nb;
    const int c4 = lane & 7, kk8 = lane >> 3;
    int c = n0 + 4 * c4; float s = 1.f;
    if (MAP == 1) win_map(n0 + 4 * c4, c, s);
#pragma unroll
    for (int i = 0; i < 8; ++i) { const int kk = 8 * i + kk8; f32x4 v = {0.f, 0.f, 0.f, 0.f};
        if (c >= 0) v = *(const GAS f32x4*)(W + (size_t)(k0 + kk) * N + c) * (ksc ? s * ksc[k0 + kk] : s);
        LAS float* d = scr + kk * 33 + 4 * c4; d[0] = v.x; d[1] = v.y; d[2] = v.z; d[3] = v.w; }
    LDS_WAIT(); asm volatile("" ::: "memory");
    if (cmax) { if (MAP == 0 || win_is8(n0 >> 8)) {
        float mx = 0.f;
#pragma unroll 8
        for (int i = 0; i < 32; ++i) mx = fmaxf(mx, fabsf(scr[(2 * i + (lane >> 5)) * 33 + (lane & 31)]));
        mx = fmaxf(mx, __shfl_xor(mx, 32));
        if (lane < 32) __hip_atomic_fetch_max(cmax + row_off + n0 + lane, f2bf(mx) << 16, RLX_AGENT); } }
    const int ch = lane & 7;
#pragma unroll
    for (int j = 0; j < 4; ++j) { const int n = (lane >> 3) + 8 * j; const LAS float* sp = scr + (8 * ch) * 33 + n;
        v4u o; o.x = pk2(sp[0 * 33], sp[1 * 33]); o.y = pk2(sp[2 * 33], sp[3 * 33]); o.z = pk2(sp[4 * 33], sp[5 * 33]); o.w = pk2(sp[6 * 33], sp[7 * 33]);
        *(GAS v4u*)(WT + (size_t)(row_off + n0 + n) * K + k0 + 8 * ch) = o; }
    LDS_WAIT(); asm volatile("" ::: "memory");
}
__device__ __forceinline__ void rms_row_to_bf16(const float* xrow, const float* g, bf16* orow, int lane) {
    const GAS f32x4* xr = (const GAS f32x4*)xrow + lane; const GAS f32x4* gr = (const GAS f32x4*)g + lane;
    f32x4 v[4]; float s = 0.f;
#pragma unroll
    for (int j = 0; j < 4; ++j) { v[j] = xr[64 * j]; s += (v[j].x * v[j].x + v[j].y * v[j].y) + (v[j].z * v[j].z + v[j].w * v[j].w); }
    const float rs = 1.0f / sqrtf(wave_sum(s) * (1.f / D) + EPS);
    GAS unsigned long long* o8 = (GAS unsigned long long*)orow + lane;
#pragma unroll
    for (int j = 0; j < 4; ++j) { const f32x4 gg = gr[64 * j]; o8[64 * j] = (unsigned long long)pk2(v[j].x * rs * gg.x, v[j].y * rs * gg.y) | ((unsigned long long)pk2(v[j].z * rs * gg.z, v[j].w * rs * gg.w) << 32); }
}
__device__ __forceinline__ void p0_prologue(Frame& F, const Args& A) {
    LAS float* scr = (LAS float*)(F.lds + RING_OFF + F.wave * 16384);
    const int gw = F.vcu * NWAVES + F.wave, NGW = F.G * NWAVES;
    constexpr int I_IN = (D / 64) * (NP / 32);
    constexpr int I_AB = (512 / 64) * (D / 32);
    constexpr int I_O = (D / 64) * (D / 32);
    constexpr int I_GU = (D / 64) * (DEXP / 32);
    constexpr int I_DN = (DEXP / 64) * (D / 32);
    constexpr int NITEMS = I_IN + 2 * I_AB + I_O + NEXP * (2 * I_GU + I_DN);
    for (int it = gw; it < NITEMS; it += NGW) {
        int r = it;
        if (r < I_IN) { p0_transpose_item<1>(A.in[IN_WIN], D, D_IN, WSP(bf16, WS_WIN), 0, NP, scr, r, F.lane, nullptr, F.ctl + CW_CMAX); continue; } r -= I_IN;
        if (r < I_AB) { p0_transpose_item<0>(A.in[IN_WBRG], 512, D, WSP(bf16, WS_WA), 0, D, scr, r, F.lane); continue; } r -= I_AB;
        if (r < I_AB) { p0_transpose_item<0>(A.in[IN_WBRA], 512, D, WSP(bf16, WS_WB), 0, D, scr, r, F.lane); continue; } r -= I_AB;
        if (r < I_O) { p0_transpose_item<0>(A.in[IN_WOUT], D, D, WSP(bf16, WS_WO), 0, D, scr, r, F.lane, nullptr, F.ctl + CW_CMAX + NP + NEXP * 256); continue; } r -= I_O;
        const int e = r / (2 * I_GU + I_DN); r -= e * (2 * I_GU + I_DN);
        if (r < I_GU) { p0_transpose_item<0>(A.in[IN_WGATE] + (size_t)e * D * DEXP, D, DEXP, WSP(bf16, WS_WGU) + (size_t)e * 256 * D, 0, DEXP, scr, r, F.lane, A.in[IN_GFFN], F.ctl + CW_CMAX + NP + e * 256); continue; } r -= I_GU;
        if (r < I_GU) { p0_transpose_item<0>(A.in[IN_WUP] + (size_t)e * D * DEXP, D, DEXP, WSP(bf16, WS_WGU) + (size_t)e * 256 * D, 128, DEXP, scr, r, F.lane, A.in[IN_GFFN], F.ctl + CW_CMAX + NP + e * 256); continue; } r -= I_GU;
        p0_transpose_item<0>(A.in[IN_WDOWN] + (size_t)e * DEXP * D, DEXP, D, WSP(bf16, WS_WD) + (size_t)e * D * DEXP, 0, D, scr, r, F.lane);
    }
    { bf16* WRH = WSP(bf16, WS_WR); bf16* WRL = WRH + 64 * D;
      for (int i = F.vcu * 512 + F.tid; i < 64 * D; i += F.G * 512) { const int c = i >> 10, k = i & 1023;
          float v = 0.f; if (c < 4) v = A.in[IN_WRG][k * 4 + c]; else if (c < 36) v = A.in[IN_WRE][k * 32 + (c - 4)];
          v *= A.in[IN_GFFN][k]; const unsigned hb = f2bf(v); const float lo = v - __builtin_bit_cast(float, hb << 16);
          WRH[i] = (bf16)hb; WRL[i] = (bf16)f2bf(lo); } }
    for (int m = gw * 8; m < M; m += NGW * 8) {
        const GAS f32x4* gr = (const GAS f32x4*)A.in[IN_GMIX] + F.lane;
        f32x4 v[8][4]; float ss[8], am[8];
#pragma unroll
        for (int r = 0; r < 8; ++r) { const GAS f32x4* xr = (const GAS f32x4*)(A.in[IN_X] + (size_t)(m + r) * D) + F.lane; ss[r] = 0.f; am[r] = 0.f;
#pragma unroll
            for (int j = 0; j < 4; ++j) { v[r][j] = __builtin_nontemporal_load(xr + 64 * j); } }
#pragma unroll
        for (int r = 0; r < 8; ++r) {
#pragma unroll
            for (int j = 0; j < 4; ++j) ss[r] += (v[r][j].x * v[r][j].x + v[r][j].y * v[r][j].y) + (v[r][j].z * v[r][j].z + v[r][j].w * v[r][j].w);
            ss[r] = 1.0f / sqrtf(wave_sum(ss[r]) * (1.f / D) + EPS); }
#pragma unroll
        for (int j = 0; j < 4; ++j) { const f32x4 gg = gr[64 * j];
#pragma unroll
            for (int r = 0; r < 8; ++r) { GAS unsigned long long* o8 = (GAS unsigned long long*)(WSP(bf16, WS_HN) + (size_t)(m + r) * D) + F.lane; const float rs = ss[r];
                const f32x4 y = {v[r][j].x * rs * gg.x, v[r][j].y * rs * gg.y, v[r][j].z * rs * gg.z, v[r][j].w * rs * gg.w}; v[r][j] = y;
                am[r] = fmaxf(fmaxf(am[r], fmaxf(fabsf(y.x), fabsf(y.y))), fmaxf(fabsf(y.z), fabsf(y.w)));
                if (G1_NBF > 0) o8[64 * j] = (unsigned long long)pk2(y.x, y.y) | ((unsigned long long)pk2(y.z, y.w) << 32); } }
#pragma unroll
        for (int r = 0; r < 8; ++r) { const float a = wave_max(am[r]); const float inv = a > 0.f ? 127.0f / a : 0.f;
            if (F.lane == 0) WSP(float, WS_RS8)[m + r] = a * (1.0f / 127.0f);
            v4u q;
#pragma unroll
            for (int j = 0; j < 4; ++j) { unsigned b = 0u;
                b = __builtin_amdgcn_cvt_pk_u8_f32(__builtin_rintf(__builtin_fmaf(v[r][j].x, inv, 128.0f)), 0, b); b = __builtin_amdgcn_cvt_pk_u8_f32(__builtin_rintf(__builtin_fmaf(v[r][j].y, inv, 128.0f)), 1, b);
                b = __builtin_amdgcn_cvt_pk_u8_f32(__builtin_rintf(__builtin_fmaf(v[r][j].z, inv, 128.0f)), 2, b); b = __builtin_amdgcn_cvt_pk_u8_f32(__builtin_rintf(__builtin_fmaf(v[r][j].w, inv, 128.0f)), 3, b);
                q[j] = b ^ 0x80808080u; }
            *(GAS v4u*)(F.ws + WS_HN8 + (size_t)(m + r) * D + 16 * F.lane) = q; }
    }
}
__device__ __forceinline__ void p0_quant(Frame& F, const Args& A) {
    const int gw = F.vcu * NWAVES + F.wave, NGW = F.G * NWAVES;
    for (int idx = gw; idx < (22 - G1_NBF) * 256; idx += NGW) {
        const int tile = g1_tile(1, idx >> 8), p = tile * 256 + (idx & 255);
        const float a = __builtin_bit_cast(float, __hip_atomic_load(F.ctl + CW_CMAX + p, RLX_AGENT)); const float inv = a > 0.f ? 127.0f / a : 0.f;
        if (F.lane == 0) WSP(float, WS_CS8)[p] = a * (1.0f / 127.0f);
        const GAS v2u* row = (const GAS v2u*)(WSP(bf16, WS_WIN) + (size_t)p * D) + F.lane;
        v4u q;
#pragma unroll
        for (int j = 0; j < 4; ++j) { const v2u w = row[64 * j]; unsigned b = 0u;
            b = __builtin_amdgcn_cvt_pk_u8_f32(__builtin_rintf(__builtin_fmaf(bflo(w[0]), inv, 128.0f)), 0, b); b = __builtin_amdgcn_cvt_pk_u8_f32(__builtin_rintf(__builtin_fmaf(bfhi(w[0]), inv, 128.0f)), 1, b);
            b = __builtin_amdgcn_cvt_pk_u8_f32(__builtin_rintf(__builtin_fmaf(bflo(w[1]), inv, 128.0f)), 2, b); b = __builtin_amdgcn_cvt_pk_u8_f32(__builtin_rintf(__builtin_fmaf(bfhi(w[1]), inv, 128.0f)), 3, b);
            q[j] = b ^ 0x80808080u; }
        *(GAS v4u*)(F.ws + WS_WIN8 + (size_t)p * D + 16 * F.lane) = q;
    }
    for (int r = gw; r < NEXP * 256; r += NGW) {
        const float a = __builtin_bit_cast(float, __hip_atomic_load(F.ctl + CW_CMAX + NP + r, RLX_AGENT)); const float inv = a > 0.f ? 127.0f / a : 0.f;
        if (F.lane == 0) WSP(float, WS_CSU)[r] = a * (1.0f / 127.0f);
        const GAS v4u* row = (const GAS v4u*)(WSP(bf16, WS_WGU) + (size_t)r * D + 32 * (F.lane >> 1) + 8 * (F.lane & 1));
        v4u q;
#pragma unroll
        for (int c = 0; c < 2; ++c) { const v4u w = row[2 * c];
#pragma unroll
            for (int j = 0; j < 2; ++j) { unsigned b = 0u;
                b = __builtin_amdgcn_cvt_pk_u8_f32(__builtin_rintf(__builtin_fmaf(bflo(w[2 * j]), inv, 128.0f)), 0, b); b = __builtin_amdgcn_cvt_pk_u8_f32(__builtin_rintf(__builtin_fmaf(bfhi(w[2 * j]), inv, 128.0f)), 1, b);
                b = __builtin_amdgcn_cvt_pk_u8_f32(__builtin_rintf(__builtin_fmaf(bflo(w[2 * j + 1]), inv, 128.0f)), 2, b); b = __builtin_amdgcn_cvt_pk_u8_f32(__builtin_rintf(__builtin_fmaf(bfhi(w[2 * j + 1]), inv, 128.0f)), 3, b);
                q[2 * c + j] = b ^ 0x80808080u; } }
        *(GAS v4u*)(F.ws + WS_WGU8 + (size_t)r * D + 16 * F.lane) = q;
    }
    for (int r = gw; r < D; r += NGW) {
        const float a = __builtin_bit_cast(float, __hip_atomic_load(F.ctl + CW_CMAX + NP + NEXP * 256 + r, RLX_AGENT)); const float inv = a > 0.f ? 127.0f / a : 0.f;
        if (F.lane == 0) WSP(float, WS_CSO)[r] = a * (1.0f / 127.0f);
        const GAS v4u* row = (const GAS v4u*)(WSP(bf16, WS_WO) + (size_t)r * D + 256 * (F.lane >> 4) + 32 * ((F.lane >> 2) & 3) + 8 * (F.lane & 3));
        v4u q;
#pragma unroll
        for (int c = 0; c < 2; ++c) { const v4u w = row[16 * c];
#pragma unroll
            for (int j = 0; j < 2; ++j) { unsigned b = 0u;
                b = __builtin_amdgcn_cvt_pk_u8_f32(__builtin_rintf(__builtin_fmaf(bflo(w[2 * j]), inv, 128.0f)), 0, b); b = __builtin_amdgcn_cvt_pk_u8_f32(__builtin_rintf(__builtin_fmaf(bfhi(w[2 * j]), inv, 128.0f)), 1, b);
                b = __builtin_amdgcn_cvt_pk_u8_f32(__builtin_rintf(__builtin_fmaf(bflo(w[2 * j + 1]), inv, 128.0f)), 2, b); b = __builtin_amdgcn_cvt_pk_u8_f32(__builtin_rintf(__builtin_fmaf(bfhi(w[2 * j + 1]), inv, 128.0f)), 3, b);
                q[2 * c + j] = b ^ 0x80808080u; } }
        *(GAS v4u*)(F.ws + WS_WO8 + (size_t)r * D + 16 * F.lane) = q;
    }
}
namespace pg8 {
template <bool I8>
struct EpiG1 {
    static constexpr bool PERM = true;
    unsigned char* ws; const float *gq, *gk; const float *RS, *CS;
    __device__ __forceinline__ int operator()(const f32x4 (&acc)[2][2][4][2], const Unit& u, int wr, int wc, int fr, int fq) const {
        { int l; asm volatile("v_mbcnt_lo_u32_b32 %0, -1, 0\n\tv_mbcnt_hi_u32_b32 %0, -1, %0" : "=v"(l)); fr = l & 15; fq = l >> 4; }
        const int pn = u.pn; const size_t row0 = (size_t)u.pm * BM + wr * 64 + fr;
        float rsc[2][4]; f32x4 csc[2][2];
        if constexpr (I8) {
#pragma unroll
            for (int ai = 0; ai < 2; ++ai)
#pragma unroll
                for (int m = 0; m < 4; ++m) rsc[ai][m] = RS[row0 + ai * HALF + m * 16];
#pragma unroll
            for (int bj = 0; bj < 2; ++bj)
#pragma unroll
                for (int n = 0; n < 2; ++n) csc[bj][n] = *(const f32x4*)(CS + pn * BM + bj * HALF + wc * 32 + 8 * fq + 4 * n);
        }
        auto DQ = [&](int ai, int bj, int m, int n) -> f32x4 {
            if constexpr (I8) return __builtin_convertvector(__builtin_bit_cast(i32x4, acc[ai][bj][m][n]), f32x4) * csc[bj][n] * rsc[ai][m];
            else return acc[ai][bj][m][n]; };
        if (pn >= 6 && pn < 10) {
            const bool isq = pn < 8; const int t2 = pn - (isq ? 6 : 8); bf16_t* out = (bf16_t*)(ws + (isq ? WS_QB : WS_KB)); const float* g = isq ? gq : gk; const float sc = isq ? 0.125f * 1.4426950408889634f : 1.0f;
            f32x4 gl[2][2];
#pragma unroll
            for (int bj = 0; bj < 2; ++bj)
#pragma unroll
                for (int n = 0; n < 2; ++n) gl[bj][n] = *(const f32x4*)(g + 32 * bj + 8 * fq + 4 * n) * sc;
#pragma unroll
            for (int ai = 0; ai < 2; ++ai)
#pragma unroll
                for (int m = 0; m < 4; ++m) {
                    float ss = 0.f; f32x4 xv[2][2];
#pragma unroll
                    for (int bj = 0; bj < 2; ++bj)
#pragma unroll
                        for (int n = 0; n < 2; ++n) { const f32x4 x = DQ(ai, bj, m, n); xv[bj][n] = x; ss += (x[0] * x[0] + x[1] * x[1]) + (x[2] * x[2] + x[3] * x[3]); }
                    ss += __shfl_xor(ss, 16); ss += __shfl_xor(ss, 32);
                    const float rs = 1.0f / sqrtf(ss * (1.0f / 64.0f) + 1e-6f);
                    bf16_t* rowp = out + (row0 + ai * HALF + m * 16) * 512 + t2 * 256 + 64 * wc + 8 * fq;
#pragma unroll
                    for (int bj = 0; bj < 2; ++bj) { const f32x4 v0 = xv[bj][0] * rs * gl[bj][0], v1 = xv[bj][1] * rs * gl[bj][1];
                        u32x4 w; w.x = cvt_pk_bf16(v0[0], v0[1]); w.y = cvt_pk_bf16(v0[2], v0[3]); w.z = cvt_pk_bf16(v1[0], v1[1]); w.w = cvt_pk_bf16(v1[2], v1[3]);
                        __builtin_nontemporal_store(w, (u32x4*)(rowp + 32 * bj)); }
                }
            return 16;
        }
        if (pn == 13) {
            if (wc == 0) {
#pragma unroll
                for (int ai = 0; ai < 2; ++ai)
#pragma unroll
                    for (int m = 0; m < 4; ++m) { const f32x4 v0 = DQ(ai, 0, m, 0), v1 = DQ(ai, 0, m, 1);
                        u32x4 w; w.x = cvt_pk_bf16(v0[0], v0[1]); w.y = cvt_pk_bf16(v0[2], v0[3]); w.z = cvt_pk_bf16(v1[0], v1[1]); w.w = cvt_pk_bf16(v1[2], v1[3]);
                        *(u32x4*)((bf16_t*)(ws + WS_KI) + (row0 + ai * HALF + m * 16) * 32 + 8 * fq) = w; }
            } else if (wc == 1 && fq < 3) {
#pragma unroll
                for (int ai = 0; ai < 2; ++ai)
#pragma unroll
                    for (int m = 0; m < 4; ++m) { const size_t r = row0 + ai * HALF + m * 16;
                        float* dst = (fq == 0) ? ((float*)(ws + WS_WI) + r * 8) : ((float*)(ws + WS_ALR) + r * 16 + 8 * (fq - 1));
                        *(f32x4*)dst = DQ(ai, 0, m, 0); *(f32x4*)(dst + 4) = DQ(ai, 0, m, 1); }
            }
            return wc == 0 ? 8 : (wc == 1 ? 16 : 0);
        }
        if (pn >= 14) {
            unsigned char* gb = ws + (pn < 18 ? WS_GA : WS_GB) + ((pn - 14) & 3) * 256 + 64 * wc + 16 * fq;
#pragma unroll
            for (int ai = 0; ai < 2; ++ai)
#pragma unroll
                for (int m = 0; m < 4; ++m) { u32x4 w;
#pragma unroll
                    for (int bj = 0; bj < 2; ++bj) { const f32x4 v0 = DQ(ai, bj, m, 0), v1 = DQ(ai, bj, m, 1); unsigned b0 = 0u, b1 = 0u;
#pragma unroll
                        for (int j = 0; j < 4; ++j) { b0 = __builtin_amdgcn_cvt_pk_u8_f32(sigmoidf_(v0[j]) * 255.0f, j, b0); b1 = __builtin_amdgcn_cvt_pk_u8_f32(sigmoidf_(v1[j]) * 255.0f, j, b1); }
                        if (bj == 0) { w.x = b0; w.y = b1; } else { w.z = b0; w.w = b1; } }
                    __builtin_nontemporal_store(w, (u32x4*)(gb + (row0 + ai * HALF + m * 16) * (size_t)1024)); }
            return 8;
        }
        const bool act = (pn == 4 || pn == 5);
        const size_t ob = pn == 0 ? WS_QA : (pn == 1 ? WS_KA : (pn < 4 ? WS_VA : (pn < 6 ? WS_RA : (pn < 12 ? WS_VB : WS_QI))));
        const int ld = (pn < 2 || pn == 12) ? 256 : 512, cb = (pn < 2 || pn == 12) ? 0 : ((pn < 4 ? pn - 2 : (pn < 6 ? pn - 4 : pn - 10)) * 256);
        bf16_t* base = (bf16_t*)(ws + ob);
        const int col0 = cb + wc * 32 + 8 * fq;
#pragma unroll
        for (int ai = 0; ai < 2; ++ai)
#pragma unroll
            for (int m = 0; m < 4; ++m) { bf16_t* rowp = base + (row0 + ai * HALF + m * 16) * ld + col0;
#pragma unroll
                for (int bj = 0; bj < 2; ++bj) { f32x4 v0 = DQ(ai, bj, m, 0), v1 = DQ(ai, bj, m, 1);
                    if (act) {
#pragma unroll
                        for (int j = 0; j < 4; ++j) { v0[j] = siluf_(v0[j]); v1[j] = siluf_(v1[j]); } }
                    u32x4 w; w.x = cvt_pk_bf16(v0[0], v0[1]); w.y = cvt_pk_bf16(v0[2], v0[3]); w.z = cvt_pk_bf16(v1[0], v1[1]); w.w = cvt_pk_bf16(v1[2], v1[3]);
                    __builtin_nontemporal_store(w, (u32x4*)(rowp + bj * HALF)); } }
        return 16;
    }
};
struct G1Order {
    static constexpr bool GATHER = false, SPLITB = false;
    int G, c, ns, set, cnt;
    __device__ bool next(int i, Unit& u) const {
        u.sel = 0;
        if (c < ns) return false;
        const long L = (long)i * (G - ns) + (c - ns); if (L >= 256L * cnt) return false;
        int j; tile_of((int)L, 256, cnt, u.pm, j);
        u.pn = g1_tile(set, j); return true;
    }
    __device__ __forceinline__ const char* baseA(const Gemm& g, const Unit& u) const { return (const char*)g.A + (size_t)u.pm * BM * g.lda * 2; }
    __device__ __forceinline__ const char* baseB(const Gemm& g, const Unit& u) const { return (const char*)g.Bt + (size_t)u.pn * BM * g.ldb * 2; }
};
struct PairOrder {
    static constexpr bool GATHER = false, SPLITB = false;
    int nM, nN, nwg, G, c; const bf16_t* Wa; const bf16_t* Wb;
    __device__ bool next(int i, Unit& u) const {
        const long L = (long)(i >> 1) * G + c; if (L >= nwg) return false;
        tile_of((int)L, nM, nN, u.pm, u.pn); u.sel = i & 1; return true;
    }
    __device__ __forceinline__ const char* baseA(const Gemm& g, const Unit& u) const { return (const char*)g.A + ((size_t)u.pm * BM * g.lda + (u.sel ? 512 : 0)) * 2; }
    __device__ __forceinline__ const char* baseB(const Gemm& g, const Unit& u) const { return (const char*)(u.sel ? Wb : Wa) + (size_t)u.pn * BM * g.ldb * 2; }
};
struct PanelX { PG8_LAS float* xl; unsigned* slots; gu32* cnt; float* scale; };
__device__ __forceinline__ void panel_rowmax(const PanelX& P, int pm, int pn, int wr, int wc, int fr, int fq, float (&mx)[8]) {
    const int tid = threadIdx.x;
#pragma unroll
    for (int it = 0; it < 8; ++it) { mx[it] = fmaxf(mx[it], __shfl_xor(mx[it], 16)); mx[it] = fmaxf(mx[it], __shfl_xor(mx[it], 32)); }
    if (fq == 0) {
#pragma unroll
        for (int it = 0; it < 8; ++it) P.xl[wc * 256 + (it >> 2) * HALF + wr * 64 + (it & 3) * 16 + fr] = mx[it]; }
    __syncthreads();
    if (tid < 256) { const float v = fmaxf(fmaxf(P.xl[tid], P.xl[256 + tid]), fmaxf(P.xl[512 + tid], P.xl[768 + tid]));
        __hip_atomic_store(P.slots + (pm * 4 + pn) * 256 + tid, __builtin_bit_cast(unsigned, v), RLX_AGENT); }
    asm volatile("s_waitcnt vmcnt(0)" ::: "memory");
    __syncthreads();
    if (tid == 0) { __hip_atomic_fetch_add(P.cnt + pm, 1u, __ATOMIC_RELEASE, __HIP_MEMORY_SCOPE_AGENT);
        while (__hip_atomic_load(P.cnt + pm, __ATOMIC_ACQUIRE, __HIP_MEMORY_SCOPE_AGENT) < 4u) __builtin_amdgcn_s_sleep(2); }
    __syncthreads();
    if (tid < 256) { unsigned s[4];
#pragma unroll
        for (int j = 0; j < 4; ++j) s[j] = __hip_atomic_load(P.slots + (pm * 4 + j) * 256 + tid, RLX_AGENT);
        const float v = fmaxf(fmaxf(__builtin_bit_cast(float, s[0]), __builtin_bit_cast(float, s[1])), fmaxf(__builtin_bit_cast(float, s[2]), __builtin_bit_cast(float, s[3])));
        P.xl[1024 + tid] = v; if (pn == 0) P.scale[(size_t)pm * 256 + tid] = v * (1.0f / 127.0f); }
    __syncthreads();
#pragma unroll
    for (int it = 0; it < 8; ++it) mx[it] = P.xl[1024 + (it >> 2) * HALF + wr * 64 + (it & 3) * 16 + fr];
}
struct EpiMix {
    static constexpr bool PERM = true;
    const bf16_t *GA, *GB; bf16_t* MIX; unsigned char* M8; PanelX PX;
    __device__ __forceinline__ int operator()(f32x4 (&acc)[2][2][4][2], const Unit& u, int wr, int wc, int fr, int fq) const {
        { int l; asm volatile("v_mbcnt_lo_u32_b32 %0, -1, 0\n\tv_mbcnt_hi_u32_b32 %0, -1, %0" : "=v"(l)); fr = l & 15; fq = l >> 4; }
        const size_t row0 = (size_t)u.pm * BM + wr * 64 + fr; const int col0 = u.pn * BM + wc * 32 + 8 * fq; const unsigned char* gate = (const unsigned char*)(u.sel ? GB : GA);
        v2u gwb[2][2]; u32x4 pwb[2][2]; float mx[8];
#pragma unroll
        for (int bj = 0; bj < 2; ++bj) { const size_t off = row0 * 1024 + col0 + bj * HALF; gwb[0][bj] = *(const v2u*)(gate + off); pwb[0][bj] = (u32x4){0u, 0u, 0u, 0u}; if (u.sel) pwb[0][bj] = *(const u32x4*)(MIX + off); }
#pragma unroll
        for (int it = 0; it < 8; ++it) { const int ai = it >> 2, m = it & 3, sl = it & 1; const size_t off = (row0 + ai * HALF + m * 16) * 1024 + col0;
            if (it + 1 < 8) { const size_t offn = (row0 + ((it + 1) >> 2) * HALF + ((it + 1) & 3) * 16) * 1024 + col0;
#pragma unroll
                for (int bj = 0; bj < 2; ++bj) { gwb[sl ^ 1][bj] = *(const v2u*)(gate + offn + bj * HALF); pwb[sl ^ 1][bj] = (u32x4){0u, 0u, 0u, 0u}; if (u.sel) pwb[sl ^ 1][bj] = *(const u32x4*)(MIX + offn + bj * HALF); } }
            asm volatile("" ::: "memory");
            mx[it] = 0.f;
#pragma unroll
            for (int bj = 0; bj < 2; ++bj) { const v2u gw = gwb[sl][bj]; const u32x4 pw = pwb[sl][bj]; f32x4 v0 = acc[ai][bj][m][0], v1 = acc[ai][bj][m][1];
                const float k = 1.0f / 255.0f;
                v0[0] *= (float)(gw[0] & 255u) * k; v0[1] *= (float)((gw[0] >> 8) & 255u) * k; v0[2] *= (float)((gw[0] >> 16) & 255u) * k; v0[3] *= (float)(gw[0] >> 24) * k;
                v1[0] *= (float)(gw[1] & 255u) * k; v1[1] *= (float)((gw[1] >> 8) & 255u) * k; v1[2] *= (float)((gw[1] >> 16) & 255u) * k; v1[3] *= (float)(gw[1] >> 24) * k;
                v0[0] += bflo(pw.x); v0[1] += bfhi(pw.x); v0[2] += bflo(pw.y); v0[3] += bfhi(pw.y); v1[0] += bflo(pw.z); v1[1] += bfhi(pw.z); v1[2] += bflo(pw.w); v1[3] += bfhi(pw.w);
                if (u.sel) { acc[ai][bj][m][0] = v0; acc[ai][bj][m][1] = v1;
                    mx[it] = fmaxf(fmaxf(mx[it], fmaxf(fmaxf(fabsf(v0[0]), fabsf(v0[1])), fmaxf(fabsf(v0[2]), fabsf(v0[3])))), fmaxf(fmaxf(fabsf(v1[0]), fabsf(v1[1])), fmaxf(fabsf(v1[2]), fabsf(v1[3])))); }
                else { u32x4 w; w.x = cvt_pk_bf16(v0[0], v0[1]); w.y = cvt_pk_bf16(v0[2], v0[3]); w.z = cvt_pk_bf16(v1[0], v1[1]); w.w = cvt_pk_bf16(v1[2], v1[3]);
                    *(u32x4*)(MIX + off + bj * HALF) = w; } }
            asm volatile("" ::: "memory"); }
        if (!u.sel) return 16;
        panel_rowmax(PX, u.pm, u.pn, wr, wc, fr, fq, mx);
        unsigned char* o8 = M8 + row0 * 1024 + u.pn * BM + 64 * wc + 16 * fq;
#pragma unroll
        for (int it = 0; it < 8; ++it) { const int ai = it >> 2, m = it & 3; const float a = mx[it]; const float inv = a > 0.f ? 127.0f / a : 0.f;
            u32x4 w;
#pragma unroll
            for (int bj = 0; bj < 2; ++bj) { const f32x4 v0 = acc[ai][bj][m][0], v1 = acc[ai][bj][m][1]; unsigned b0 = 0u, b1 = 0u;
#pragma unroll
                for (int j = 0; j < 4; ++j) { b0 = __builtin_amdgcn_cvt_pk_u8_f32(__builtin_rintf(__builtin_fmaf(v0[j], inv, 128.0f)), j, b0); b1 = __builtin_amdgcn_cvt_pk_u8_f32(__builtin_rintf(__builtin_fmaf(v1[j], inv, 128.0f)), j, b1); }
                if (bj == 0) { w.x = b0 ^ 0x80808080u; w.y = b1 ^ 0x80808080u; } else { w.z = b0 ^ 0x80808080u; w.w = b1 ^ 0x80808080u; } }
            *(u32x4*)(o8 + (size_t)(ai * HALF + m * 16) * 1024) = w; }
        return 8;
    }
};
struct EpiRes {
    static constexpr bool PERM = true;
    const float* X; bf16_t* XB; const float *MS, *CSO; PG8_LAS float* xl; unsigned* slots;
    __device__ __forceinline__ int operator()(const f32x4 (&acc)[2][2][4][2], const Unit& u, int wr, int wc, int fr, int fq) const {
        { int l; asm volatile("v_mbcnt_lo_u32_b32 %0, -1, 0\n\tv_mbcnt_hi_u32_b32 %0, -1, %0" : "=v"(l)); fr = l & 15; fq = l >> 4; }
        const size_t row0 = (size_t)u.pm * BM + wr * 64 + fr; const int col0 = u.pn * BM + wc * 32 + 8 * fq;
        f32x4 csc[2][2];
#pragma unroll
        for (int bj = 0; bj < 2; ++bj)
#pragma unroll
            for (int n = 0; n < 2; ++n) csc[bj][n] = *(const f32x4*)(CSO + col0 + bj * HALF + 4 * n);
        f32x4 xb[2][2][2];
#pragma unroll
        for (int bj = 0; bj < 2; ++bj) { const size_t off = row0 * 1024 + col0 + bj * HALF; xb[0][bj][0] = *(const f32x4*)(X + off); xb[0][bj][1] = *(const f32x4*)(X + off + 4); }
#pragma unroll
        for (int it = 0; it < 8; ++it) { const int ai = it >> 2, m = it & 3, sl = it & 1; const size_t off = (row0 + ai * HALF + m * 16) * 1024 + col0;
            if (it + 1 < 8) { const size_t offn = (row0 + ((it + 1) >> 2) * HALF + ((it + 1) & 3) * 16) * 1024 + col0;
#pragma unroll
                for (int bj = 0; bj < 2; ++bj) { xb[sl ^ 1][bj][0] = *(const f32x4*)(X + offn + bj * HALF); xb[sl ^ 1][bj][1] = *(const f32x4*)(X + offn + bj * HALF + 4); } }
            asm volatile("" ::: "memory");
            const float rsc = MS[row0 + ai * HALF + m * 16]; float mx = 0.f;
#pragma unroll
            for (int bj = 0; bj < 2; ++bj) { const f32x4 y0 = xb[sl][bj][0] + __builtin_convertvector(__builtin_bit_cast(i32x4, acc[ai][bj][m][0]), f32x4) * csc[bj][0] * rsc, y1 = xb[sl][bj][1] + __builtin_convertvector(__builtin_bit_cast(i32x4, acc[ai][bj][m][1]), f32x4) * csc[bj][1] * rsc;
                mx = fmaxf(fmaxf(mx, fmaxf(fmaxf(fabsf(y0[0]), fabsf(y0[1])), fmaxf(fabsf(y0[2]), fabsf(y0[3])))), fmaxf(fmaxf(fabsf(y1[0]), fabsf(y1[1])), fmaxf(fabsf(y1[2]), fabsf(y1[3]))));
                u32x4 w; w.x = cvt_pk_bf16(y0[0], y0[1]); w.y = cvt_pk_bf16(y0[2], y0[3]); w.z = cvt_pk_bf16(y1[0], y1[1]); w.w = cvt_pk_bf16(y1[2], y1[3]);
                *(u32x4*)(XB + off + bj * HALF) = w; }
            mx = fmaxf(mx, __shfl_xor(mx, 16)); mx = fmaxf(mx, __shfl_xor(mx, 32));
            if (fq == 0) xl[wc * 256 + ai * HALF + wr * 64 + m * 16 + fr] = __builtin_bit_cast(float, f2bf(mx) << 16);
            asm volatile("" ::: "memory"); }
        __syncthreads();
        { const int tid = threadIdx.x;
          if (tid < 256) { const float v = fmaxf(fmaxf(xl[tid], xl[256 + tid]), fmaxf(xl[512 + tid], xl[768 + tid])); slots[(u.pm * 4 + u.pn) * 256 + tid] = __builtin_bit_cast(unsigned, v); } }
        __syncthreads();
        return 16;
    }
};
}
__device__ __forceinline__ void gla_prep(Frame& F, const Args& A) {
    const int half = F.tid >> 8, dcol = F.tid & 255;
    LAS float* alr_s = (LAS float*)(F.lds) + half * 1024;
    const float* W2 = A.in[IN_WA2]; const float* ALR = WSP(float, WS_ALR); const bf16* KA = WSP(bf16, WS_KA);
    bf16* KDT = WSP(bf16, WS_KDT); float* DEC = WSP(float, WS_DEC);
    float w2[16];
#pragma unroll
    for (int r = 0; r < 16; ++r) w2[r] = W2[r * 256 + dcol];
    const float bb = A.in[IN_BA][dcol];
    for (int it = F.vcu; it < NCHUNK / 2; it += F.G) {
        const int chunk = it * 2 + half; const size_t row0 = (size_t)chunk * CH;
        __syncthreads();
        *(LAS f32x4*)(alr_s + dcol * 4) = *(const f32x4*)(ALR + row0 * 16 + dcol * 4);
        __syncthreads();
        float cum[64]; float run = 0.f;
#pragma unroll
        for (int t = 0; t < 64; ++t) {
            float z = bb;
#pragma unroll
            for (int r4 = 0; r4 < 4; ++r4) { const f32x4 a = *(const LAS f32x4*)(alr_s + t * 16 + r4 * 4); z += a[0] * w2[r4 * 4] + a[1] * w2[r4 * 4 + 1] + a[2] * w2[r4 * 4 + 2] + a[3] * w2[r4 * 4 + 3]; }
            const float ls = fminf(z, 0.f) - 0.6931471805599453f * __builtin_amdgcn_logf(1.0f + __builtin_amdgcn_exp2f(-fabsf(z) * LOG2E));
            run += ls * (1.0f / 16.0f); cum[t] = run;
        }
        const float total = run;
        DEC[(size_t)chunk * 256 + dcol] = __builtin_amdgcn_exp2f(total * LOG2E);
        const int h = dcol >> 6, d = dcol & 63;
        bf16* dst = KDT + (((size_t)chunk * 4 + h) * 64 + d) * 64;
        const bf16* ksrc = KA + row0 * 256 + dcol;
#pragma unroll
        for (int t8 = 0; t8 < 8; ++t8) {
            float kv[8];
#pragma unroll
            for (int j = 0; j < 8; ++j) { const int t = t8 * 8 + j; kv[j] = bf2f(ksrc[(size_t)t * 256]) * __builtin_amdgcn_exp2f((total - cum[t]) * LOG2E); }
            v4u o; o.x = pk2(kv[0], kv[1]); o.y = pk2(kv[2], kv[3]); o.z = pk2(kv[4], kv[5]); o.w = pk2(kv[6], kv[7]);
            *(GAS v4u*)(dst + t8 * 8) = o;
        }
    }
    __syncthreads();
}
namespace gla {
using s16x4 = __attribute__((ext_vector_type(4))) short;
typedef short v4i16_t __attribute__((ext_vector_type(4)));
typedef __attribute__((address_space(3))) const char* lds_cptr;
__device__ __forceinline__ s16x4 vtr(lds_cptr p) { return __builtin_bit_cast(s16x4, __builtin_amdgcn_ds_read_tr16_b64_v4i16((__attribute__((address_space(3))) v4i16_t*)p)); }
__device__ __forceinline__ void glds16(const void* gsrc, unsigned lds_dst) { unsigned keep;
    asm volatile("s_mov_b32 %0, m0\n\ts_mov_b32 m0, %2\n\ts_nop 0\n\tglobal_load_lds_dwordx4 %1, off\n\ts_mov_b32 m0, %0" : "=&s"(keep) : "v"(gsrc), "s"(lds_dst) : "memory"); }
__device__ __forceinline__ unsigned cvtpk(float lo, float hi) { return pg8::cvt_pk_bf16(lo, hi); }
constexpr int L_Q = 0, L_KD = 16384, L_V = 32768, L_R = 65536, L_DEC = 98304, L_OST = 98816, L_RED = 115200, L_END = L_RED + 2048;
struct Ctx { const bf16* KDT; const float* DEC; const bf16* QA; const bf16* VA; const bf16* RA; bf16* OC; };
#define GLA_BAR() asm volatile("s_waitcnt lgkmcnt(0)\n\ts_barrier" ::: "memory")

__device__ __forceinline__ void load_chunk(const Ctx& X, unsigned lds0, int chunk, int h, int ld, int lane, int slot) {
    const size_t row0 = (size_t)chunk * 64;
#pragma unroll
    for (int i = 0; i < 2; ++i) { const int p = 128 * ld + 64 * i + lane, r = p >> 3, cg = (p & 7) ^ (r & 7);
        glds16(X.QA + (row0 + r) * 256 + h * 64 + cg * 8, (unsigned)__builtin_amdgcn_readfirstlane(lds0 + L_Q + slot * 8192 + (128 * ld + 64 * i) * 16));
        glds16(X.KDT + (((size_t)chunk * 4 + h) * 64 + r) * 64 + cg * 8, (unsigned)__builtin_amdgcn_readfirstlane(lds0 + L_KD + slot * 8192 + (128 * ld + 64 * i) * 16)); }
    const size_t voff = (row0 + (lane >> 2)) * 512 + h * 128 + ld * 32 + (lane & 3) * 8;
#pragma unroll
    for (int p = 0; p < 4; ++p) { glds16(X.VA + voff + (size_t)p * 16 * 512, (unsigned)__builtin_amdgcn_readfirstlane(lds0 + L_V + slot * 16384 + ld * 4096 + p * 1024));
                                  glds16(X.RA + voff + (size_t)p * 16 * 512, (unsigned)__builtin_amdgcn_readfirstlane(lds0 + L_R + slot * 16384 + ld * 4096 + p * 1024)); }
}
__device__ __forceinline__ void store_chunk(const Ctx& X, LAS unsigned char* lds, int chunk, int h, int ld, int lane) {
    const size_t row0 = (size_t)chunk * 64; v4u v[4];
#pragma unroll
    for (int p = 0; p < 4; ++p) v[p] = *(const LAS v4u*)(lds + L_OST + ld * 4096 + p * 1024 + lane * 16);
    asm volatile("s_waitcnt lgkmcnt(0)" ::: "memory");
#pragma unroll
    for (int p = 0; p < 4; ++p) *(v4u*)(X.OC + (row0 + 16 * p + (lane >> 2)) * 1024 + h * 128 + ld * 32 + (lane & 3) * 8) = v[p];
}
__device__ __forceinline__ void step_a(LAS unsigned char* lds, int slot, int sl, int lane, f32x16 (&S)[2], f32x16 (&oT)[2]) {
    const int n32 = lane & 31, hi = lane >> 5;
    const LAS float* dsc = (const LAS float*)(lds + L_DEC + slot * 256);
#pragma unroll
    for (int dt = 0; dt < 2; ++dt)
#pragma unroll
        for (int g = 0; g < 4; ++g) { const f32x4 dv = *(const LAS f32x4*)(dsc + 32 * dt + 8 * g + 4 * hi);
#pragma unroll
            for (int j = 0; j < 4; ++j) S[dt][4 * g + j] *= dv[j]; }
    const lds_cptr kdp = (lds_cptr)lds + L_KD + slot * 8192, qp = (lds_cptr)lds + L_Q + slot * 8192;
    const lds_cptr vp = (lds_cptr)lds + L_V + slot * 16384 + sl * 4096 + ((lane >> 4) & 1) * 32 + (lane & 3) * 8 + (8 * hi + ((lane & 15) >> 2)) * 64;
#pragma unroll
    for (int s = 0; s < 4; ++s) { const s16x4 a0 = vtr(vp + s * 1024), a1 = vtr(vp + s * 1024 + 256);
        const bf16x8 vf = (bf16x8){a0[0], a0[1], a0[2], a0[3], a1[0], a1[1], a1[2], a1[3]};
#pragma unroll
        for (int dt = 0; dt < 2; ++dt) { const int d = 32 * dt + n32; const bf16x8 kf = *(const __attribute__((address_space(3))) bf16x8*)(kdp + d * 128 + (((2 * s + hi) ^ (d & 7)) << 4));
            S[dt] = __builtin_amdgcn_mfma_f32_32x32x16_bf16(kf, vf, S[dt], 0, 0, 0); } }
    v4u sa[2][2];
#pragma unroll
    for (int dt = 0; dt < 2; ++dt)
#pragma unroll
        for (int s = 0; s < 2; ++s)
#pragma unroll
            for (int i = 0; i < 4; ++i) sa[dt][s][i] = cvtpk(S[dt][8 * s + 2 * i], S[dt][8 * s + 2 * i + 1]);
#pragma unroll
    for (int tn = 0; tn < 2; ++tn) { const int t = 32 * tn + n32;
#pragma unroll
        for (int r = 0; r < 16; ++r) oT[tn][r] = 0.f;
#pragma unroll
        for (int dt = 0; dt < 2; ++dt)
#pragma unroll
            for (int s = 0; s < 2; ++s) { const int c0 = 4 * dt + 2 * s;
                const v2u q0 = *(const __attribute__((address_space(3))) v2u*)(qp + t * 128 + ((c0 ^ (t & 7)) << 4) + 8 * hi), q1 = *(const __attribute__((address_space(3))) v2u*)(qp + t * 128 + (((c0 + 1) ^ (t & 7)) << 4) + 8 * hi);
                const v4u qq = (v4u){q0[0], q0[1], q1[0], q1[1]};
                oT[tn] = __builtin_amdgcn_mfma_f32_32x32x16_bf16(__builtin_bit_cast(bf16x8, sa[dt][s]), __builtin_bit_cast(bf16x8, qq), oT[tn], 0, 0, 0); } }
    LAS float* red = (LAS float*)(lds + L_RED) + slot * 256;
#pragma unroll
    for (int tn = 0; tn < 2; ++tn) { float ss = 0.f;
#pragma unroll
        for (int r = 0; r < 16; ++r) ss += oT[tn][r] * oT[tn][r];
        { auto rr = __builtin_amdgcn_permlane32_swap(__float_as_uint(ss), __float_as_uint(ss), false, false); ss = __uint_as_float(rr[0]) + __uint_as_float(rr[1]); }
        if (hi == 0) red[sl * 64 + 32 * tn + n32] = ss; }
}
__device__ __forceinline__ void step_b(LAS unsigned char* lds, int slot, int sl, int lane, const f32x16 (&oT)[2], const float (&gg)[16]) {
    const int n32 = lane & 31, hi = lane >> 5;
    const LAS float* red = (const LAS float*)(lds + L_RED) + slot * 256;
#pragma unroll
    for (int tn = 0; tn < 2; ++tn) { const int t = 32 * tn + n32;
        const float tot = (red[t] + red[64 + t]) + (red[128 + t] + red[192 + t]);
        const float rs = 1.0f / sqrtf(tot * (1.0f / 128.0f) + EPS);
        const int toff = sl * 4096 + (t >> 4) * 1024 + (t & 15) * 64 + 8 * hi;
#pragma unroll
        for (int g = 0; g < 4; ++g) { const v2u rw = *(const LAS v2u*)(lds + L_R + slot * 16384 + toff + 16 * g);
            const float y0 = oT[tn][4 * g] * rs * gg[4 * g] * bflo(rw[0]), y1 = oT[tn][4 * g + 1] * rs * gg[4 * g + 1] * bfhi(rw[0]);
            const float y2 = oT[tn][4 * g + 2] * rs * gg[4 * g + 2] * bflo(rw[1]), y3 = oT[tn][4 * g + 3] * rs * gg[4 * g + 3] * bfhi(rw[1]);
            v2u w; w[0] = cvtpk(y0, y1); w[1] = cvtpk(y2, y3); *(LAS v2u*)(lds + L_OST + toff + 16 * g) = w; } }
}
}

__device__ __forceinline__ void gla_scan_mfma(Frame& F, const Args& A) {
    if (F.vcu >= 64) return;
    const gla::Ctx X{WSP(bf16, WS_KDT), WSP(float, WS_DEC), WSP(bf16, WS_QA), WSP(bf16, WS_VA), WSP(bf16, WS_RA), WSP(bf16, WS_OCAT)};
    const int wid = F.wave, lane = F.lane, hi = lane >> 5;
    const int bh = F.vcu, b = bh >> 2, h = bh & 3, c0 = b * NCH;
    const unsigned lds0 = (unsigned)(uintptr_t)F.lds;
    __syncthreads();
    if (wid >= 4) {
        const int ld = wid - 4;
        gla::load_chunk(X, lds0, c0, h, ld, lane, 0);
        float dv = X.DEC[(size_t)c0 * 256 + h * 64 + lane];
        asm volatile("s_waitcnt vmcnt(0)" ::: "memory");
        if (ld == 0) ((LAS float*)(F.lds + gla::L_DEC))[lane] = dv;
        for (int c = 0; c < NCH; ++c) {
            GLA_BAR();
            if (c + 1 < NCH) { gla::load_chunk(X, lds0, c0 + c + 1, h, ld, lane, (c + 1) & 1); dv = X.DEC[(size_t)(c0 + c + 1) * 256 + h * 64 + lane]; }
            if (c > 0) gla::store_chunk(X, F.lds, c0 + c - 1, h, ld, lane);
            GLA_BAR();
            asm volatile("s_waitcnt vmcnt(0)" ::: "memory");
            if (ld == 0 && c + 1 < NCH) ((LAS float*)(F.lds + gla::L_DEC + ((c + 1) & 1) * 256))[lane] = dv;
        }
        GLA_BAR();
        gla::store_chunk(X, F.lds, c0 + NCH - 1, h, ld, lane);
    } else {
        const int sl = wid;
        float gg[16];
#pragma unroll
        for (int r = 0; r < 16; ++r) gg[r] = A.in[IN_GGLA][sl * 32 + (r & 3) + 8 * (r >> 2) + 4 * hi];
        f32x16 S[2], oT[2];
#pragma unroll
        for (int r = 0; r < 16; ++r) { S[0][r] = 0.f; S[1][r] = 0.f; }
        for (int c = 0; c < NCH; ++c) {
            GLA_BAR();
            gla::step_a(F.lds, c & 1, sl, lane, S, oT);
            GLA_BAR();
            gla::step_b(F.lds, c & 1, sl, lane, oT, gg);
        }
        GLA_BAR();
    }
    __syncthreads();
}
__device__ __forceinline__ unsigned f2key(float f) { const unsigned u = __builtin_bit_cast(unsigned, f + 0.0f);     return u ^ ((u >> 31) ? 0xffffffffu : 0x80000000u); }
template <int NREG>
__device__ __forceinline__ unsigned long long radix_select(const unsigned (&key)[NREG], int lane) {
    unsigned prefix = 0u; bool exact = false;
    for (int bit = 31; bit >= 0; --bit) {
        const unsigned cand = prefix | (1u << bit); int cnt = 0;
#pragma unroll
        for (int j = 0; j < NREG; ++j) cnt += __popcll(__ballot(key[j] >= cand));
        if (cnt >= 256) { prefix = cand; if (cnt == 256) { exact = true; break; } }
    }
    int mlo = 0, mhi = 0;
    int cgt = 0;
#pragma unroll
    for (int j = 0; j < NREG; ++j) cgt += __popcll(__ballot(key[j] > prefix));
    int rem = exact ? 0 : 256 - cgt;
#pragma unroll
    for (int j = 0; j < NREG; ++j) {
        const unsigned long long gt = __ballot(exact ? key[j] >= prefix : key[j] > prefix), eq = exact ? 0ull : __ballot(key[j] == prefix);
        unsigned long long w = gt;
        if (eq != 0ull && rem > 0) {
            const int c = __popcll(eq);
            if (c <= rem) { w |= eq; rem -= c; }
            else { const int rank = __popcll(eq & ((1ull << lane) - 1ull)); w |= __ballot(((eq >> lane) & 1ull) && rank < rem); rem = 0; }
        }
        asm volatile("s_nop 4\n\tv_writelane_b32 %0, %2, %4\n\tv_writelane_b32 %1, %3, %4" : "+v"(mlo), "+v"(mhi) : "s"((unsigned)w), "s"((unsigned)(w >> 32)), "i"(j));
    }
    return ((unsigned long long)(unsigned)mhi << 32) | (unsigned)mlo;
}
#define DPP_STEP_U(x, ctrl, rmask) __builtin_amdgcn_update_dpp(0, (int)(x), ctrl, rmask, 0xf, false)
__device__ __forceinline__ unsigned dpp_scan_add(unsigned x) {
    x += (unsigned)DPP_STEP_U(x, 0x111, 0xf); x += (unsigned)DPP_STEP_U(x, 0x112, 0xf); x += (unsigned)DPP_STEP_U(x, 0x114, 0xf); x += (unsigned)DPP_STEP_U(x, 0x118, 0xf);
    x += (unsigned)DPP_STEP_U(x, 0x142, 0xa); x += (unsigned)DPP_STEP_U(x, 0x143, 0xc); return x; }
#define DPP_STEP_F(x, ctrl, rmask) __builtin_bit_cast(float, __builtin_amdgcn_update_dpp((int)0xff800000, __builtin_bit_cast(int, (x)), ctrl, rmask, 0xf, false))
__device__ __forceinline__ float dpp_wave_max(float x) {
    x = fmaxf(x, DPP_STEP_F(x, 0x111, 0xf)); x = fmaxf(x, DPP_STEP_F(x, 0x112, 0xf)); x = fmaxf(x, DPP_STEP_F(x, 0x114, 0xf)); x = fmaxf(x, DPP_STEP_F(x, 0x118, 0xf));
    x = fmaxf(x, DPP_STEP_F(x, 0x142, 0xa)); x = fmaxf(x, DPP_STEP_F(x, 0x143, 0xc));
    return __builtin_bit_cast(float, __builtin_amdgcn_readlane(__builtin_bit_cast(int, x), 63)); }
__device__ __forceinline__ float rl_f(float v, int l) { return __builtin_bit_cast(float, __builtin_amdgcn_readlane(__builtin_bit_cast(int, v), l)); }
__device__ __forceinline__ int rl_i(int v, int l) { return __builtin_amdgcn_readlane(v, l); }
template <int NREG>
__device__ __forceinline__ unsigned long long select_hist(LAS float* sc, int nr_, int lane) {
    const int nr = __builtin_amdgcn_readfirstlane(nr_);
    float s[NREG]; float lo = INFINITY, hi = -INFINITY;
#pragma unroll
    for (int j = 0; j < NREG; ++j) { if (j < NREG - 7 || j < nr) { s[j] = sc[j * 64 + lane]; lo = fminf(lo, s[j]); hi = fmaxf(hi, s[j]); } else s[j] = -INFINITY; }
    hi = dpp_wave_max(hi); lo = -dpp_wave_max(-lo);
    float c1 = 4095.0f / fmaxf(hi - lo, 1e-30f), c0 = -lo * c1;
    LAS unsigned* hist = (LAS unsigned*)sc;
    asm volatile("s_waitcnt lgkmcnt(0)" ::: "memory");
#pragma unroll
    for (int k = 0; k < 16; ++k) *(LAS v4u*)(hist + k * 256 + lane * 4) = (v4u){0u, 0u, 0u, 0u};
    asm volatile("s_waitcnt lgkmcnt(0)" ::: "memory");
#define SEL_BIN(v) ((int)__builtin_amdgcn_fmed3f(__builtin_fmaf((v), c1, c0), 0.0f, 4095.0f))
#pragma unroll
    for (int j = 0; j < NREG; ++j) { if (j < NREG - 7 || j < nr) (void)__hip_atomic_fetch_add(hist + SEL_BIN(s[j]), 1u, __ATOMIC_RELAXED, __HIP_MEMORY_SCOPE_WORKGROUP); }
    asm volatile("s_waitcnt lgkmcnt(0)" ::: "memory");
    unsigned tot = 0u;
#pragma unroll
    for (int k = 0; k < 16; ++k) { const v4u h4 = *(const LAS v4u*)(hist + lane * 64 + k * 4); tot += (h4[0] + h4[1]) + (h4[2] + h4[3]); }
    const unsigned pre = dpp_scan_add(tot); const unsigned all = (unsigned)rl_i((int)pre, 63);
    const unsigned suf = all - pre + tot;
    const unsigned above = suf - tot;
    const unsigned long long m1 = __ballot(above < 256u && suf >= 256u);
    const int Ls = __ffsll((long long)m1) - 1;
    const unsigned aboveL = (unsigned)rl_i((int)above, Ls);
    const unsigned hb = hist[Ls * 64 + lane];
    const unsigned pre2 = dpp_scan_add(hb); const unsigned suf2 = (unsigned)rl_i((int)pre2, 63) - pre2 + hb;
    const unsigned ab2 = aboveL + (suf2 - hb);
    const unsigned long long m2 = __ballot(ab2 < 256u && ab2 + hb >= 256u);
    const int ks = __ffsll((long long)m2) - 1;
    const int bstar = Ls * 64 + ks; const int cab = rl_i((int)ab2, ks); const int nc = rl_i((int)hb, ks); const int need = 256 - cab;
    if (nc > 64) {
        unsigned key[NREG];
#pragma unroll
        for (int j = 0; j < NREG; ++j) key[j] = (s[j] == -INFINITY) ? 0u : f2key(s[j]);
        return radix_select<NREG>(key, lane);
    }
    LAS float* cv = (LAS float*)(hist) ; LAS int* ci = (LAS int*)(hist + 64);
    asm volatile("s_waitcnt lgkmcnt(0)" ::: "memory");
    int base = 0;
    asm volatile("" : "+v"(c0), "+v"(c1));
#pragma unroll
    for (int j = 0; j < NREG; ++j) { if (j < NREG - 7 || j < nr) { const bool inb = SEL_BIN(s[j]) == bstar; const unsigned long long mk = __ballot(inb);
        if (mk) { if (inb) { const int p = base + __popcll(mk & ((1ull << lane) - 1ull)); cv[p] = s[j]; ci[p] = j * 64 + lane; } base += __popcll(mk); } } }
#undef SEL_BIN
    asm volatile("s_waitcnt lgkmcnt(0)" ::: "memory");
    const float myv = lane < nc ? cv[lane] : -INFINITY; const int myi = lane < nc ? ci[lane] : 0x7fffffff;
    int rank = 0;
    for (int k = 0; k < nc; ++k) { const float vk = rl_f(myv, k); const int ik = rl_i(myi, k); rank += (vk > myv || (vk == myv && ik < myi)) ? 1 : 0; }
    const unsigned long long m3 = __ballot(lane < nc && rank == need - 1);
    const int ts = __ffsll((long long)m3) - 1;
    const float vstar = rl_f(myv, ts); const int istar = rl_i(myi, ts);
    const int ties = __popcll(__ballot(lane < nc && myv == vstar));
    int mlo = 0, mhi = 0;
    if (ties == 1) {
#pragma unroll
        for (int j = 0; j < NREG; ++j) { const unsigned long long w = __ballot(s[j] >= vstar);
            asm volatile("s_nop 4\n\tv_writelane_b32 %0, %2, %4\n\tv_writelane_b32 %1, %3, %4" : "+v"(mlo), "+v"(mhi) : "s"((unsigned)w), "s"((unsigned)(w >> 32)), "i"(j)); }
    } else {
#pragma unroll
        for (int j = 0; j < NREG; ++j) { const int idx = j * 64 + lane; const unsigned long long w = __ballot(s[j] > vstar || (s[j] == vstar && idx <= istar));
            asm volatile("s_nop 4\n\tv_writelane_b32 %0, %2, %4\n\tv_writelane_b32 %1, %3, %4" : "+v"(mlo), "+v"(mhi) : "s"((unsigned)w), "s"((unsigned)(w >> 32)), "i"(j)); }
    }
    return ((unsigned long long)(unsigned)mhi << 32) | (unsigned)mlo;
}
__device__ __forceinline__ float dsa_relu(float x) { const int b = __builtin_bit_cast(int, x); return __builtin_bit_cast(float, b > 0 ? b : 0); }
__device__ __forceinline__ void dsa_select_mfma(Frame& F, const Args& A) {
    LAS float* sc = (LAS float*)F.lds;
    const bf16* QI = WSP(bf16, WS_QI); const bf16* KI = WSP(bf16, WS_KI); const float* WI = WSP(float, WS_WI);
    unsigned long long* MASK = WSP(unsigned long long, WS_MASK);
    const int lane = F.lane, n32 = lane & 31, hi = lane >> 5;
    const int qi_m = 2 * ((n32 >> 2) & 1) + (n32 >> 4), hd_m = (n32 & 3) + 4 * ((n32 >> 3) & 1);
    for (int u = F.vcu; u < 8192; u += F.G) {
        const int g = u & 7, rest = u >> 3, b = rest & 15, i = rest >> 4;
        const int N = (i + 1) * 64; const size_t seq0 = (size_t)b * SEQ; const size_t q0 = seq0 + (size_t)i * 64 + g * 8;
        if (i < 4) {
            const size_t r = q0 + F.wave; const int nw = N >> 6;
            MASK[r * 64 + lane] = (lane < nw) ? ~0ull : 0ull;
            continue;
        }
        bf16x8 aq[2][2]; f32x4 wv[2][4];
#pragma unroll
        for (int mt = 0; mt < 2; ++mt) {
#pragma unroll
            for (int s = 0; s < 2; ++s) aq[mt][s] = *(const bf16x8*)(QI + (q0 + 4 * mt + qi_m) * 256 + hd_m * 32 + 16 * s + 8 * hi);
#pragma unroll
            for (int c = 0; c < 4; ++c) wv[mt][c] = *(const f32x4*)(WI + (q0 + 4 * mt + 2 * hi) * 8 + 4 * c);
        }
        __syncthreads();
        const int nj = N / 32;
        bf16x8 nb0, nb1;
        { const int key = 32 * F.wave + n32; nb0 = *(const bf16x8*)(KI + (seq0 + key) * 32 + 8 * hi); nb1 = *(const bf16x8*)(KI + (seq0 + key) * 32 + 16 + 8 * hi); }
        for (int j = F.wave; j < nj; j += 8) {
            const int key = 32 * j + n32;
            const bf16x8 bk0 = nb0, bk1 = nb1;
            { const int jn = (j + 8 < nj) ? j + 8 : j; const int kn = 32 * jn + n32; nb0 = *(const bf16x8*)(KI + (seq0 + kn) * 32 + 8 * hi); nb1 = *(const bf16x8*)(KI + (seq0 + kn) * 32 + 16 + 8 * hi); }
            f32x16 a0, a1;
#pragma unroll
            for (int r = 0; r < 16; ++r) { a0[r] = 0.f; a1[r] = 0.f; }
            a0 = __builtin_amdgcn_mfma_f32_32x32x16_bf16(aq[0][0], bk0, a0, 0, 0, 0); a0 = __builtin_amdgcn_mfma_f32_32x32x16_bf16(aq[0][1], bk1, a0, 0, 0, 0);
            a1 = __builtin_amdgcn_mfma_f32_32x32x16_bf16(aq[1][0], bk0, a1, 0, 0, 0); a1 = __builtin_amdgcn_mfma_f32_32x32x16_bf16(aq[1][1], bk1, a1, 0, 0, 0);
            float s00 = 0.f, s01 = 0.f, s10 = 0.f, s11 = 0.f;
#pragma unroll
            for (int r = 0; r < 8; ++r) { s00 += wv[0][r >> 2][r & 3] * dsa_relu(a0[r]); s01 += wv[0][2 + (r >> 2)][r & 3] * dsa_relu(a0[8 + r]);
                                          s10 += wv[1][r >> 2][r & 3] * dsa_relu(a1[r]); s11 += wv[1][2 + (r >> 2)][r & 3] * dsa_relu(a1[8 + r]); }
            sc[(2 * hi) * 4096 + key] = s00 + 0.0f; sc[(2 * hi + 1) * 4096 + key] = s01 + 0.0f; sc[(4 + 2 * hi) * 4096 + key] = s10 + 0.0f; sc[(5 + 2 * hi) * 4096 + key] = s11 + 0.0f;
        }
        __syncthreads();
        unsigned long long w;
        LAS float* my = sc + F.wave * 4096;
        switch ((i + 8) >> 3) {
            case 1: w = select_hist<8>(my, i + 1, lane); break;
            case 2: w = select_hist<16>(my, i + 1, lane); break;
            case 3: w = select_hist<24>(my, i + 1, lane); break;
            case 4: w = select_hist<32>(my, i + 1, lane); break;
            case 5: w = select_hist<40>(my, i + 1, lane); break;
            case 6: w = select_hist<48>(my, i + 1, lane); break;
            case 7: w = select_hist<56>(my, i + 1, lane); break;
            default: w = select_hist<64>(my, i + 1, lane); break;
        }
        MASK[(q0 + F.wave) * 64 + lane] = w;
    }
    __syncthreads();
}

__device__ __forceinline__ int t5_bucket(int rel) {
    const int n = rel < 0 ? -rel : rel;
    const int v = n < 8 ? n : 8 + (n >= 12) + (n >= 16) + (n >= 23) + (n >= 32) + (n >= 46) + (n >= 64) + (n >= 91);
    return (rel > 0 ? 16 : 0) + v;
}
namespace att {
using s16x4 = __attribute__((ext_vector_type(4))) short;
typedef short v4i16_t __attribute__((ext_vector_type(4)));
constexpr int SLOTB = 8192, LDS_K = 0  , LDS_V = 4 * SLOTB  , LDS_TBL = 6 * SLOTB  , LDS_WS = LDS_TBL + 8 * 2048, LDS_OST = LDS_WS + 8 * 64 * 4, LDS_Q = LDS_OST + 8 * 4096  , LDS_END = LDS_Q + 16;
__device__ __forceinline__ int crow(int r, int hi) { return (r & 3) + 8 * (r >> 2) + 4 * hi; }
__device__ __forceinline__ void glds16(const void* gsrc, unsigned lds_dst) { unsigned keep;
    asm volatile("s_mov_b32 %0, m0\n\ts_mov_b32 m0, %2\n\ts_nop 0\n\tglobal_load_lds_dwordx4 %1, off\n\ts_mov_b32 m0, %0" : "=&s"(keep) : "v"(gsrc), "s"(lds_dst) : "memory"); }
__device__ __forceinline__ void gload8(unsigned long long& dst, const void* gsrc) { asm volatile("global_load_dwordx2 %0, %1, off" : "=v"(dst) : "v"(gsrc) : "memory"); }
typedef __attribute__((address_space(3))) const char* lds_cptr;
__device__ __forceinline__ s16x4 vtr(lds_cptr p) { return __builtin_bit_cast(s16x4, __builtin_amdgcn_ds_read_tr16_b64_v4i16((__attribute__((address_space(3))) v4i16_t*)p)); }
__device__ __forceinline__ unsigned cvtpk(float lo, float hi) { return pg8::cvt_pk_bf16(lo, hi); }

__device__ __forceinline__ void tile_qk(f32x16& p0, f32x16& p1, const bf16x8 (&qr)[4], lds_cptr kb, float cinit) {
#pragma unroll
    for (int r = 0; r < 16; ++r) { p0[r] = cinit; p1[r] = cinit; }
#pragma unroll
    for (int d0 = 0; d0 < 4; ++d0) {
        const bf16x8 b0 = *(const __attribute__((address_space(3))) bf16x8*)(kb + d0 * 2048);
        const bf16x8 b1 = *(const __attribute__((address_space(3))) bf16x8*)(kb + d0 * 2048 + 512);
        p0 = __builtin_amdgcn_mfma_f32_32x32x16_bf16(b0, qr[d0], p0, 0, 0, 0);
        p1 = __builtin_amdgcn_mfma_f32_32x32x16_bf16(b1, qr[d0], p1, 0, 0, 0);
    }
}
template <bool NEAR>
__device__ __forceinline__ void tile_sm_pv(f32x16& o0, f32x16& o1, float& l, f32x16& p0, f32x16& p1, lds_cptr vp, unsigned long long wcur, int hi, const LAS float* tb) {
    const unsigned wl = (unsigned)wcur >> (4 * hi), wh = (unsigned)(wcur >> 32) >> (4 * hi);
    float ls = 0.f;
#define ATT_SM_ELEM(r) do { constexpr int bp = ((r) & 3) + 8 * ((r) >> 2); float a = p0[r], b = p1[r]; \
        if (NEAR) { a += tb[bp]; b += tb[32 + bp]; } \
        a = __builtin_amdgcn_exp2f(a); b = __builtin_amdgcn_exp2f(b); \
        int m0, m1; asm("v_bfe_i32 %0, %1, %2, 1" : "=v"(m0) : "v"(wl), "n"(bp)); asm("v_bfe_i32 %0, %1, %2, 1" : "=v"(m1) : "v"(wh), "n"(bp)); \
        a = __builtin_bit_cast(float, __builtin_bit_cast(unsigned, a) & (unsigned)m0); b = __builtin_bit_cast(float, __builtin_bit_cast(unsigned, b) & (unsigned)m1); \
        p0[r] = a; p1[r] = b; ls += a + b; } while (0)
    ATT_SM_ELEM(0); ATT_SM_ELEM(1); ATT_SM_ELEM(2); ATT_SM_ELEM(3); ATT_SM_ELEM(4); ATT_SM_ELEM(5); ATT_SM_ELEM(6); ATT_SM_ELEM(7);
    ATT_SM_ELEM(8); ATT_SM_ELEM(9); ATT_SM_ELEM(10); ATT_SM_ELEM(11); ATT_SM_ELEM(12); ATT_SM_ELEM(13); ATT_SM_ELEM(14); ATT_SM_ELEM(15);
#undef ATT_SM_ELEM
    l += ls;
    v4u pw[4];
#pragma unroll
    for (int i = 0; i < 4; ++i) { pw[0][i] = cvtpk(p0[2 * i], p0[2 * i + 1]); pw[1][i] = cvtpk(p0[8 + 2 * i], p0[9 + 2 * i]); pw[2][i] = cvtpk(p1[2 * i], p1[2 * i + 1]); pw[3][i] = cvtpk(p1[8 + 2 * i], p1[9 + 2 * i]); }
#pragma unroll
    for (int ks = 0; ks < 4; ++ks) {
        const s16x4 a0 = vtr(vp + ks * 1024), a1 = vtr(vp + ks * 1024 + 512), c0 = vtr(vp + 4096 + ks * 1024), c1 = vtr(vp + 4096 + ks * 1024 + 512);
        const bf16x8 v0 = (bf16x8){a0[0], a0[1], a0[2], a0[3], a1[0], a1[1], a1[2], a1[3]}, v1 = (bf16x8){c0[0], c0[1], c0[2], c0[3], c1[0], c1[1], c1[2], c1[3]};
        const bf16x8 pa = __builtin_bit_cast(bf16x8, pw[ks]);
        o0 = __builtin_amdgcn_mfma_f32_32x32x16_bf16(pa, v0, o0, 0, 0, 0);
        o1 = __builtin_amdgcn_mfma_f32_32x32x16_bf16(pa, v1, o1, 0, 0, 0);
    }
}

__device__ __forceinline__ void attn_unit(LAS unsigned char* lds, int b, int h, int qb, float cfar, float cnear, const bf16* QB, const bf16* KB, const bf16* VB, const unsigned long long* MASK, bf16* OC) {
    const int tid = threadIdx.x, lane = tid & 63, r32 = lane & 31, hi = lane >> 5; const int wid = __builtin_amdgcn_readfirstlane(tid >> 6);
    const size_t rowbase = (size_t)b * SEQ; const int q0 = qb * 256; const int myq = q0 + wid * 32 + r32;
    const bf16* Qw = QB + (rowbase + myq) * 512 + h * 64;
    const bf16* ksrc = KB + (rowbase + lane) * 512 + h * 64 + wid * 8;
    const bf16* vsrc = VB + (rowbase + 16 * (wid & 3) + (lane >> 2)) * 512 + h * 64 + (wid >> 2) * 32 + (lane & 3) * 8;
    const unsigned long long* msrc = MASK + (rowbase + myq) * 64;
    const unsigned lds0 = (unsigned)(uintptr_t)lds;
    const unsigned kdst = lds0 + LDS_K + wid * 1024, vdst = lds0 + LDS_V + wid * 1024;
    const lds_cptr l3 = (lds_cptr)lds;
    const lds_cptr kb0 = l3 + LDS_K + hi * 1024 + r32 * 16;
    const lds_cptr vp0 = l3 + LDS_V + ((lane >> 4) & 1) * 32 + (lane & 3) * 8 + (4 * hi + ((lane & 15) >> 2)) * 64;
    const LAS float* tbl = (const LAS float*)(lds + LDS_TBL) + h * 512;
    LAS float* wsf = (LAS float*)(lds + LDS_WS) + wid * 64;
    const int NT = 4 * (qb + 1);
    const int nfar_ = (q0 + 32 * wid - 154 >= 0) ? ((q0 + 32 * wid - 154) >> 6) + 1 : 0; const int nfar = nfar_ < NT ? nfar_ : NT;
    bf16x8 qr[4];
#pragma unroll
    for (int d0 = 0; d0 < 4; ++d0) qr[d0] = *(const bf16x8*)(Qw + d0 * 16 + hi * 8);
    f32x16 o0, o1;
#pragma unroll
    for (int r = 0; r < 16; ++r) { o0[r] = 0.f; o1[r] = 0.f; }
    float l = 0.f;
    unsigned long long wA, wB;
    const unsigned kd0 = (unsigned)__builtin_amdgcn_readfirstlane(kdst), vd0 = (unsigned)__builtin_amdgcn_readfirstlane(vdst);
#define ATT_WAITBAR(w) asm volatile("s_waitcnt vmcnt(0) lgkmcnt(0)\n\ts_barrier" : "+v"(w) :: "memory")
#define ATT_DMA_K(tt) glds16(ksrc + (size_t)(tt) * 64 * 512, kd0 + ((tt) & 3) * SLOTB)
#define ATT_DMA_V(tt) glds16(vsrc + (size_t)(tt) * 64 * 512, vd0 + ((tt) & 1) * SLOTB)
#define ATT_CINIT(tt) (((tt) < nfar) ? cfar : cnear)
#define ATT_SMPV(tt, P0, P1, w) do { if ((tt) < nfar) tile_sm_pv<false>(o0, o1, l, P0, P1, vp0 + ((tt) & 1) * SLOTB, w, hi, tbl); \
        else tile_sm_pv<true>(o0, o1, l, P0, P1, vp0 + ((tt) & 1) * SLOTB, w, hi, tbl + ((tt) * 64 + 4 * hi - myq + 447)); } while (0)
    f32x16 sA0, sA1, sB0, sB1;
    ATT_DMA_K(0); ATT_DMA_V(0); gload8(wA, msrc); ATT_DMA_K(1);
    ATT_WAITBAR(wA);
    tile_qk(sA0, sA1, qr, kb0, ATT_CINIT(0));
    for (int t = 0; t < NT; t += 2) {
        if (t > 0) ATT_WAITBAR(wA);
        if (t + 2 < NT) ATT_DMA_K(t + 2);
        ATT_DMA_V(t + 1); gload8(wB, msrc + (t + 1));
        tile_qk(sB0, sB1, qr, kb0 + ((t + 1) & 3) * SLOTB, ATT_CINIT(t + 1));
        ATT_SMPV(t, sA0, sA1, wA);
        ATT_WAITBAR(wB);
        if (t + 3 < NT) ATT_DMA_K(t + 3);
        if (t + 2 < NT) { ATT_DMA_V(t + 2); gload8(wA, msrc + (t + 2)); tile_qk(sA0, sA1, qr, kb0 + ((t + 2) & 3) * SLOTB, ATT_CINIT(t + 2)); }
        ATT_SMPV(t + 1, sB0, sB1, wB);
    }
#undef ATT_WAITBAR
#undef ATT_DMA_K
#undef ATT_DMA_V
#undef ATT_CINIT
#undef ATT_SMPV
    { auto rr = __builtin_amdgcn_permlane32_swap(__float_as_uint(l), __float_as_uint(l), false, false); l = __uint_as_float(rr[0]) + __uint_as_float(rr[1]); }
    if (hi == 0) wsf[32 + r32] = l; asm volatile("s_waitcnt lgkmcnt(0)" ::: "memory");
    float rli[16];
#pragma unroll
    for (int r = 0; r < 16; ++r) rli[r] = __builtin_amdgcn_rcpf(wsf[32 + crow(r, hi)]);
    bf16* Ow = OC + (rowbase + q0 + wid * 32) * 1024 + 512 + h * 64;
    { LAS bf16* stg = (LAS bf16*)(lds + LDS_OST) + wid * 2048;
#pragma unroll
      for (int r = 0; r < 16; ++r) { const int orow = crow(r, hi); stg[orow * 64 + r32] = (bf16)f2bf(o0[r] * rli[r]); stg[orow * 64 + 32 + r32] = (bf16)f2bf(o1[r] * rli[r]); }
      asm volatile("s_waitcnt lgkmcnt(0)" ::: "memory");
#pragma unroll
      for (int i = 0; i < 4; ++i) { const int row = i * 8 + (lane >> 3), ch = lane & 7; const v4u v = *(const LAS v4u*)(stg + row * 64 + ch * 8); *(v4u*)(Ow + (size_t)row * 1024 + ch * 8) = v; } }
    asm volatile("s_waitcnt lgkmcnt(0)\n\ts_barrier" ::: "memory");
}
}

__device__ __forceinline__ void dsa_attn_mfma(Frame& F, const Args& A) {
    LAS float* tbl = (LAS float*)(F.lds + att::LDS_TBL);
    volatile LAS int* qw = (volatile LAS int*)(F.lds + att::LDS_Q);
    const bf16* QB = WSP(bf16, WS_QB); const bf16* KB = WSP(bf16, WS_KB); const bf16* VB = WSP(bf16, WS_VB);
    const unsigned long long* MASK = WSP(unsigned long long, WS_MASK); bf16* OC = WSP(bf16, WS_OCAT);
    const float* relb = A.in[IN_RELB];
    float mq = 0.f, mk = 0.f, mb = 0.f;
    { mq = fabsf(A.in[IN_GQ][F.lane]); mk = fabsf(A.in[IN_GK][F.lane]); mb = fmaxf(fmaxf(fabsf(relb[F.lane]), fabsf(relb[64 + F.lane])), fmaxf(fabsf(relb[128 + F.lane]), fabsf(relb[192 + F.lane])));
      mq = wave_max(mq); mk = wave_max(mk); mb = wave_max(mb); }
    const float ref = 8.0f * LOG2E * mq * mk + LOG2E * mb;
    __syncthreads();
    for (int i = F.tid; i < 8 * 512; i += 512) { const int hh = i >> 9, j = i & 511; tbl[i] = (j < 511) ? relb[t5_bucket(j - 447) * 8 + hh] * LOG2E : 0.f; }
    __syncthreads();
    gu32* qctr = F.ctl + CW_ATTQ;
    for (;;) {
        if (F.tid == 0) qw[0] = (int)__hip_atomic_fetch_add(qctr, 1u, RLX_AGENT);
        __syncthreads();
        const int u = qw[0];
        __syncthreads();
        if (u >= 2048) break;
        const int qb = 15 - (u >> 7), bh = u & 127, b = bh >> 3, h = bh & 7;
        const float cnear = -ref, cfar = -ref + relb[15 * 8 + h] * LOG2E;
        att::attn_unit(F.lds, b, h, qb, cfar, cnear, QB, KB, VB, MASK, OC);
    }
    __syncthreads();
}
__device__ __forceinline__ void moe_route_mfma(Frame& F, const Args& A) {
    const bf16* XB = WSP(bf16, WS_H2); const bf16* WRH = WSP(bf16, WS_WR); const bf16* WRL = WRH + 64 * D;
    unsigned* ME = WSP(unsigned, WS_META); float* MC = (float*)(F.ws + WS_META + 512 * 1024); float* MRS = WSP(float, WS_MRS);
    const int lane = F.lane, n32 = lane & 31, hi = lane >> 5;
    LAS float* lg = (LAS float*)F.lds + F.wave * 2048;
    LAS int* lcnt = (LAS int*)(F.lds + XTRA_OFF); LAS int* lbase = lcnt + 128; int* POSC = (int*)(F.ws + WS_META + 256 * 1024);
    if (F.tid < 128) lcnt[F.tid] = 0;
    LAS unsigned char* wl = F.lds + RING_OFF; constexpr int WPITCH = 2048;
    for (int tile = F.vcu * NWAVES + F.wave; tile < M / 32; tile += F.G * NWAVES) {
        __syncthreads();
#pragma unroll 4
        for (int i = 0; i < 16; ++i) { const int p = F.tid + 512 * i, row = p >> 7, c16 = p & 127;
            const v4u v = *(const GAS v4u*)((row < 32 ? WRH + (size_t)row * D : WRL + (size_t)(row - 32) * D) + 8 * c16);
            *(LAS v4u*)(wl + row * WPITCH + 16 * (c16 ^ (row & 7))) = v; }
        __syncthreads();
        const size_t t0 = (size_t)tile * 32;
        const bf16* xp = XB + (t0 + n32) * D + 8 * hi;
        const bf16* bh = WRH + (size_t)n32 * D + 8 * hi; const bf16* bl = WRL + (size_t)n32 * D + 8 * hi;
        f32x16 acc0, acc1;
#pragma unroll
        for (int r = 0; r < 16; ++r) { acc0[r] = 0.f; acc1[r] = 0.f; }
        float ss = 0.f;
        float ra; { const unsigned* sl = WSP(const unsigned, WS_SLOT2) + ((t0 + n32) >> 8) * 1024 + ((t0 + n32) & 255);
            ra = fmaxf(fmaxf(__builtin_bit_cast(float, sl[0]), __builtin_bit_cast(float, sl[256])), fmaxf(__builtin_bit_cast(float, sl[512]), __builtin_bit_cast(float, sl[768]))); }
        const float qinv = ra > 0.f ? 127.0f / ra : 0.f;
        if (hi == 0) WSP(float, WS_XS8)[t0 + n32] = ra * (1.0f / 127.0f);
        unsigned char* x8 = F.ws + WS_XB8 + (t0 + n32) * D + 16 * hi; v4u q8;
        v4u xs[4]; bf16x8 wq[4][4];
#define RT_LOAD(sl, s) do { xs[sl] = *(const v4u*)(xp + 16 * (s)); \
                            wq[sl][1] = (bf16x8){0, 0, 0, 0, 0, 0, 0, 0}; wq[sl][3] = (bf16x8){0, 0, 0, 0, 0, 0, 0, 0}; \
                            if (n32 < 4) { wq[sl][1] = *(const bf16x8*)(bh + 32 * D + 16 * (s)); wq[sl][3] = *(const bf16x8*)(bl + 32 * D + 16 * (s)); } } while (0)
        RT_LOAD(0, 0); RT_LOAD(1, 1); RT_LOAD(2, 2);
        for (int s4 = 0; s4 < 64; s4 += 4) {
#pragma unroll
            for (int u4 = 0; u4 < 4; ++u4) { const int s = s4 + u4;
                if (s + 3 < 64) RT_LOAD((u4 + 3) & 3, s + 3);
                asm volatile("" ::: "memory");
                const v4u xw = xs[u4];
                {
                    unsigned b0 = 0u, b1 = 0u;
                    b0 = __builtin_amdgcn_cvt_pk_u8_f32(__builtin_rintf(__builtin_fmaf(bflo(xw[0]), qinv, 128.0f)), 0, b0); b0 = __builtin_amdgcn_cvt_pk_u8_f32(__builtin_rintf(__builtin_fmaf(bfhi(xw[0]), qinv, 128.0f)), 1, b0);
                    b0 = __builtin_amdgcn_cvt_pk_u8_f32(__builtin_rintf(__builtin_fmaf(bflo(xw[1]), qinv, 128.0f)), 2, b0); b0 = __builtin_amdgcn_cvt_pk_u8_f32(__builtin_rintf(__builtin_fmaf(bfhi(xw[1]), qinv, 128.0f)), 3, b0);
                    b1 = __builtin_amdgcn_cvt_pk_u8_f32(__builtin_rintf(__builtin_fmaf(bflo(xw[2]), qinv, 128.0f)), 0, b1); b1 = __builtin_amdgcn_cvt_pk_u8_f32(__builtin_rintf(__builtin_fmaf(bfhi(xw[2]), qinv, 128.0f)), 1, b1);
                    b1 = __builtin_amdgcn_cvt_pk_u8_f32(__builtin_rintf(__builtin_fmaf(bflo(xw[3]), qinv, 128.0f)), 2, b1); b1 = __builtin_amdgcn_cvt_pk_u8_f32(__builtin_rintf(__builtin_fmaf(bfhi(xw[3]), qinv, 128.0f)), 3, b1);
                    if ((u4 & 1) == 0) { q8.x = b0 ^ 0x80808080u; q8.y = b1 ^ 0x80808080u; } else { q8.z = b0 ^ 0x80808080u; q8.w = b1 ^ 0x80808080u; *(v4u*)(x8 + 32 * (s >> 1)) = q8; } }
#pragma unroll
                for (int j = 0; j < 4; ++j) { const float a = bflo(xw[j]), b = bfhi(xw[j]); ss += a * a + b * b; }
                const bf16x8 Ah = __builtin_bit_cast(bf16x8, xw);
                const bf16x8 w0h = *(const LAS bf16x8*)(wl + n32 * WPITCH + 16 * ((2 * s + hi) ^ (n32 & 7))), w0l = *(const LAS bf16x8*)(wl + (32 + n32) * WPITCH + 16 * ((2 * s + hi) ^ (n32 & 7)));
                acc0 = __builtin_amdgcn_mfma_f32_32x32x16_bf16(Ah, w0h, acc0, 0, 0, 0); acc1 = __builtin_amdgcn_mfma_f32_32x32x16_bf16(Ah, wq[u4][1], acc1, 0, 0, 0);
                acc0 = __builtin_amdgcn_mfma_f32_32x32x16_bf16(Ah, w0l, acc0, 0, 0, 0); acc1 = __builtin_amdgcn_mfma_f32_32x32x16_bf16(Ah, wq[u4][3], acc1, 0, 0, 0);
            }
        }
#undef RT_LOAD
        ss += __shfl_xor(ss, 32);
        const float rs = 1.0f / sqrtf(ss * (1.f / D) + EPS);
        __syncthreads();
#pragma unroll
        for (int r = 0; r < 16; ++r) { const int tk = (r & 3) + 8 * (r >> 2) + 4 * hi; lg[tk * 64 + n32] = acc0[r]; lg[tk * 64 + 32 + n32] = acc1[r]; }
        LDS_WAIT(); asm volatile("" ::: "memory");
        if (hi == 0) {
            const size_t r = t0 + n32; const LAS float* my = lg + n32 * 64;
            float gl[4];
#pragma unroll
            for (int c = 0; c < 4; ++c) gl[c] = my[c] * rs + A.in[IN_BRG][c];
            int gs = 0; float gm = gl[0];
#pragma unroll
            for (int c = 1; c < 4; ++c) if (gl[c] > gm) { gm = gl[c]; gs = c; }
            float den = 0.f;
#pragma unroll
            for (int c = 0; c < 4; ++c) den += __expf(gl[c] - gm);
            const float gw = 1.0f / den;
            float el[8];
#pragma unroll
            for (int c = 0; c < 8; ++c) el[c] = my[4 + gs * 8 + c] * rs + A.in[IN_BRE][gs * 8 + c];
            int i0 = 0; float v0 = el[0];
#pragma unroll
            for (int c = 1; c < 8; ++c) if (el[c] > v0) { v0 = el[c]; i0 = c; }
            int i1 = -1; float v1 = -INFINITY;
#pragma unroll
            for (int c = 0; c < 8; ++c) if (c != i0 && el[c] > v1) { v1 = el[c]; i1 = c; }
            const float p1 = 1.0f / (1.0f + __expf(v0 - v1)), p0 = 1.0f - p1;
            const float c0 = p0 * gw, c1 = p1 * gw;
            const int a = i0 < i1 ? i0 : i1, bq = i0 < i1 ? i1 : i0; const float ca = i0 < i1 ? c0 : c1, cb = i0 < i1 ? c1 : c0;
            const int cls = gs * 28 + (a * (15 - a)) / 2 + (bq - a - 1);
            ME[r] = (unsigned)(gs * 8 + a) | ((unsigned)(gs * 8 + bq) << 8) | ((unsigned)cls << 16); MC[r * 2] = ca; MC[r * 2 + 1] = cb; MRS[r] = rs;
            POSC[r] = __hip_atomic_fetch_add(lcnt + cls, 1, __ATOMIC_RELAXED, __HIP_MEMORY_SCOPE_WORKGROUP);
        }
        LDS_WAIT(); asm volatile("" ::: "memory");
    }
    __syncthreads();
    if (F.tid < NCLASS) { const int n = lcnt[F.tid]; lbase[F.tid] = n ? (int)__hip_atomic_fetch_add(F.ctl + CW_CLS + F.tid, (unsigned)n, RLX_AGENT) : 0; }
    __syncthreads();
    for (int tile = F.vcu * NWAVES + F.wave; tile < M / 32; tile += F.G * NWAVES) {
        if (hi == 0) { const size_t r = (size_t)tile * 32 + n32; POSC[r] += lbase[ME[r] >> 16]; } }
    __syncthreads();
}
constexpr size_t WS_TILEE = WS_TOK + 512 * 1024, WS_NT = WS_TOK + 768 * 1024;
__device__ __forceinline__ void moe_assign(Frame& F, const Args& A) {
    LAS int* off_s = (LAS int*)F.lds; LAS int* cnt_s = off_s + 128;
    gu32* cnt = F.ctl + CW_CLS;
    int* TOK = WSP(int, WS_TOK); unsigned* TILEE = WSP(unsigned, WS_TILEE); int* NT = WSP(int, WS_NT); const unsigned* ME = WSP(unsigned, WS_META);
    __syncthreads();
    if (F.tid < NCLASS) cnt_s[F.tid] = (int)__hip_atomic_load(cnt + F.tid, RLX_AGENT);
    __syncthreads();
    if (F.tid == 0) { int o = 0; for (int c = 0; c < NCLASS; ++c) { off_s[c] = o; o += (cnt_s[c] + 255) & ~255; } off_s[NCLASS] = o; }
    __syncthreads();
    for (int r = F.vcu * 512 + F.tid; r < M; r += F.G * 512) { const int cls = (int)(ME[r] >> 16); const int pos = off_s[cls] + WSP(const int, WS_META + 256 * 1024)[r]; TOK[pos] = r; }
    for (int c = F.vcu; c < NCLASS; c += F.G) {
        const int lo = off_s[c] + cnt_s[c], hi = off_s[c + 1];
        for (int p = lo + F.tid; p < hi; p += 512) TOK[p] = -1;
        const int g = c / 28; int pi = c % 28, a = 0; while (pi >= 7 - a) { pi -= 7 - a; ++a; } const int b = a + 1 + pi;
        const unsigned ee = (unsigned)(g * 8 + a) | ((unsigned)(g * 8 + b) << 8);
        for (int t = off_s[c] / 256 + F.tid; t < off_s[c + 1] / 256; t += 512) TILEE[t] = ee;
    }
    if (F.vcu == 0 && F.tid == 0) NT[0] = off_s[NCLASS] / 256;
    __syncthreads();
}
namespace pg8 {
struct MoeUpOrder {
    static constexpr bool GATHER = true, SPLITB = false;
    int nT, G, c; const int* TOK; const unsigned* TILEE; const bf16_t* WGU;
    __device__ bool next(int i, Unit& u) const { const long L = (long)i * G + c; if (L >= 2L * nT) return false; tile_of((int)L, nT, 2, u.pm, u.pn); u.sel = (int)TILEE[u.pm]; return true; }
    __device__ __forceinline__ const char* baseA(const Gemm& g, const Unit&) const { return (const char*)g.A; }
    __device__ __forceinline__ const char* baseB(const Gemm& g, const Unit& u) const { const int e = (u.pn ? (u.sel >> 8) : u.sel) & 255; return (const char*)WGU + (size_t)e * 256 * g.ldb * 2; }
    __device__ __forceinline__ int row(const Unit& u, int r) const { const int t = TOK[u.pm * BM + r]; return t < 0 ? 0 : t; }
};
struct EpiMoeUp {
    static constexpr bool PERM = true;
    const int* TOK; const float* MC; const float* MRS; bf16_t* HID; const float* XS; const float* CSU;
    __device__ __forceinline__ int operator()(const f32x4 (&acc)[2][2][4][2], const Unit& u, int wr, int wc, int fr, int fq) const {
        { int l; asm volatile("v_mbcnt_lo_u32_b32 %0, -1, 0\n\tv_mbcnt_hi_u32_b32 %0, -1, %0" : "=v"(l)); fr = l & 15; fq = l >> 4; }
        const int pos0 = u.pm * BM + wr * 64 + fr; const int e = (u.pn ? (u.sel >> 8) : u.sel) & 255;
        f32x4 csc[2][2];
#pragma unroll
        for (int bj = 0; bj < 2; ++bj)
#pragma unroll
            for (int n = 0; n < 2; ++n) csc[bj][n] = *(const f32x4*)(CSU + e * 256 + bj * HALF + wc * 32 + 8 * fq + 4 * n);
#pragma unroll
        for (int ai = 0; ai < 2; ++ai)
#pragma unroll
            for (int m = 0; m < 4; ++m) { const int pos = pos0 + ai * HALF + m * 16; const int tok = TOK[pos]; const float cw = tok >= 0 ? MC[(size_t)tok * 2 + u.pn] : 0.f; const float rs = tok >= 0 ? MRS[tok] * XS[tok] : 0.f;
                const f32x4 g0 = __builtin_convertvector(__builtin_bit_cast(i32x4, acc[ai][0][m][0]), f32x4) * csc[0][0], g1 = __builtin_convertvector(__builtin_bit_cast(i32x4, acc[ai][0][m][1]), f32x4) * csc[0][1];
                const f32x4 u0 = __builtin_convertvector(__builtin_bit_cast(i32x4, acc[ai][1][m][0]), f32x4) * csc[1][0], u1 = __builtin_convertvector(__builtin_bit_cast(i32x4, acc[ai][1][m][1]), f32x4) * csc[1][1]; float h[8];
#pragma unroll
                for (int j = 0; j < 4; ++j) { h[j] = cw * siluf_(rs * g0[j]) * (rs * u0[j]); h[4 + j] = cw * siluf_(rs * g1[j]) * (rs * u1[j]); }
                u32x4 w; w.x = cvt_pk_bf16(h[0], h[1]); w.y = cvt_pk_bf16(h[2], h[3]); w.z = cvt_pk_bf16(h[4], h[5]); w.w = cvt_pk_bf16(h[6], h[7]);
                *(u32x4*)(HID + (size_t)pos * 256 + u.pn * 128 + wc * 32 + 8 * fq) = w; }
        return 8;
    }
};
struct MoeDownOrder {
    static constexpr bool GATHER = false, SPLITB = true;
    int nT, G, c; const unsigned* TILEE; const bf16_t* WD;
    __device__ bool next(int i, Unit& u) const { const long L = (long)i * G + c; if (L >= 4L * nT) return false; tile_of((int)L, nT, 4, u.pm, u.pn); u.sel = (int)TILEE[u.pm]; return true; }
    __device__ __forceinline__ const char* baseA(const Gemm& g, const Unit& u) const { return (const char*)g.A + (size_t)u.pm * BM * g.lda * 2; }
    __device__ __forceinline__ const char* baseB(const Gemm&, const Unit& u) const { return (const char*)WD + ((size_t)(u.sel & 255) * 1024 + (size_t)u.pn * BM) * 128 * 2; }
    __device__ __forceinline__ const char* baseB2(const Gemm&, const Unit& u) const { return (const char*)WD + ((size_t)((u.sel >> 8) & 255) * 1024 + (size_t)u.pn * BM) * 128 * 2; }
};
struct EpiMoeDown {
    static constexpr bool PERM = true;
    const int* TOK; const bf16_t* XB; float* O; float* DUMP;
    __device__ __forceinline__ int operator()(const f32x4 (&acc)[2][2][4][2], const Unit& u, int wr, int wc, int fr, int fq) const {
        { int l; asm volatile("v_mbcnt_lo_u32_b32 %0, -1, 0\n\tv_mbcnt_hi_u32_b32 %0, -1, %0" : "=v"(l)); fr = l & 15; fq = l >> 4; }
        const int* tp = TOK + u.pm * BM + wr * 64 + fr; const int col0 = u.pn * BM + wc * 32 + 8 * fq;
        int tk[8];
#pragma unroll
        for (int it = 0; it < 8; ++it) tk[it] = tp[(it >> 2) * HALF + (it & 3) * 16];
        u32x4 xw[2][2];
#pragma unroll
        for (int bj = 0; bj < 2; ++bj) xw[0][bj] = *(const u32x4*)(XB + (size_t)(tk[0] >= 0 ? tk[0] : 0) * 1024 + col0 + bj * HALF);
#pragma unroll
        for (int it = 0; it < 8; ++it) { const int ai = it >> 2, m = it & 3, sl = it & 1; const int tok = tk[it];
            if (it + 1 < 8) {
#pragma unroll
                for (int bj = 0; bj < 2; ++bj) xw[sl ^ 1][bj] = *(const u32x4*)(XB + (size_t)(tk[it + 1] >= 0 ? tk[it + 1] : 0) * 1024 + col0 + bj * HALF); }
            asm volatile("" ::: "memory");
            float* rowp = (tok >= 0 ? O + (size_t)tok * 1024 : DUMP) + col0;
#pragma unroll
            for (int bj = 0; bj < 2; ++bj) { const u32x4 x = xw[sl][bj]; f32x4 y0 = acc[ai][bj][m][0], y1 = acc[ai][bj][m][1];
                y0[0] += bflo(x.x); y0[1] += bfhi(x.x); y0[2] += bflo(x.y); y0[3] += bfhi(x.y);
                y1[0] += bflo(x.z); y1[1] += bfhi(x.z); y1[2] += bflo(x.w); y1[3] += bfhi(x.w);
                *(f32x4*)(rowp + bj * HALF) = y0; *(f32x4*)(rowp + bj * HALF + 4) = y1; }
            asm volatile("" ::: "memory"); }
        return 32;
    }
};
}
#ifndef MK_SPLIT
#define MK_SPLIT 0
#endif
constexpr int NPHASE = 12;
__global__ void __launch_bounds__(NWAVES * 64, 2) fwd(Args args) {
    extern __shared__ __attribute__((aligned(16))) unsigned char lds[];
    Frame F;
    F.lds = (LAS unsigned char*)lds;
    F.MISC = (volatile LAS unsigned*)(F.lds + MISC_OFF);
    F.tid = threadIdx.x; F.lane = F.tid & 63; F.wave = __builtin_amdgcn_readfirstlane(F.tid >> 6);
    F.G = gridDim.x; { const int bx = blockIdx.x; F.vcu = (F.G % 8 == 0) ? (bx % 8) * (F.G / 8) + bx / 8 : bx; }
    F.ws = args.ws; F.out = args.out; F.ctl = (gu32*)(args.ws + WS_CTL);
    for (int u = F.tid; u < 256; u += NWAVES * 64) ((LAS unsigned*)(F.lds + LDSCTL_OFF))[u] = 0u;
    __syncthreads();
    const int lo = args.ph_lo, hi = args.ph_hi;
    XcdBarrier bar; bar.bar = (unsigned*)(F.ctl + CW_BAR); bar.x = 0; bar.st = nullptr;
    if (hi - lo > 1) { bar = xcd_barrier_post((unsigned*)(F.ctl + CW_BAR), F.MISC + 8);
        if (F.tid == 0) { const unsigned x = xb_xcc_id(); F.MISC[16] = x; F.MISC[17] = __hip_atomic_fetch_add(F.ctl + CW_XRANK + 64 * x, 1u, RLX_AGENT); } }
    int vid = (int)blockIdx.x;
#ifndef ONLY
#define ONLY -1
#endif
#define IN(k) ((ONLY < 0 || ONLY == (k)) && lo <= (k) && (k) < hi)
#define BOTH(k) (IN(k) && IN((k) + 1))
#ifndef PROBE_FLAG
#define PROBE_FLAG 1
#endif
#ifndef REP_PHASE
#define REP_PHASE -1
#endif
#define NREP(k) 1
#define GRID_BAR() xcd_barrier(bar)

    if (IN(0)) _Pragma("unroll") for (int rep_ = 0; rep_ < NREP(0); ++rep_) { p0_prologue(F, args); if (BOTH(0)) GRID_BAR(); }
    if (IN(1)) { p0_quant(F, args); if (BOTH(1)) GRID_BAR(); }
    if (hi - lo > 1 && lo == 0) {
        bool ok = (F.G % 8) == 0;
#pragma unroll
        for (int j = 0; j < 8; ++j) ok = ok && (__hip_atomic_load(F.ctl + CW_XRANK + 64 * j, RLX_AGENT) == (unsigned)(F.G / 8));
        __syncthreads();
        if (ok) vid = (int)__builtin_amdgcn_readfirstlane((int)(F.MISC[17] * 8u + F.MISC[16]));
    }
    if (IN(2)) _Pragma("unroll") for (int rep_ = 0; rep_ < NREP(2); ++rep_) {
        if (G1_NBF > 0) { pg8::Gemm g{WSP(bf16, WS_HN), WSP(bf16, WS_WIN), D, D, D}; pg8::G1Order S{F.G, vid, 0, 0, G1_NBF};
          pg8::EpiG1<false> E{F.ws, args.in[IN_GQ], args.in[IN_GK], nullptr, nullptr};
          pg8::gemm_phase<pg8::EpiG1<false>, pg8::G1Order>(F.lds + RING_OFF, g, S, E); }
        { pg8::Gemm g{WSP(bf16, WS_HN8), WSP(bf16, WS_WIN8), D / 2, D / 2, D / 2}; pg8::G1Order S{F.G, vid, 0, 1, 22 - G1_NBF};
          pg8::EpiG1<true> E{F.ws, args.in[IN_GQ], args.in[IN_GK], WSP(const float, WS_RS8), WSP(const float, WS_CS8)};
          pg8::gemm_phase<pg8::EpiG1<true>, pg8::G1Order, true>(F.lds + RING_OFF, g, S, E); }
        if (BOTH(2)) GRID_BAR();
    }
    if (IN(3)) _Pragma("unroll") for (int rep_ = 0; rep_ < NREP(3); ++rep_) { gla_prep(F, args); }
    if (IN(4)) _Pragma("unroll") for (int rep_ = 0; rep_ < NREP(4); ++rep_) { dsa_select_mfma(F, args); if (BOTH(4)) GRID_BAR(); }
    if (IN(5)) _Pragma("unroll") for (int rep_ = 0; rep_ < NREP(5); ++rep_) { gla_scan_mfma(F, args); dsa_attn_mfma(F, args); if (BOTH(5)) GRID_BAR(); }
    if (IN(6)) _Pragma("unroll") for (int rep_ = 0; rep_ < NREP(6); ++rep_) {
        pg8::Gemm g{WSP(bf16, WS_OCAT), nullptr, 1024, 512, 512};
        pg8::PairOrder S; S.nM = M / 256; S.nN = D / 256; S.nwg = S.nM * S.nN; S.G = F.G; S.c = vid; S.Wa = WSP(bf16, WS_WA); S.Wb = WSP(bf16, WS_WB);
        pg8::EpiMix E{WSP(bf16, WS_GA), WSP(bf16, WS_GB), WSP(bf16, WS_MIXED), F.ws + WS_MIX8, pg8::PanelX{(LAS float*)(F.lds + XTRA_OFF), WSP(unsigned, WS_SLOT1), F.ctl + CW_PCNT, WSP(float, WS_MS8)}};
        pg8::gemm_phase<pg8::EpiMix, pg8::PairOrder>(F.lds + RING_OFF, g, S, E);
        if (BOTH(6)) GRID_BAR();
    }
    if (IN(7)) _Pragma("unroll") for (int rep_ = 0; rep_ < NREP(7); ++rep_) {
        pg8::Gemm g{WSP(bf16, WS_MIX8), WSP(bf16, WS_WO8), D / 2, D / 2, D / 2}; pg8::StaticOrder S; S.init(M, D, F.G, vid);
        pg8::EpiRes E{args.in[IN_X], WSP(bf16, WS_H2), WSP(const float, WS_MS8), WSP(const float, WS_CSO), (LAS float*)(F.lds + XTRA_OFF), WSP(unsigned, WS_SLOT2)};
        pg8::gemm_phase<pg8::EpiRes, pg8::StaticOrder, true>(F.lds + RING_OFF, g, S, E);
        if (BOTH(7)) GRID_BAR();
    }
    if (IN(8)) _Pragma("unroll") for (int rep_ = 0; rep_ < NREP(8); ++rep_) { moe_route_mfma(F, args); if (BOTH(8)) GRID_BAR(); }
    if (IN(9)) _Pragma("unroll") for (int rep_ = 0; rep_ < NREP(9); ++rep_) { moe_assign(F, args); if (BOTH(9)) GRID_BAR(); }
    if (IN(10)) _Pragma("unroll") for (int rep_ = 0; rep_ < NREP(10); ++rep_) {
        const int nT = __builtin_amdgcn_readfirstlane(*WSP(const int, WS_NT));
        pg8::Gemm g{WSP(bf16, WS_XB8), nullptr, D / 2, D / 2, D / 2};
        pg8::MoeUpOrder S{nT, F.G, vid, WSP(const int, WS_TOK), WSP(const unsigned, WS_TILEE), WSP(bf16, WS_WGU8)};
        pg8::EpiMoeUp E{WSP(const int, WS_TOK), (const float*)(F.ws + WS_META + 512 * 1024), WSP(const float, WS_MRS), WSP(bf16, WS_HID), WSP(const float, WS_XS8), WSP(const float, WS_CSU)};
        pg8::gemm_phase<pg8::EpiMoeUp, pg8::MoeUpOrder, true>(F.lds + RING_OFF, g, S, E);
        if (BOTH(10)) GRID_BAR();
    }
    if (IN(11)) _Pragma("unroll") for (int rep_ = 0; rep_ < NREP(11); ++rep_) {
        const int nT = __builtin_amdgcn_readfirstlane(*WSP(const int, WS_NT));
        pg8::Gemm g{WSP(bf16, WS_HID), nullptr, 256, 128, 256};
        pg8::MoeDownOrder S{nT, F.G, vid, WSP(const unsigned, WS_TILEE), WSP(bf16, WS_WD)};
        pg8::EpiMoeDown E{WSP(const int, WS_TOK), WSP(bf16, WS_H2), F.out, WSP(float, WS_NT + 4096)};
        pg8::gemm_phase<pg8::EpiMoeDown, pg8::MoeDownOrder>(F.lds + RING_OFF, g, S, E);
    }
#undef IN
#undef BOTH
#undef GRID_BAR
}

extern "C" void kernel_launch(void* const* d_in, const int* in_sizes, int n_in, void* d_out, int out_size, void* d_ws, size_t ws_size, hipStream_t stream) {
    static int grid = 0;
    if (grid == 0) {
        if (n_in != 20 || in_sizes[0] != M * D || out_size != M * D || ws_size < WS_END) { fprintf(stderr, "kernel_launch: unexpected shapes (n_in %d, in0 %d, out %d, ws %zu); nothing launched\n", n_in, n_in > 0 ? in_sizes[0] : -1, out_size, ws_size); grid = -1; return; }
        int dev = 0, cus = 0, per_cu = 0;
        if (hipGetDevice(&dev) != hipSuccess || hipDeviceGetAttribute(&cus, hipDeviceAttributeMultiprocessorCount, dev) != hipSuccess) { grid = -1; return; }
        if (hipFuncSetAttribute((const void*)fwd, hipFuncAttributeMaxDynamicSharedMemorySize, LDS_BYTES) != hipSuccess) { fprintf(stderr, "kernel_launch: hipFuncSetAttribute failed\n"); grid = -1; return; }
        if (hipOccupancyMaxActiveBlocksPerMultiprocessor(&per_cu, (const void*)fwd, NWAVES * 64, LDS_BYTES) != hipSuccess || per_cu < 1) fprintf(stderr, "kernel_launch: occupancy query says %d\n", per_cu);
        (void)hipGetLastError();
        grid = cus;
        if (grid > 256) grid = 256;
        if (grid != 256 || per_cu < 1) { fprintf(stderr, "kernel_launch: needs 256 resident workgroups (the merge epilogue's panel exchange); nothing launched\n"); grid = -1; return; }
    }
    if (grid < 0) return;
    if (hipMemsetAsync((char*)d_ws + WS_CTL, 0, CTL_ZERO_BYTES, stream) != hipSuccess) return;
    Args a{};
    for (int i = 0; i < 20; ++i) a.in[i] = (const float*)d_in[i];
    a.out = (float*)d_out; a.ws = (unsigned char*)d_ws;
#if MK_SPLIT
    for (int p = 0; p < NPHASE; ++p) for (int rep = 0; rep < ((p == REP_PHASE) ? 2 : 1); ++rep) { a.ph_lo = p; a.ph_hi = p + 1; a.flag = rep ? PROBE_FLAG : 0; hipLaunchKernelGGL(fwd, dim3(grid), dim3(NWAVES * 64), LDS_BYTES, stream, a); }
#else
    a.ph_lo = 0; a.ph_hi = NPHASE; hipLaunchKernelGGL(fwd, dim3(grid), dim3(NWAVES * 64), LDS_BYTES, stream, a);
#endif
}
```

```cpp
#include <hip/hip_runtime.h>
#include <cstdio>
#include <cstdint>
#include <cmath>
#define MK_SPLIT 0
namespace pg8 {
#define PG8_LAS __attribute__((address_space(3)))
typedef unsigned short bf16_t;
typedef short bf16x8 __attribute__((ext_vector_type(8)));
typedef float f32x4 __attribute__((ext_vector_type(4)));
typedef unsigned u32x4 __attribute__((ext_vector_type(4)));
typedef int i32x4 __attribute__((ext_vector_type(4)));
constexpr int BM = 256, BK = 64, HALF = 128, HTB = HALF * BK * 2  , STAGE_BYTES = 8 * HTB, NXCD = 8, WGM = 8;

__host__ __device__ __forceinline__ int lds_byte(int r, int c) { const int st = (r >> 4) * 2 + (c >> 5), rr = r & 15, cc = c & 31, ob = rr * 64 + cc * 2; return st * 1024 + (ob ^ (((ob >> 9) & 1) << 5)); }
__host__ __device__ __forceinline__ void stage_rc(int b, int& R, int& C) { const int st = b / 1024, sb = b % 1024, swz = sb ^ (((sb >> 9) & 1) << 5); R = (st >> 1) * 16 + swz / 64; C = (st & 1) * 32 + (swz % 64) / 2; }
__host__ __device__ __forceinline__ int perm32(int rho) { const int n = rho >> 4, i = rho & 15; return 8 * (i >> 2) + 4 * n + (i & 3); }

struct Unit { int pm, pn, sel; };
struct Gemm { const bf16_t* A; const bf16_t* Bt; int lda, ldb, K; int nomma = 0; };

__host__ __device__ __forceinline__ void tile_of(int wgid, int nM, int nN, int& pm, int& pn) {
    const int nwg = nM * nN;
    { const int q = nwg / NXCD, r = nwg % NXCD, xcd = wgid % NXCD, off = wgid / NXCD; wgid = (xcd < r ? xcd * (q + 1) : r * (q + 1) + (xcd - r) * q) + off; }
    const int nig = WGM * nN, gid = wgid / nig, fm = gid * WGM, gsz = (nM - fm) < WGM ? (nM - fm) : WGM;
    pm = fm + ((wgid % nig) % gsz); pn = (wgid % nig) / gsz;
}
struct StaticOrder {
    static constexpr bool GATHER = false, SPLITB = false;
    int nM, nN, nwg, G, c;
    __host__ __device__ void init(int M, int N, int G_, int c_) { nM = M / BM; nN = N / BM; nwg = nM * nN; G = G_; c = c_; }
    __host__ __device__ bool next(int i, Unit& u) const {
        const long L = (long)i * G + c; if (L >= nwg) return false;
        tile_of((int)L, nM, nN, u.pm, u.pn); u.sel = 0; return true;
    }
    __device__ __forceinline__ const char* baseA(const Gemm& g, const Unit& u) const { return (const char*)g.A + (size_t)u.pm * BM * g.lda * 2; }
    __device__ __forceinline__ const char* baseB(const Gemm& g, const Unit& u) const { return (const char*)g.Bt + (size_t)u.pn * BM * g.ldb * 2; }
};

typedef float f32x2_t __attribute__((ext_vector_type(2))); typedef __bf16 bf16x2_t __attribute__((ext_vector_type(2)));
__device__ __forceinline__ unsigned cvt_pk_bf16(float lo, float hi) { const f32x2_t v = {lo, hi}; const bf16x2_t b = __builtin_convertvector(v, bf16x2_t); return __builtin_bit_cast(unsigned, b); }

template <class Epi, class Sched, bool I8 = false>
__device__ __forceinline__ void gemm_phase(PG8_LAS unsigned char* lds, const Gemm g, const Sched& S, const Epi& E) {
    const int tid = threadIdx.x, wid = __builtin_amdgcn_readfirstlane(tid >> 6), lane = tid & 63, wr = wid >> 2, wc = wid & 3, fr = lane & 15, fq = lane >> 4;
    const int K = g.K, nt = K / BK;
    unsigned voffA[2][2], voffN[2][2], voffB[2]; int RA_[2], CA_[2];
#pragma unroll
    for (int i = 0; i < 2; ++i) { int R, C; stage_rc(tid * 16 + i * 8192, R, C); const int Rb = Epi::PERM ? ((R & ~31) + perm32(R & 31)) : R; RA_[i] = R; CA_[i] = C;
        voffB[i] = (unsigned)(Rb * g.ldb + C) * 2u;
#pragma unroll
        for (int h = 0; h < 2; ++h) { voffA[h][i] = (unsigned)((R + h * HALF) * g.lda + C) * 2u; voffN[h][i] = voffA[h][i]; } }
    const size_t kstep = (size_t)(BK * 2);
    const size_t hstepB = (size_t)HALF * g.ldb * 2;
    const unsigned ldsw = (unsigned)wid * 1024u;
    const int aoff = lds_byte(wr * 64 + fr, fq * 8), boff = lds_byte(wc * 32 + fr, fq * 8);
#define PG8_SA(b, h) (((b) * 2 + (h)) * HTB)
#define PG8_SB(b, h) ((4 + (b) * 2 + (h)) * HTB)
#define PG8_STAGE(bufoff, gbase, voff) do { _Pragma("unroll") for (int _i = 0; _i < 2; ++_i) \
        __builtin_amdgcn_global_load_lds((const unsigned*)((const char*)(gbase) + (voff)[_i]), (PG8_LAS unsigned*)(lds + (bufoff) + ldsw + _i * 8192), 16, 0, 0); } while (0)
#define PG8_LDA(dst, b, h) do { _Pragma("unroll") for (int m = 0; m < 4; ++m) _Pragma("unroll") for (int k = 0; k < 2; ++k) dst[m][k] = *(const PG8_LAS bf16x8*)(lds + PG8_SA(b, h) + aoff + m * 2048 + k * 1024); } while (0)
#define PG8_LDB(dst, b, h) do { _Pragma("unroll") for (int n = 0; n < 2; ++n) _Pragma("unroll") for (int k = 0; k < 2; ++k) dst[n][k] = *(const PG8_LAS bf16x8*)(lds + PG8_SB(b, h) + boff + n * 2048 + k * 1024); } while (0)
#ifdef PROBE_NOMMA
#define PG8_MMA_GUARD if (!g.nomma)
#else
#define PG8_MMA_GUARD
#endif
#define PG8_MMA(ai, bj, At, Bt) PG8_MMA_GUARD do { __builtin_amdgcn_s_setprio(1); _Pragma("unroll") for (int m = 0; m < 4; ++m) _Pragma("unroll") for (int n = 0; n < 2; ++n) _Pragma("unroll") for (int k = 0; k < 2; ++k) { \
        if constexpr (I8) acc[ai][bj][m][n] = __builtin_bit_cast(f32x4, __builtin_amdgcn_mfma_i32_16x16x64_i8(__builtin_bit_cast(i32x4, Bt[n][k]), __builtin_bit_cast(i32x4, At[m][k]), __builtin_bit_cast(i32x4, acc[ai][bj][m][n]), 0, 0, 0)); \
        else acc[ai][bj][m][n] = __builtin_amdgcn_mfma_f32_16x16x32_bf16(Bt[n][k], At[m][k], acc[ai][bj][m][n], 0, 0, 0); } __builtin_amdgcn_s_setprio(0); } while (0)
#define PG8_WAIT_V(n) asm volatile("s_waitcnt vmcnt(" #n ")" ::: "memory")
#define PG8_WAIT_L(n) asm volatile("s_waitcnt lgkmcnt(" #n ")" ::: "memory")
#define PG8_WAIT_VE() PG8_WAIT_V(8)
#define PG8_BAR __builtin_amdgcn_s_barrier()
#define PG8_SCHED __builtin_amdgcn_sched_barrier(0)
#define PG8_GATHER(dst, u) do { if constexpr (Sched::GATHER) { _Pragma("unroll") for (int _h = 0; _h < 2; ++_h) _Pragma("unroll") for (int _i = 0; _i < 2; ++_i) \
        dst[_h][_i] = (unsigned)S.row(u, _h * HALF + RA_[_i]) * (unsigned)(g.lda * 2) + (unsigned)(CA_[_i] * 2); } } while (0)
    Unit cur, nxt, nn; int ui = 0, en = 0;
    if (!S.next(0, cur)) return;
    bool has_next = S.next(1, nxt);
    f32x4 acc[2][2][4][2];
#pragma unroll
    for (int a = 0; a < 2; ++a)
#pragma unroll
        for (int b = 0; b < 2; ++b)
#pragma unroll
            for (int m = 0; m < 4; ++m)
#pragma unroll
                for (int n = 0; n < 2; ++n) acc[a][b][m][n] = (f32x4){0.f, 0.f, 0.f, 0.f};
    bf16x8 At[4][2], B0[2][2], B1[2][2];
    const char* cA = S.baseA(g, cur); const char* cB = S.baseB(g, cur);
    PG8_GATHER(voffA, cur);
    if constexpr (Sched::GATHER) { if (has_next) { PG8_GATHER(voffN, nxt); } else {
#pragma unroll
        for (int h = 0; h < 2; ++h)
#pragma unroll
            for (int i = 0; i < 2; ++i) voffN[h][i] = voffA[h][i]; } }
    PG8_STAGE(PG8_SB(0, 0), cB, voffB); PG8_STAGE(PG8_SB(0, 1), cB + hstepB, voffB); PG8_STAGE(PG8_SA(0, 0), cA, voffA[0]); PG8_STAGE(PG8_SA(0, 1), cA, voffA[1]);
    if (wr == 1) PG8_BAR;
    PG8_WAIT_V(2); PG8_BAR;
    PG8_STAGE(PG8_SB(1, 0), cB + kstep, voffB); PG8_STAGE(PG8_SA(1, 0), cA + kstep, voffA[0]); PG8_STAGE(PG8_SB(1, 1), cB + hstepB + kstep, voffB);
    PG8_WAIT_V(6); PG8_BAR;
    for (;;) {
        const char* nA = has_next ? S.baseA(g, nxt) : cA; const char* nB = has_next ? S.baseB(g, nxt) : cB;
        const char* cB2 = cB; if constexpr (Sched::SPLITB) cB2 = S.baseB2(g, cur);
        for (int t = 0; t < nt; t += 2) {
            const bool last = (t == nt - 2);
            const char* a1 = cA + (size_t)(t + 1) * kstep;
            const char* a2 = last ? nA : cA + (size_t)(t + 2) * kstep;
            const char* b2 = last ? nB : (Sched::SPLITB ? cB2 + (size_t)t * kstep : cB + (size_t)(t + 2) * kstep);
            const char* a3 = a2 + kstep; const char* b3 = b2 + kstep;
            unsigned v2[2][2];
#pragma unroll
            for (int h = 0; h < 2; ++h)
#pragma unroll
                for (int i = 0; i < 2; ++i) v2[h][i] = (Sched::GATHER && last) ? voffN[h][i] : voffA[h][i];
            PG8_LDB(B0, 0, 0); PG8_LDB(B1, 0, 1); PG8_SCHED; PG8_LDA(At, 0, 0); PG8_STAGE(PG8_SA(1, 1), a1, voffA[1]);
            PG8_WAIT_VE(); PG8_WAIT_L(0); PG8_BAR; PG8_MMA(0, 0, At, B0); PG8_MMA(0, 1, At, B1); PG8_BAR; PG8_SCHED;
            PG8_LDA(At, 0, 1); PG8_STAGE(PG8_SB(0, 0), b2, voffB); PG8_STAGE(PG8_SB(0, 1), b2 + hstepB, voffB); PG8_STAGE(PG8_SA(0, 0), a2, v2[0]);
            PG8_WAIT_VE(); PG8_WAIT_L(0); PG8_BAR; PG8_MMA(1, 0, At, B0); PG8_MMA(1, 1, At, B1); PG8_BAR; PG8_SCHED;
            PG8_LDB(B0, 1, 0); PG8_LDB(B1, 1, 1); PG8_SCHED; PG8_LDA(At, 1, 0); PG8_STAGE(PG8_SA(0, 1), a2, v2[1]);
            PG8_WAIT_V(8); PG8_WAIT_L(0); PG8_BAR; PG8_MMA(0, 0, At, B0); PG8_MMA(0, 1, At, B1); PG8_BAR; PG8_SCHED;
            PG8_LDA(At, 1, 1); PG8_STAGE(PG8_SB(1, 0), b3, voffB); PG8_STAGE(PG8_SB(1, 1), b3 + hstepB, voffB); PG8_STAGE(PG8_SA(1, 0), a3, v2[0]);
            PG8_WAIT_V(8); PG8_WAIT_L(0); PG8_BAR; PG8_MMA(1, 0, At, B0); PG8_MMA(1, 1, At, B1); PG8_BAR; PG8_SCHED;
        }
        const bool has_nn = has_next && S.next(ui + 2, nn);
        int trow[2][2];
        if constexpr (Sched::GATHER) { if (has_nn) {
#pragma unroll
            for (int h = 0; h < 2; ++h)
#pragma unroll
                for (int i = 0; i < 2; ++i) trow[h][i] = S.row(nn, h * HALF + RA_[i]); } }
        if (wr == 0) PG8_BAR;
        en = __builtin_amdgcn_readfirstlane(E(acc, cur, wr, wc, fr, fq));
        if (!has_next) break;
#pragma unroll
        for (int a = 0; a < 2; ++a)
#pragma unroll
            for (int b = 0; b < 2; ++b)
#pragma unroll
                for (int m = 0; m < 4; ++m)
#pragma unroll
                    for (int n = 0; n < 2; ++n) acc[a][b][m][n] = (f32x4){0.f, 0.f, 0.f, 0.f};
        cur = nxt; cA = nA; cB = nB; ++ui; nxt = nn; has_next = has_nn;
        if constexpr (Sched::GATHER) {
#pragma unroll
            for (int h = 0; h < 2; ++h)
#pragma unroll
                for (int i = 0; i < 2; ++i) { voffA[h][i] = voffN[h][i]; if (has_nn) voffN[h][i] = (unsigned)trow[h][i] * (unsigned)(g.lda * 2) + (unsigned)(CA_[i] * 2); } }
        if (wr == 1) PG8_BAR;
    }
    PG8_WAIT_V(0);
    PG8_BAR;
#undef PG8_SA
#undef PG8_SB
#undef PG8_STAGE
#undef PG8_LDA
#undef PG8_LDB
#undef PG8_MMA
#undef PG8_WAIT_V
#undef PG8_WAIT_L
#undef PG8_WAIT_VE
#undef PG8_BAR
#undef PG8_SCHED
#undef PG8_GATHER
}
}
constexpr int NWAVES = 8;
constexpr int BATCH = 16, SEQ = 4096, D = 1024, M = BATCH * SEQ;
constexpr int CH = 64, NCH = SEQ / CH, NCHUNK = M / CH;
constexpr int NP = 5632;
constexpr float EPS = 1e-6f;
constexpr float LOG2E = 1.4426950408889634f;
constexpr int L_QA = 0, L_KA = 256, L_VA = 512, L_RA = 1024, L_ALR = 1536, L_QB = 1552, L_KB = 2064, L_VB = 2576, L_QI = 3088, L_KI = 3344, L_WI = 3376, L_GA = 3384, L_GB = 4408, D_IN = 5432;
constexpr int NEXP = 32, DEXP = 128, NCLASS = 112;

constexpr size_t MiB = 1u << 20;
constexpr size_t WS_CTL = 0, CTL_ZERO_BYTES = 1 * MiB;
constexpr size_t WS_WIN = 2 * MiB;
constexpr size_t WS_WA = 13 * MiB;
constexpr size_t WS_WB = 14 * MiB;
constexpr size_t WS_WO = 15 * MiB;
constexpr size_t WS_WGU = 17 * MiB;
constexpr size_t WS_WD = 33 * MiB;
constexpr size_t WS_META = 41 * MiB;
constexpr size_t WS_WR = 43 * MiB;
constexpr size_t WS_MRS = 44 * MiB;
constexpr size_t WS_TOK = 42 * MiB;
constexpr size_t WS_R0 = 48 * MiB;
constexpr size_t WS_HN = WS_R0, WS_KDT = WS_R0, WS_MASK = WS_R0 + 32 * MiB, WS_MIXED = WS_R0;
constexpr size_t WS_QA = 176 * MiB, WS_KA = 208 * MiB, WS_VA = 240 * MiB, WS_RA = 304 * MiB, WS_QB = 368 * MiB, WS_KB = 432 * MiB, WS_VB = 496 * MiB, WS_QI = 560 * MiB;
constexpr size_t WS_KI = 592 * MiB, WS_WI = 596 * MiB, WS_ALR = 598 * MiB, WS_DEC = 602 * MiB;
constexpr size_t WS_GA = 608 * MiB, WS_GB = 736 * MiB, WS_OCAT = 864 * MiB, WS_END = 992 * MiB;
constexpr size_t WS_HN8 = 672 * MiB;
constexpr size_t WS_WIN8 = 800 * MiB;
constexpr size_t WS_RS8 = 808 * MiB, WS_CS8 = 809 * MiB;
constexpr size_t WS_WGU8 = 812 * MiB, WS_CSU = 820 * MiB;
constexpr size_t WS_XB8 = WS_R0, WS_XS8 = WS_R0 + 64 * MiB;
constexpr size_t WS_WO8 = 821 * MiB, WS_CSO = 822 * MiB;
constexpr size_t WS_MIX8 = 368 * MiB, WS_MS8 = 432 * MiB;
constexpr size_t WS_SLOT1 = 824 * MiB, WS_SLOT2 = 826 * MiB;
constexpr size_t WS_H2 = 176 * MiB;
constexpr size_t WS_HID = 304 * MiB;
constexpr int CW_TMO = 0, CW_CODE = 1;
constexpr int CW_BAR = 4096;
constexpr int CW_XRANK = 9216;
constexpr int CW_ATTQ = 8448;
constexpr int CW_CMAX = 16384;
constexpr int CW_ROWMAX2 = 131072;
constexpr int CW_PCNT = 196608;
constexpr int CW_ROWMAX = 65536;
constexpr int CW_CLS = 8192;

constexpr int RING_OFF = 0, RING_BYTES = 131072;
constexpr int LDSCTL_OFF = RING_BYTES, MISC_OFF = LDSCTL_OFF + 320;
constexpr int XTRA_OFF = RING_BYTES + 1024;
constexpr int LDS_BYTES = 147456;

#define GAS __attribute__((address_space(1)))
#define LAS __attribute__((address_space(3)))
typedef unsigned short bf16;
typedef unsigned v4u __attribute__((ext_vector_type(4)));
typedef unsigned v2u __attribute__((ext_vector_type(2)));
typedef float f32x4 __attribute__((ext_vector_type(4)));
typedef float f32x16 __attribute__((ext_vector_type(16)));
typedef short bf16x8 __attribute__((ext_vector_type(8)));
typedef GAS unsigned gu32;
#define RLX_AGENT __ATOMIC_RELAXED, __HIP_MEMORY_SCOPE_AGENT
#define LDS_WAIT() asm volatile("s_waitcnt lgkmcnt(0)" ::: "memory")
#define VM_WAIT() asm volatile("s_waitcnt vmcnt(0)" ::: "memory")
__device__ __forceinline__ unsigned f2bf(float f) { unsigned u = __builtin_bit_cast(unsigned, f); return (u + 0x7fffu + ((u >> 16) & 1u)) >> 16; }
__device__ __forceinline__ unsigned pk2(float lo, float hi) { return f2bf(lo) | (f2bf(hi) << 16); }
__device__ __forceinline__ float bf2f(unsigned short b) { return __builtin_bit_cast(float, ((unsigned)b) << 16); }
__device__ __forceinline__ float bflo(unsigned w) { return __builtin_bit_cast(float, w << 16); }
__device__ __forceinline__ float bfhi(unsigned w) { return __builtin_bit_cast(float, w & 0xffff0000u); }
__device__ __forceinline__ float fast_exp2(float x) { return __builtin_amdgcn_exp2f(x); }
__device__ __forceinline__ float sigmoidf_(float x) { return __builtin_amdgcn_rcpf(1.0f + __builtin_amdgcn_exp2f(-x * LOG2E)); }
__device__ __forceinline__ float siluf_(float x) { return x * sigmoidf_(x); }

#define XB_TMO      128
#define XB_XCNT(j)  (256  + 64 * (j))
#define XB_XSUB(j)  (1280 + 64 * (j))
#define XB_XGEN(j)  (2304 + 64 * (j))
#define XB_TOP      3328
#define XB_TOPGEN   3392
#define XCD_BAR_WORDS 3456
#define XB_SPIN_CAP (1u << 18)
__device__ __forceinline__ unsigned xb_ld(unsigned* p)              { return __hip_atomic_load(p, __ATOMIC_RELAXED, __HIP_MEMORY_SCOPE_AGENT); }
__device__ __forceinline__ unsigned xb_add(unsigned* p, unsigned v) { return __hip_atomic_fetch_add(p, v, __ATOMIC_RELAXED, __HIP_MEMORY_SCOPE_AGENT); }
__device__ __forceinline__ unsigned xb_xcc_id() { return (unsigned)__builtin_amdgcn_s_getreg((3 << 11) | 20) & 0xFu; }
#define XB_SPIN(cond, bar) do { unsigned _sp = 0; while (cond) { __builtin_amdgcn_s_sleep(1); \
    if ((++_sp & 255u) == 0u) { if (xb_ld(&(bar)[XB_TMO])) break; if (_sp > XB_SPIN_CAP) { atomicAdd(&(bar)[XB_TMO], 1u); break; } } } } while (0)
struct XcdBarrier { unsigned* bar; unsigned x; volatile LAS unsigned* st; };
__device__ __forceinline__ XcdBarrier xcd_barrier_post(unsigned* bar, volatile LAS unsigned* st) {
    XcdBarrier b; b.bar = bar; b.x = xb_xcc_id(); b.st = st;
    if (threadIdx.x == 0) (void)xb_add(&bar[XB_XCNT(b.x)], 1u);
    return b;
}
__device__ __forceinline__ void xcd_barrier_complete(unsigned* bar, unsigned x, unsigned& nloc, unsigned& nx) {
    const unsigned G = gridDim.x * gridDim.y * gridDim.z;
    unsigned sum, cnt, mine, sp = 0u;
    for (;;) {
        sum = 0u; cnt = 0u; mine = 0u;
#pragma unroll
        for (unsigned j = 0; j < 16; ++j) { const unsigned c = xb_ld(&bar[XB_XCNT(j)]); sum += c; cnt += (c > 0u) ? 1u : 0u; mine = (j == x) ? c : mine; }
        if (sum == G) break;
        __builtin_amdgcn_s_sleep(1);
        if ((++sp & 255u) == 0u) { if (xb_ld(&bar[XB_TMO])) break; if (sp > XB_SPIN_CAP) { atomicAdd(&bar[XB_TMO], 1u); break; } }
    }
    nloc = mine > 0u ? mine : 1u; nx = cnt > 0u ? cnt : 1u;
}
__device__ __forceinline__ void xcd_barrier(const XcdBarrier& b) {
    asm volatile("s_waitcnt vmcnt(0)" ::: "memory");
    __syncthreads();
    if (threadIdx.x == 0) {
        unsigned* bar = b.bar;
        __builtin_amdgcn_s_waitcnt(0);
        unsigned nloc = b.st[0], nx = b.st[1];
        if (nloc == 0u) { xcd_barrier_complete(bar, b.x, nloc, nx); b.st[0] = nloc; b.st[1] = nx; }
        const unsigned old = xb_add(&bar[XB_XSUB(b.x)], 1u);
        const unsigned gen = old / nloc;
        if (old + 1u == (gen + 1u) * nloc) {
            __builtin_amdgcn_fence(__ATOMIC_RELEASE, "agent");
            asm volatile("s_waitcnt vmcnt(0)" ::: "memory");
            const unsigned og = xb_add(&bar[XB_TOP], 1u);
            const unsigned tg = og / nx;
            if (og + 1u == (tg + 1u) * nx) xb_add(&bar[XB_TOPGEN], 1u);
            else XB_SPIN(xb_ld(&bar[XB_TOPGEN]) == tg, bar);
            __builtin_amdgcn_fence(__ATOMIC_ACQUIRE, "agent");
            xb_add(&bar[XB_XGEN(b.x)], 1u);
            asm volatile("s_waitcnt vmcnt(0)" ::: "memory");
        } else {
            XB_SPIN(xb_ld(&bar[XB_XGEN(b.x)]) == gen, bar);
            __builtin_amdgcn_fence(__ATOMIC_ACQUIRE, "agent");
            asm volatile("s_waitcnt vmcnt(0)" ::: "memory");
        }
    }
    __syncthreads();
}

struct Args { const float* in[20]; float* out; unsigned char* ws; int ph_lo, ph_hi, flag, pad; };
struct Frame {
    LAS unsigned char* lds;
    volatile LAS unsigned* MISC;
    gu32* ctl;
    int tid, lane, wave;
    int vcu, G;
    float* out; unsigned char* ws;
};
#define IN_X 0
#define IN_GMIX 1
#define IN_WIN 2
#define IN_WA2 3
#define IN_BA 4
#define IN_GGLA 5
#define IN_WBRG 6
#define IN_GQ 7
#define IN_GK 8
#define IN_RELB 9
#define IN_WBRA 10
#define IN_WOUT 11
#define IN_GFFN 12
#define IN_WRG 13
#define IN_BRG 14
#define IN_WRE 15
#define IN_BRE 16
#define IN_WGATE 17
#define IN_WUP 18
#define IN_WDOWN 19
#define WSP(T, off) ((T*)(F.ws + (off)))

__device__ __forceinline__ float wave_sum(float v) {
#pragma unroll
    for (int o = 1; o < 64; o <<= 1) v += __shfl_xor(v, o);
    return v;
}
__device__ __forceinline__ float wave_max(float v) {
#pragma unroll
    for (int o = 1; o < 64; o <<= 1) v = fmaxf(v, __shfl_xor(v, o));
    return v;
}
__device__ __forceinline__ void win_map(int p, int& c, float& s) {
    const int tile = p >> 8, j = p & 255; s = 1.f;
    if (tile == 0) { c = L_QA + j; s = 0.125f; }
    else if (tile == 1) c = L_KA + j;
    else if (tile < 4) c = L_VA + (p - 512);
    else if (tile < 6) c = L_RA + (p - 1024);
    else if (tile < 10) {
        const int pl = (p - 1536) & 511, t2 = pl >> 8, jj = pl & 255, bj = jj >> 7, wc = (jj >> 5) & 3, x = jj & 31;
        c = (tile < 8 ? L_QB : L_KB) + t2 * 256 + 64 * wc + 32 * bj + x;
    }
    else if (tile < 12) c = L_VB + (p - 2560);
    else if (tile == 12) c = L_QI + j;
    else if (tile == 13) { if (j < 32) c = L_KI + j; else if (j < 40) { c = L_WI + (j - 32); s = 0.0625f; } else if (j < 56) c = L_ALR + (j - 40); else c = -1; }
    else {
        const int pl = (p - 3584) & 1023, t4 = pl >> 8, jj = pl & 255, bj = jj >> 7, wc = (jj >> 5) & 3, fq = (jj >> 3) & 3, j2 = jj & 7;
        c = (tile < 18 ? L_GA : L_GB) + t4 * 256 + 64 * wc + 16 * fq + 8 * bj + j2;
    }
}
#ifndef G1_NBF
#define G1_NBF 0
#endif
__host__ __device__ __forceinline__ int g1_tile(int set, int j) {
#if G1_NBF == 8
    return set ? (j < 4 ? j + 2 : (j < 6 ? j + 6 : j + 8)) : (j < 2 ? j : (j < 6 ? j + 4 : j + 6));
#elif G1_NBF == 2
    return set ? (j < 12 ? j : j + 2) : 12 + j;
#else
    return j;
#endif
}
__device__ __forceinline__ bool win_is8(int tile) {
#if G1_NBF == 8
    return (tile >= 2 && tile < 6) || tile == 10 || tile == 11 || tile >= 14;
#elif G1_NBF == 2
    return tile != 12 && tile != 13;
#else
    return true;
#endif
}
template <int MAP>
__device__ __forceinline__ void p0_transpose_item(const float* W, int K, int N, bf16* WT, int row_off, int nrows, LAS float* scr, int item, int lane, const float* ksc = nullptr, gu32* cmax = nullptr) {
    const int nblk = nrows / 32, kb = item / nblk, nb = item % nblk, k0 = 64 * kb, n0 = 32 * nb;
    const int c4 = lane & 7, kk8 = lane >> 3;
    int c = n0 + 4 * c4; float s = 1.f;
    if (MAP == 1) win_map(n0 + 4 * c4, c, s);
#pragma unroll
    for (int i = 0; i < 8; ++i) { const int kk = 8 * i + kk8; f32x4 v = {0.f, 0.f, 0.f, 0.f};
        if (c >= 0) v = *(const GAS f32x4*)(W + (size_t)(k0 + kk) * N + c) * (ksc ? s * ksc[k0 + kk] : s);
        LAS float* d = scr + kk * 33 + 4 * c4; d[0] = v.x; d[1] = v.y; d[2] = v.z; d[3] = v.w; }
    LDS_WAIT(); asm volatile("" ::: "memory");
    if (cmax) { if (MAP == 0 || win_is8(n0 >> 8)) {
        float mx = 0.f;
#pragma unroll 8
        for (int i = 0; i < 32; ++i) mx = fmaxf(mx, fabsf(scr[(2 * i + (lane >> 5)) * 33 + (lane & 31)]));
        mx = fmaxf(mx, __shfl_xor(mx, 32));
        if (lane < 32) __hip_atomic_fetch_max(cmax + row_off + n0 + lane, f2bf(mx) << 16, RLX_AGENT); } }
    const int ch = lane & 7;
#pragma unroll
    for (int j = 0; j < 4; ++j) { const int n = (lane >> 3) + 8 * j; const LAS float* sp = scr + (8 * ch) * 33 + n;
        v4u o; o.x = pk2(sp[0 * 33], sp[1 * 33]); o.y = pk2(sp[2 * 33], sp[3 * 33]); o.z = pk2(sp[4 * 33], sp[5 * 33]); o.w = pk2(sp[6 * 33], sp[7 * 33]);
        *(GAS v4u*)(WT + (size_t)(row_off + n0 + n) * K + k0 + 8 * ch) = o; }
    LDS_WAIT(); asm volatile("" ::: "memory");
}
__device__ __forceinline__ void rms_row_to_bf16(const float* xrow, const float* g, bf16* orow, int lane) {
    const GAS f32x4* xr = (const GAS f32x4*)xrow + lane; const GAS f32x4* gr = (const GAS f32x4*)g + lane;
    f32x4 v[4]; float s = 0.f;
#pragma unroll
    for (int j = 0; j < 4; ++j) { v[j] = xr[64 * j]; s += (v[j].x * v[j].x + v[j].y * v[j].y) + (v[j].z * v[j].z + v[j].w * v[j].w); }
    const float rs = 1.0f / sqrtf(wave_sum(s) * (1.f / D) + EPS);
    GAS unsigned long long* o8 = (GAS unsigned long long*)orow + lane;
#pragma unroll
    for (int j = 0; j < 4; ++j) { const f32x4 gg = gr[64 * j]; o8[64 * j] = (unsigned long long)pk2(v[j].x * rs * gg.x, v[j].y * rs * gg.y) | ((unsigned long long)pk2(v[j].z * rs * gg.z, v[j].w * rs * gg.w) << 32); }
}
__device__ __forceinline__ void p0_prologue(Frame& F, const Args& A) {
    LAS float* scr = (LAS float*)(F.lds + RING_OFF + F.wave * 16384);
    const int gw = F.vcu * NWAVES + F.wave, NGW = F.G * NWAVES;
    constexpr int I_IN = (D / 64) * (NP / 32);
    constexpr int I_AB = (512 / 64) * (D / 32);
    constexpr int I_O = (D / 64) * (D / 32);
    constexpr int I_GU = (D / 64) * (DEXP / 32);
    constexpr int I_DN = (DEXP / 64) * (D / 32);
    constexpr int NITEMS = I_IN + 2 * I_AB + I_O + NEXP * (2 * I_GU + I_DN);
    for (int it = gw; it < NITEMS; it += NGW) {
        int r = it;
        if (r < I_IN) { p0_transpose_item<1>(A.in[IN_WIN], D, D_IN, WSP(bf16, WS_WIN), 0, NP, scr, r, F.lane, nullptr, F.ctl + CW_CMAX); continue; } r -= I_IN;
        if (r < I_AB) { p0_transpose_item<0>(A.in[IN_WBRG], 512, D, WSP(bf16, WS_WA), 0, D, scr, r, F.lane); continue; } r -= I_AB;
        if (r < I_AB) { p0_transpose_item<0>(A.in[IN_WBRA], 512, D, WSP(bf16, WS_WB), 0, D, scr, r, F.lane); continue; } r -= I_AB;
        if (r < I_O) { p0_transpose_item<0>(A.in[IN_WOUT], D, D, WSP(bf16, WS_WO), 0, D, scr, r, F.lane, nullptr, F.ctl + CW_CMAX + NP + NEXP * 256); continue; } r -= I_O;
        const int e = r / (2 * I_GU + I_DN); r -= e * (2 * I_GU + I_DN);
        if (r < I_GU) { p0_transpose_item<0>(A.in[IN_WGATE] + (size_t)e * D * DEXP, D, DEXP, WSP(bf16, WS_WGU) + (size_t)e * 256 * D, 0, DEXP, scr, r, F.lane, A.in[IN_GFFN], F.ctl + CW_CMAX + NP + e * 256); continue; } r -= I_GU;
        if (r < I_GU) { p0_transpose_item<0>(A.in[IN_WUP] + (size_t)e * D * DEXP, D, DEXP, WSP(bf16, WS_WGU) + (size_t)e * 256 * D, 128, DEXP, scr, r, F.lane, A.in[IN_GFFN], F.ctl + CW_CMAX + NP + e * 256); continue; } r -= I_GU;
        p0_transpose_item<0>(A.in[IN_WDOWN] + (size_t)e * DEXP * D, DEXP, D, WSP(bf16, WS_WD) + (size_t)e * D * DEXP, 0, D, scr, r, F.lane);
    }
    { bf16* WRH = WSP(bf16, WS_WR); bf16* WRL = WRH + 64 * D;
      for (int i = F.vcu * 512 + F.tid; i < 64 * D; i += F.G * 512) { const int c = i >> 10, k = i & 1023;
          float v = 0.f; if (c < 4) v = A.in[IN_WRG][k * 4 + c]; else if (c < 36) v = A.in[IN_WRE][k * 32 + (c - 4)];
          v *= A.in[IN_GFFN][k]; const unsigned hb = f2bf(v); const float lo = v - __builtin_bit_cast(float, hb << 16);
          WRH[i] = (bf16)hb; WRL[i] = (bf16)f2bf(lo); } }
    for (int m = gw * 8; m < M; m += NGW * 8) {
        const GAS f32x4* gr = (const GAS f32x4*)A.in[IN_GMIX] + F.lane;
        f32x4 v[8][4]; float ss[8], am[8];
#pragma unroll
        for (int r = 0; r < 8; ++r) { const GAS f32x4* xr = (const GAS f32x4*)(A.in[IN_X] + (size_t)(m + r) * D) + F.lane; ss[r] = 0.f; am[r] = 0.f;
#pragma unroll
            for (int j = 0; j < 4; ++j) { v[r][j] = __builtin_nontemporal_load(xr + 64 * j); } }
#pragma unroll
        for (int r = 0; r < 8; ++r) {
#pragma unroll
            for (int j = 0; j < 4; ++j) ss[r] += (v[r][j].x * v[r][j].x + v[r][j].y * v[r][j].y) + (v[r][j].z * v[r][j].z + v[r][j].w * v[r][j].w);
            ss[r] = 1.0f / sqrtf(wave_sum(ss[r]) * (1.f / D) + EPS); }
#pragma unroll
        for (int j = 0; j < 4; ++j) { const f32x4 gg = gr[64 * j];
#pragma unroll
            for (int r = 0; r < 8; ++r) { GAS unsigned long long* o8 = (GAS unsigned long long*)(WSP(bf16, WS_HN) + (size_t)(m + r) * D) + F.lane; const float rs = ss[r];
                const f32x4 y = {v[r][j].x * rs * gg.x, v[r][j].y * rs * gg.y, v[r][j].z * rs * gg.z, v[r][j].w * rs * gg.w}; v[r][j] = y;
                am[r] = fmaxf(fmaxf(am[r], fmaxf(fabsf(y.x), fabsf(y.y))), fmaxf(fabsf(y.z), fabsf(y.w)));
                if (G1_NBF > 0) o8[64 * j] = (unsigned long long)pk2(y.x, y.y) | ((unsigned long long)pk2(y.z, y.w) << 32); } }
#pragma unroll
        for (int r = 0; r < 8; ++r) { const float a = wave_max(am[r]); const float inv = a > 0.f ? 127.0f / a : 0.f;
            if (F.lane == 0) WSP(float, WS_RS8)[m + r] = a * (1.0f / 127.0f);
            v4u q;
#pragma unroll
            for (int j = 0; j < 4; ++j) { unsigned b = 0u;
                b = __builtin_amdgcn_cvt_pk_u8_f32(__builtin_rintf(__builtin_fmaf(v[r][j].x, inv, 128.0f)), 0, b); b = __builtin_amdgcn_cvt_pk_u8_f32(__builtin_rintf(__builtin_fmaf(v[r][j].y, inv, 128.0f)), 1, b);
                b = __builtin_amdgcn_cvt_pk_u8_f32(__builtin_rintf(__builtin_fmaf(v[r][j].z, inv, 128.0f)), 2, b); b = __builtin_amdgcn_cvt_pk_u8_f32(__builtin_rintf(__builtin_fmaf(v[r][j].w, inv, 128.0f)), 3, b);
                q[j] = b ^ 0x80808080u; }
            *(GAS v4u*)(F.ws + WS_HN8 + (size_t)(m + r) * D + 16 * F.lane) = q; }
    }
}
__device__ __forceinline__ void p0_quant(Frame& F, const Args& A) {
    const int gw = F.vcu * NWAVES + F.wave, NGW = F.G * NWAVES;
    for (int idx = gw; idx < (22 - G1_NBF) * 256; idx += NGW) {
        const int tile = g1_tile(1, idx >> 8), p = tile * 256 + (idx & 255);
        const float a = __builtin_bit_cast(float, __hip_atomic_load(F.ctl + CW_CMAX + p, RLX_AGENT)); const float inv = a > 0.f ? 127.0f / a : 0.f;
        if (F.lane == 0) WSP(float, WS_CS8)[p] = a * (1.0f / 127.0f);
        const GAS v2u* row = (const GAS v2u*)(WSP(bf16, WS_WIN) + (size_t)p * D) + F.lane;
        v4u q;
#pragma unroll
        for (int j = 0; j < 4; ++j) { const v2u w = row[64 * j]; unsigned b = 0u;
            b = __builtin_amdgcn_cvt_pk_u8_f32(__builtin_rintf(__builtin_fmaf(bflo(w[0]), inv, 128.0f)), 0, b); b = __builtin_amdgcn_cvt_pk_u8_f32(__builtin_rintf(__builtin_fmaf(bfhi(w[0]), inv, 128.0f)), 1, b);
            b = __builtin_amdgcn_cvt_pk_u8_f32(__builtin_rintf(__builtin_fmaf(bflo(w[1]), inv, 128.0f)), 2, b); b = __builtin_amdgcn_cvt_pk_u8_f32(__builtin_rintf(__builtin_fmaf(bfhi(w[1]), inv, 128.0f)), 3, b);
            q[j] = b ^ 0x80808080u; }
        *(GAS v4u*)(F.ws + WS_WIN8 + (size_t)p * D + 16 * F.lane) = q;
    }
    for (int r = gw; r < NEXP * 256; r += NGW) {
        const float a = __builtin_bit_cast(float, __hip_atomic_load(F.ctl + CW_CMAX + NP + r, RLX_AGENT)); const float inv = a > 0.f ? 127.0f / a : 0.f;
        if (F.lane == 0) WSP(float, WS_CSU)[r] = a * (1.0f / 127.0f);
        const GAS v4u* row = (const GAS v4u*)(WSP(bf16, WS_WGU) + (size_t)r * D + 32 * (F.lane >> 1) + 8 * (F.lane & 1));
        v4u q;
#pragma unroll
        for (int c = 0; c < 2; ++c) { const v4u w = row[2 * c];
#pragma unroll
            for (int j = 0; j < 2; ++j) { unsigned b = 0u;
                b = __builtin_amdgcn_cvt_pk_u8_f32(__builtin_rintf(__builtin_fmaf(bflo(w[2 * j]), inv, 128.0f)), 0, b); b = __builtin_amdgcn_cvt_pk_u8_f32(__builtin_rintf(__builtin_fmaf(bfhi(w[2 * j]), inv, 128.0f)), 1, b);
                b = __builtin_amdgcn_cvt_pk_u8_f32(__builtin_rintf(__builtin_fmaf(bflo(w[2 * j + 1]), inv, 128.0f)), 2, b); b = __builtin_amdgcn_cvt_pk_u8_f32(__builtin_rintf(__builtin_fmaf(bfhi(w[2 * j + 1]), inv, 128.0f)), 3, b);
                q[2 * c + j] = b ^ 0x80808080u; } }
        *(GAS v4u*)(F.ws + WS_WGU8 + (size_t)r * D + 16 * F.lane) = q;
    }
    for (int r = gw; r < D; r += NGW) {
        const float a = __builtin_bit_cast(float, __hip_atomic_load(F.ctl + CW_CMAX + NP + NEXP * 256 + r, RLX_AGENT)); const float inv = a > 0.f ? 127.0f / a : 0.f;
        if (F.lane == 0) WSP(float, WS_CSO)[r] = a * (1.0f / 127.0f);
        const GAS v4u* row = (const GAS v4u*)(WSP(bf16, WS_WO) + (size_t)r * D + 256 * (F.lane >> 4) + 32 * ((F.lane >> 2) & 3) + 8 * (F.lane & 3));
        v4u q;
#pragma unroll
        for (int c = 0; c < 2; ++c) { const v4u w = row[16 * c];
#pragma unroll
            for (int j = 0; j < 2; ++j) { unsigned b = 0u;
                b = __builtin_amdgcn_cvt_pk_u8_f32(__builtin_rintf(__builtin_fmaf(bflo(w[2 * j]), inv, 128.0f)), 0, b); b = __builtin_amdgcn_cvt_pk_u8_f32(__builtin_rintf(__builtin_fmaf(bfhi(w[2 * j]), inv, 128.0f)), 1, b);
                b = __builtin_amdgcn_cvt_pk_u8_f32(__builtin_rintf(__builtin_fmaf(bflo(w[2 * j + 1]), inv, 128.0f)), 2, b); b = __builtin_amdgcn_cvt_pk_u8_f32(__builtin_rintf(__builtin_fmaf(bfhi(w[2 * j + 1]), inv, 128.0f)), 3, b);
                q[2 * c + j] = b ^ 0x80808080u; } }
        *(GAS v4u*)(F.ws + WS_WO8 + (size_t)r * D + 16 * F.lane) = q;
    }
}
namespace pg8 {
template <bool I8>
struct EpiG1 {
    static constexpr bool PERM = true;
    unsigned char* ws; const float *gq, *gk; const float *RS, *CS;
    __device__ __forceinline__ int operator()(const f32x4 (&acc)[2][2][4][2], const Unit& u, int wr, int wc, int fr, int fq) const {
        { int l; asm volatile("v_mbcnt_lo_u32_b32 %0, -1, 0\n\tv_mbcnt_hi_u32_b32 %0, -1, %0" : "=v"(l)); fr = l & 15; fq = l >> 4; }
        const int pn = u.pn; const size_t row0 = (size_t)u.pm * BM + wr * 64 + fr;
        float rsc[2][4]; f32x4 csc[2][2];
        if constexpr (I8) {
#pragma unroll
            for (int ai = 0; ai < 2; ++ai)
#pragma unroll
                for (int m = 0; m < 4; ++m) rsc[ai][m] = RS[row0 + ai * HALF + m * 16];
#pragma unroll
            for (int bj = 0; bj < 2; ++bj)
#pragma unroll
                for (int n = 0; n < 2; ++n) csc[bj][n] = *(const f32x4*)(CS + pn * BM + bj * HALF + wc * 32 + 8 * fq + 4 * n);
        }
        auto DQ = [&](int ai, int bj, int m, int n) -> f32x4 {
            if constexpr (I8) return __builtin_convertvector(__builtin_bit_cast(i32x4, acc[ai][bj][m][n]), f32x4) * csc[bj][n] * rsc[ai][m];
            else return acc[ai][bj][m][n]; };
        if (pn >= 6 && pn < 10) {
            const bool isq = pn < 8; const int t2 = pn - (isq ? 6 : 8); bf16_t* out = (bf16_t*)(ws + (isq ? WS_QB : WS_KB)); const float* g = isq ? gq : gk; const float sc = isq ? 0.125f * 1.4426950408889634f : 1.0f;
            f32x4 gl[2][2];
#pragma unroll
            for (int bj = 0; bj < 2; ++bj)
#pragma unroll
                for (int n = 0; n < 2; ++n) gl[bj][n] = *(const f32x4*)(g + 32 * bj + 8 * fq + 4 * n) * sc;
#pragma unroll
            for (int ai = 0; ai < 2; ++ai)
#pragma unroll
                for (int m = 0; m < 4; ++m) {
                    float ss = 0.f; f32x4 xv[2][2];
#pragma unroll
                    for (int bj = 0; bj < 2; ++bj)
#pragma unroll
                        for (int n = 0; n < 2; ++n) { const f32x4 x = DQ(ai, bj, m, n); xv[bj][n] = x; ss += (x[0] * x[0] + x[1] * x[1]) + (x[2] * x[2] + x[3] * x[3]); }
                    ss += __shfl_xor(ss, 16); ss += __shfl_xor(ss, 32);
                    const float rs = 1.0f / sqrtf(ss * (1.0f / 64.0f) + 1e-6f);
                    bf16_t* rowp = out + (row0 + ai * HALF + m * 16) * 512 + t2 * 256 + 64 * wc + 8 * fq;
#pragma unroll
                    for (int bj = 0; bj < 2; ++bj) { const f32x4 v0 = xv[bj][0] * rs * gl[bj][0], v1 = xv[bj][1] * rs * gl[bj][1];
                        u32x4 w; w.x = cvt_pk_bf16(v0[0], v0[1]); w.y = cvt_pk_bf16(v0[2], v0[3]); w.z = cvt_pk_bf16(v1[0], v1[1]); w.w = cvt_pk_bf16(v1[2], v1[3]);
                        __builtin_nontemporal_store(w, (u32x4*)(rowp + 32 * bj)); }
                }
            return 16;
        }
        if (pn == 13) {
            if (wc == 0) {
#pragma unroll
                for (int ai = 0; ai < 2; ++ai)
#pragma unroll
                    for (int m = 0; m < 4; ++m) { const f32x4 v0 = DQ(ai, 0, m, 0), v1 = DQ(ai, 0, m, 1);
                        u32x4 w; w.x = cvt_pk_bf16(v0[0], v0[1]); w.y = cvt_pk_bf16(v0[2], v0[3]); w.z = cvt_pk_bf16(v1[0], v1[1]); w.w = cvt_pk_bf16(v1[2], v1[3]);
                        *(u32x4*)((bf16_t*)(ws + WS_KI) + (row0 + ai * HALF + m * 16) * 32 + 8 * fq) = w; }
            } else if (wc == 1 && fq < 3) {
#pragma unroll
                for (int ai = 0; ai < 2; ++ai)
#pragma unroll
                    for (int m = 0; m < 4; ++m) { const size_t r = row0 + ai * HALF + m * 16;
                        float* dst = (fq == 0) ? ((float*)(ws + WS_WI) + r * 8) : ((float*)(ws + WS_ALR) + r * 16 + 8 * (fq - 1));
                        *(f32x4*)dst = DQ(ai, 0, m, 0); *(f32x4*)(dst + 4) = DQ(ai, 0, m, 1); }
            }
            return wc == 0 ? 8 : (wc == 1 ? 16 : 0);
        }
        if (pn >= 14) {
            unsigned char* gb = ws + (pn < 18 ? WS_GA : WS_GB) + ((pn - 14) & 3) * 256 + 64 * wc + 16 * fq;
#pragma unroll
            for (int ai = 0; ai < 2; ++ai)
#pragma unroll
                for (int m = 0; m < 4; ++m) { u32x4 w;
#pragma unroll
                    for (int bj = 0; bj < 2; ++bj) { const f32x4 v0 = DQ(ai, bj, m, 0), v1 = DQ(ai, bj, m, 1); unsigned b0 = 0u, b1 = 0u;
#pragma unroll
                        for (int j = 0; j < 4; ++j) { b0 = __builtin_amdgcn_cvt_pk_u8_f32(sigmoidf_(v0[j]) * 255.0f, j, b0); b1 = __builtin_amdgcn_cvt_pk_u8_f32(sigmoidf_(v1[j]) * 255.0f, j, b1); }
                        if (bj == 0) { w.x = b0; w.y = b1; } else { w.z = b0; w.w = b1; } }
                    __builtin_nontemporal_store(w, (u32x4*)(gb + (row0 + ai * HALF + m * 16) * (size_t)1024)); }
            return 8;
        }
        const bool act = (pn == 4 || pn == 5);
        const size_t ob = pn == 0 ? WS_QA : (pn == 1 ? WS_KA : (pn < 4 ? WS_VA : (pn < 6 ? WS_RA : (pn < 12 ? WS_VB : WS_QI))));
        const int ld = (pn < 2 || pn == 12) ? 256 : 512, cb = (pn < 2 || pn == 12) ? 0 : ((pn < 4 ? pn - 2 : (pn < 6 ? pn - 4 : pn - 10)) * 256);
        bf16_t* base = (bf16_t*)(ws + ob);
        const int col0 = cb + wc * 32 + 8 * fq;
#pragma unroll
        for (int ai = 0; ai < 2; ++ai)
#pragma unroll
            for (int m = 0; m < 4; ++m) { bf16_t* rowp = base + (row0 + ai * HALF + m * 16) * ld + col0;
#pragma unroll
                for (int bj = 0; bj < 2; ++bj) { f32x4 v0 = DQ(ai, bj, m, 0), v1 = DQ(ai, bj, m, 1);
                    if (act) {
#pragma unroll
                        for (int j = 0; j < 4; ++j) { v0[j] = siluf_(v0[j]); v1[j] = siluf_(v1[j]); } }
                    u32x4 w; w.x = cvt_pk_bf16(v0[0], v0[1]); w.y = cvt_pk_bf16(v0[2], v0[3]); w.z = cvt_pk_bf16(v1[0], v1[1]); w.w = cvt_pk_bf16(v1[2], v1[3]);
                    __builtin_nontemporal_store(w, (u32x4*)(rowp + bj * HALF)); } }
        return 16;
    }
};
struct G1Order {
    static constexpr bool GATHER = false, SPLITB = false;
    int G, c, ns, set, cnt;
    __device__ bool next(int i, Unit& u) const {
        u.sel = 0;
        if (c < ns) return false;
        const long L = (long)i * (G - ns) + (c - ns); if (L >= 256L * cnt) return false;
        int j; tile_of((int)L, 256, cnt, u.pm, j);
        u.pn = g1_tile(set, j); return true;
    }
    __device__ __forceinline__ const char* baseA(const Gemm& g, const Unit& u) const { return (const char*)g.A + (size_t)u.pm * BM * g.lda * 2; }
    __device__ __forceinline__ const char* baseB(const Gemm& g, const Unit& u) const { return (const char*)g.Bt + (size_t)u.pn * BM * g.ldb * 2; }
};
struct PairOrder {
    static constexpr bool GATHER = false, SPLITB = false;
    int nM, nN, nwg, G, c; const bf16_t* Wa; const bf16_t* Wb;
    __device__ bool next(int i, Unit& u) const {
        const long L = (long)(i >> 1) * G + c; if (L >= nwg) return false;
        tile_of((int)L, nM, nN, u.pm, u.pn); u.sel = i & 1; return true;
    }
    __device__ __forceinline__ const char* baseA(const Gemm& g, const Unit& u) const { return (const char*)g.A + ((size_t)u.pm * BM * g.lda + (u.sel ? 512 : 0)) * 2; }
    __device__ __forceinline__ const char* baseB(const Gemm& g, const Unit& u) const { return (const char*)(u.sel ? Wb : Wa) + (size_t)u.pn * BM * g.ldb * 2; }
};
struct PanelX { PG8_LAS float* xl; unsigned* slots; gu32* cnt; float* scale; };
__device__ __forceinline__ void panel_rowmax(const PanelX& P, int pm, int pn, int wr, int wc, int fr, int fq, float (&mx)[8]) {
    const int tid = threadIdx.x;
#pragma unroll
    for (int it = 0; it < 8; ++it) { mx[it] = fmaxf(mx[it], __shfl_xor(mx[it], 16)); mx[it] = fmaxf(mx[it], __shfl_xor(mx[it], 32)); }
    if (fq == 0) {
#pragma unroll
        for (int it = 0; it < 8; ++it) P.xl[wc * 256 + (it >> 2) * HALF + wr * 64 + (it & 3) * 16 + fr] = mx[it]; }
    __syncthreads();
    if (tid < 256) { const float v = fmaxf(fmaxf(P.xl[tid], P.xl[256 + tid]), fmaxf(P.xl[512 + tid], P.xl[768 + tid]));
        __hip_atomic_store(P.slots + (pm * 4 + pn) * 256 + tid, __builtin_bit_cast(unsigned, v), RLX_AGENT); }
    asm volatile("s_waitcnt vmcnt(0)" ::: "memory");
    __syncthreads();
    if (tid == 0) { __hip_atomic_fetch_add(P.cnt + pm, 1u, __ATOMIC_RELEASE, __HIP_MEMORY_SCOPE_AGENT);
        while (__hip_atomic_load(P.cnt + pm, __ATOMIC_ACQUIRE, __HIP_MEMORY_SCOPE_AGENT) < 4u) __builtin_amdgcn_s_sleep(2); }
    __syncthreads();
    if (tid < 256) { unsigned s[4];
#pragma unroll
        for (int j = 0; j < 4; ++j) s[j] = __hip_atomic_load(P.slots + (pm * 4 + j) * 256 + tid, RLX_AGENT);
        const float v = fmaxf(fmaxf(__builtin_bit_cast(float, s[0]), __builtin_bit_cast(float, s[1])), fmaxf(__builtin_bit_cast(float, s[2]), __builtin_bit_cast(float, s[3])));
        P.xl[1024 + tid] = v; if (pn == 0) P.scale[(size_t)pm * 256 + tid] = v * (1.0f / 127.0f); }
    __syncthreads();
#pragma unroll
    for (int it = 0; it < 8; ++it) mx[it] = P.xl[1024 + (it >> 2) * HALF + wr * 64 + (it & 3) * 16 + fr];
}
struct EpiMix {
    static constexpr bool PERM = true;
    const bf16_t *GA, *GB; bf16_t* MIX; unsigned char* M8; PanelX PX;
    __device__ __forceinline__ int operator()(f32x4 (&acc)[2][2][4][2], const Unit& u, int wr, int wc, int fr, int fq) const {
        { int l; asm volatile("v_mbcnt_lo_u32_b32 %0, -1, 0\n\tv_mbcnt_hi_u32_b32 %0, -1, %0" : "=v"(l)); fr = l & 15; fq = l >> 4; }
        const size_t row0 = (size_t)u.pm * BM + wr * 64 + fr; const int col0 = u.pn * BM + wc * 32 + 8 * fq; const unsigned char* gate = (const unsigned char*)(u.sel ? GB : GA);
        v2u gwb[2][2]; u32x4 pwb[2][2]; float mx[8];
#pragma unroll
        for (int bj = 0; bj < 2; ++bj) { const size_t off = row0 * 1024 + col0 + bj * HALF; gwb[0][bj] = *(const v2u*)(gate + off); pwb[0][bj] = (u32x4){0u, 0u, 0u, 0u}; if (u.sel) pwb[0][bj] = *(const u32x4*)(MIX + off); }
#pragma unroll
        for (int it = 0; it < 8; ++it) { const int ai = it >> 2, m = it & 3, sl = it & 1; const size_t off = (row0 + ai * HALF + m * 16) * 1024 + col0;
            if (it + 1 < 8) { const size_t offn = (row0 + ((it + 1) >> 2) * HALF + ((it + 1) & 3) * 16) * 1024 + col0;
#pragma unroll
                for (int bj = 0; bj < 2; ++bj) { gwb[sl ^ 1][bj] = *(const v2u*)(gate + offn + bj * HALF); pwb[sl ^ 1][bj] = (u32x4){0u, 0u, 0u, 0u}; if (u.sel) pwb[sl ^ 1][bj] = *(const u32x4*)(MIX + offn + bj * HALF); } }
            asm volatile("" ::: "memory");
            mx[it] = 0.f;
#pragma unroll
            for (int bj = 0; bj < 2; ++bj) { const v2u gw = gwb[sl][bj]; const u32x4 pw = pwb[sl][bj]; f32x4 v0 = acc[ai][bj][m][0], v1 = acc[ai][bj][m][1];
                const float k = 1.0f / 255.0f;
                v0[0] *= (float)(gw[0] & 255u) * k; v0[1] *= (float)((gw[0] >> 8) & 255u) * k; v0[2] *= (float)((gw[0] >> 16) & 255u) * k; v0[3] *= (float)(gw[0] >> 24) * k;
                v1[0] *= (float)(gw[1] & 255u) * k; v1[1] *= (float)((gw[1] >> 8) & 255u) * k; v1[2] *= (float)((gw[1] >> 16) & 255u) * k; v1[3] *= (float)(gw[1] >> 24) * k;
                v0[0] += bflo(pw.x); v0[1] += bfhi(pw.x); v0[2] += bflo(pw.y); v0[3] += bfhi(pw.y); v1[0] += bflo(pw.z); v1[1] += bfhi(pw.z); v1[2] += bflo(pw.w); v1[3] += bfhi(pw.w);
                if (u.sel) { acc[ai][bj][m][0] = v0; acc[ai][bj][m][1] = v1;
                    mx[it] = fmaxf(fmaxf(mx[it], fmaxf(fmaxf(fabsf(v0[0]), fabsf(v0[1])), fmaxf(fabsf(v0[2]), fabsf(v0[3])))), fmaxf(fmaxf(fabsf(v1[0]), fabsf(v1[1])), fmaxf(fabsf(v1[2]), fabsf(v1[3])))); }
                else { u32x4 w; w.x = cvt_pk_bf16(v0[0], v0[1]); w.y = cvt_pk_bf16(v0[2], v0[3]); w.z = cvt_pk_bf16(v1[0], v1[1]); w.w = cvt_pk_bf16(v1[2], v1[3]);
                    *(u32x4*)(MIX + off + bj * HALF) = w; } }
            asm volatile("" ::: "memory"); }
        if (!u.sel) return 16;
        panel_rowmax(PX, u.pm, u.pn, wr, wc, fr, fq, mx);
        unsigned char* o8 = M8 + row0 * 1024 + u.pn * BM + 64 * wc + 16 * fq;
#pragma unroll
        for (int it = 0; it < 8; ++it) { const int ai = it >> 2, m = it & 3; const float a = mx[it]; const float inv = a > 0.f ? 127.0f / a : 0.f;
            u32x4 w;
#pragma unroll
            for (int bj = 0; bj < 2; ++bj) { const f32x4 v0 = acc[ai][bj][m][0], v1 = acc[ai][bj][m][1]; unsigned b0 = 0u, b1 = 0u;
#pragma unroll
                for (int j = 0; j < 4; ++j) { b0 = __builtin_amdgcn_cvt_pk_u8_f32(__builtin_rintf(__builtin_fmaf(v0[j], inv, 128.0f)), j, b0); b1 = __builtin_amdgcn_cvt_pk_u8_f32(__builtin_rintf(__builtin_fmaf(v1[j], inv, 128.0f)), j, b1); }
                if (bj == 0) { w.x = b0 ^ 0x80808080u; w.y = b1 ^ 0x80808080u; } else { w.z = b0 ^ 0x80808080u; w.w = b1 ^ 0x80808080u; } }
            *(u32x4*)(o8 + (size_t)(ai * HALF + m * 16) * 1024) = w; }
        return 8;
    }
};
struct EpiRes {
    static constexpr bool PERM = true;
    const float* X; bf16_t* XB; const float *MS, *CSO; PG8_LAS float* xl; unsigned* slots;
    __device__ __forceinline__ int operator()(const f32x4 (&acc)[2][2][4][2], const Unit& u, int wr, int wc, int fr, int fq) const {
        { int l; asm volatile("v_mbcnt_lo_u32_b32 %0, -1, 0\n\tv_mbcnt_hi_u32_b32 %0, -1, %0" : "=v"(l)); fr = l & 15; fq = l >> 4; }
        const size_t row0 = (size_t)u.pm * BM + wr * 64 + fr; const int col0 = u.pn * BM + wc * 32 + 8 * fq;
        f32x4 csc[2][2];
#pragma unroll
        for (int bj = 0; bj < 2; ++bj)
#pragma unroll
            for (int n = 0; n < 2; ++n) csc[bj][n] = *(const f32x4*)(CSO + col0 + bj * HALF + 4 * n);
        f32x4 xb[2][2][2];
#pragma unroll
        for (int bj = 0; bj < 2; ++bj) { const size_t off = row0 * 1024 + col0 + bj * HALF; xb[0][bj][0] = *(const f32x4*)(X + off); xb[0][bj][1] = *(const f32x4*)(X + off + 4); }
#pragma unroll
        for (int it = 0; it < 8; ++it) { const int ai = it >> 2, m = it & 3, sl = it & 1; const size_t off = (row0 + ai * HALF + m * 16) * 1024 + col0;
            if (it + 1 < 8) { const size_t offn = (row0 + ((it + 1) >> 2) * HALF + ((it + 1) & 3) * 16) * 1024 + col0;
#pragma unroll
                for (int bj = 0; bj < 2; ++bj) { xb[sl ^ 1][bj][0] = *(const f32x4*)(X + offn + bj * HALF); xb[sl ^ 1][bj][1] = *(const f32x4*)(X + offn + bj * HALF + 4); } }
            asm volatile("" ::: "memory");
            const float rsc = MS[row0 + ai * HALF + m * 16]; float mx = 0.f;
#pragma unroll
            for (int bj = 0; bj < 2; ++bj) { const f32x4 y0 = xb[sl][bj][0] + __builtin_convertvector(__builtin_bit_cast(i32x4, acc[ai][bj][m][0]), f32x4) * csc[bj][0] * rsc, y1 = xb[sl][bj][1] + __builtin_convertvector(__builtin_bit_cast(i32x4, acc[ai][bj][m][1]), f32x4) * csc[bj][1] * rsc;
                mx = fmaxf(fmaxf(mx, fmaxf(fmaxf(fabsf(y0[0]), fabsf(y0[1])), fmaxf(fabsf(y0[2]), fabsf(y0[3])))), fmaxf(fmaxf(fabsf(y1[0]), fabsf(y1[1])), fmaxf(fabsf(y1[2]), fabsf(y1[3]))));
                u32x4 w; w.x = cvt_pk_bf16(y0[0], y0[1]); w.y = cvt_pk_bf16(y0[2], y0[3]); w.z = cvt_pk_bf16(y1[0], y1[1]); w.w = cvt_pk_bf16(y1[2], y1[3]);
                *(u32x4*)(XB + off + bj * HALF) = w; }
            mx = fmaxf(mx, __shfl_xor(mx, 16)); mx = fmaxf(mx, __shfl_xor(mx, 32));
            if (fq == 0) xl[wc * 256 + ai * HALF + wr * 64 + m * 16 + fr] = __builtin_bit_cast(float, f2bf(mx) << 16);
            asm volatile("" ::: "memory"); }
        __syncthreads();
        { const int tid = threadIdx.x;
          if (tid < 256) { const float v = fmaxf(fmaxf(xl[tid], xl[256 + tid]), fmaxf(xl[512 + tid], xl[768 + tid])); slots[(u.pm * 4 + u.pn) * 256 + tid] = __builtin_bit_cast(unsigned, v); } }
        __syncthreads();
        return 16;
    }
};
}
__device__ __forceinline__ void gla_prep(Frame& F, const Args& A) {
    const int half = F.tid >> 8, dcol = F.tid & 255;
    LAS float* alr_s = (LAS float*)(F.lds) + half * 1024;
    const float* W2 = A.in[IN_WA2]; const float* ALR = WSP(float, WS_ALR); const bf16* KA = WSP(bf16, WS_KA);
    bf16* KDT = WSP(bf16, WS_KDT); float* DEC = WSP(float, WS_DEC);
    float w2[16];
#pragma unroll
    for (int r = 0; r < 16; ++r) w2[r] = W2[r * 256 + dcol];
    const float bb = A.in[IN_BA][dcol];
    for (int it = F.vcu; it < NCHUNK / 2; it += F.G) {
        const int chunk = it * 2 + half; const size_t row0 = (size_t)chunk * CH;
        __syncthreads();
        *(LAS f32x4*)(alr_s + dcol * 4) = *(const f32x4*)(ALR + row0 * 16 + dcol * 4);
        __syncthreads();
        float cum[64]; float run = 0.f;
#pragma unroll
        for (int t = 0; t < 64; ++t) {
            float z = bb;
#pragma unroll
            for (int r4 = 0; r4 < 4; ++r4) { const f32x4 a = *(const LAS f32x4*)(alr_s + t * 16 + r4 * 4); z += a[0] * w2[r4 * 4] + a[1] * w2[r4 * 4 + 1] + a[2] * w2[r4 * 4 + 2] + a[3] * w2[r4 * 4 + 3]; }
            const float ls = fminf(z, 0.f) - 0.6931471805599453f * __builtin_amdgcn_logf(1.0f + __builtin_amdgcn_exp2f(-fabsf(z) * LOG2E));
            run += ls * (1.0f / 16.0f); cum[t] = run;
        }
        const float total = run;
        DEC[(size_t)chunk * 256 + dcol] = __builtin_amdgcn_exp2f(total * LOG2E);
        const int h = dcol >> 6, d = dcol & 63;
        bf16* dst = KDT + (((size_t)chunk * 4 + h) * 64 + d) * 64;
        const bf16* ksrc = KA + row0 * 256 + dcol;
#pragma unroll
        for (int t8 = 0; t8 < 8; ++t8) {
            float kv[8];
#pragma unroll
            for (int j = 0; j < 8; ++j) { const int t = t8 * 8 + j; kv[j] = bf2f(ksrc[(size_t)t * 256]) * __builtin_amdgcn_exp2f((total - cum[t]) * LOG2E); }
            v4u o; o.x = pk2(kv[0], kv[1]); o.y = pk2(kv[2], kv[3]); o.z = pk2(kv[4], kv[5]); o.w = pk2(kv[6], kv[7]);
            *(GAS v4u*)(dst + t8 * 8) = o;
        }
    }
    __syncthreads();
}
namespace gla {
using s16x4 = __attribute__((ext_vector_type(4))) short;
typedef short v4i16_t __attribute__((ext_vector_type(4)));
typedef __attribute__((address_space(3))) const char* lds_cptr;
__device__ __forceinline__ s16x4 vtr(lds_cptr p) { return __builtin_bit_cast(s16x4, __builtin_amdgcn_ds_read_tr16_b64_v4i16((__attribute__((address_space(3))) v4i16_t*)p)); }
__device__ __forceinline__ void glds16(const void* gsrc, unsigned lds_dst) { unsigned keep;
    asm volatile("s_mov_b32 %0, m0\n\ts_mov_b32 m0, %2\n\ts_nop 0\n\tglobal_load_lds_dwordx4 %1, off\n\ts_mov_b32 m0, %0" : "=&s"(keep) : "v"(gsrc), "s"(lds_dst) : "memory"); }
__device__ __forceinline__ unsigned cvtpk(float lo, float hi) { return pg8::cvt_pk_bf16(lo, hi); }
constexpr int L_Q = 0, L_KD = 16384, L_V = 32768, L_R = 65536, L_DEC = 98304, L_OST = 98816, L_RED = 115200, L_END = L_RED + 2048;
struct Ctx { const bf16* KDT; const float* DEC; const bf16* QA; const bf16* VA; const bf16* RA; bf16* OC; };
#define GLA_BAR() asm volatile("s_waitcnt lgkmcnt(0)\n\ts_barrier" ::: "memory")

__device__ __forceinline__ void load_chunk(const Ctx& X, unsigned lds0, int chunk, int h, int ld, int lane, int slot) {
    const size_t row0 = (size_t)chunk * 64;
#pragma unroll
    for (int i = 0; i < 2; ++i) { const int p = 128 * ld + 64 * i + lane, r = p >> 3, cg = (p & 7) ^ (r & 7);
        glds16(X.QA + (row0 + r) * 256 + h * 64 + cg * 8, (unsigned)__builtin_amdgcn_readfirstlane(lds0 + L_Q + slot * 8192 + (128 * ld + 64 * i) * 16));
        glds16(X.KDT + (((size_t)chunk * 4 + h) * 64 + r) * 64 + cg * 8, (unsigned)__builtin_amdgcn_readfirstlane(lds0 + L_KD + slot * 8192 + (128 * ld + 64 * i) * 16)); }
    const size_t voff = (row0 + (lane >> 2)) * 512 + h * 128 + ld * 32 + (lane & 3) * 8;
#pragma unroll
    for (int p = 0; p < 4; ++p) { glds16(X.VA + voff + (size_t)p * 16 * 512, (unsigned)__builtin_amdgcn_readfirstlane(lds0 + L_V + slot * 16384 + ld * 4096 + p * 1024));
                                  glds16(X.RA + voff + (size_t)p * 16 * 512, (unsigned)__builtin_amdgcn_readfirstlane(lds0 + L_R + slot * 16384 + ld * 4096 + p * 1024)); }
}
__device__ __forceinline__ void store_chunk(const Ctx& X, LAS unsigned char* lds, int chunk, int h, int ld, int lane) {
    const size_t row0 = (size_t)chunk * 64; v4u v[4];
#pragma unroll
    for (int p = 0; p < 4; ++p) v[p] = *(const LAS v4u*)(lds + L_OST + ld * 4096 + p * 1024 + lane * 16);
    asm volatile("s_waitcnt lgkmcnt(0)" ::: "memory");
#pragma unroll
    for (int p = 0; p < 4; ++p) *(v4u*)(X.OC + (row0 + 16 * p + (lane >> 2)) * 1024 + h * 128 + ld * 32 + (lane & 3) * 8) = v[p];
}
__device__ __forceinline__ void step_a(LAS unsigned char* lds, int slot, int sl, int lane, f32x16 (&S)[2], f32x16 (&oT)[2]) {
    const int n32 = lane & 31, hi = lane >> 5;
    const LAS float* dsc = (const LAS float*)(lds + L_DEC + slot * 256);
#pragma unroll
    for (int dt = 0; dt < 2; ++dt)
#pragma unroll
        for (int g = 0; g < 4; ++g) { const f32x4 dv = *(const LAS f32x4*)(dsc + 32 * dt + 8 * g + 4 * hi);
#pragma unroll
            for (int j = 0; j < 4; ++j) S[dt][4 * g + j] *= dv[j]; }
    const lds_cptr kdp = (lds_cptr)lds + L_KD + slot * 8192, qp = (lds_cptr)lds + L_Q + slot * 8192;
    const lds_cptr vp = (lds_cptr)lds + L_V + slot * 16384 + sl * 4096 + ((lane >> 4) & 1) * 32 + (lane & 3) * 8 + (8 * hi + ((lane & 15) >> 2)) * 64;
#pragma unroll
    for (int s = 0; s < 4; ++s) { const s16x4 a0 = vtr(vp + s * 1024), a1 = vtr(vp + s * 1024 + 256);
        const bf16x8 vf = (bf16x8){a0[0], a0[1], a0[2], a0[3], a1[0], a1[1], a1[2], a1[3]};
#pragma unroll
        for (int dt = 0; dt < 2; ++dt) { const int d = 32 * dt + n32; const bf16x8 kf = *(const __attribute__((address_space(3))) bf16x8*)(kdp + d * 128 + (((2 * s + hi) ^ (d & 7)) << 4));
            S[dt] = __builtin_amdgcn_mfma_f32_32x32x16_bf16(kf, vf, S[dt], 0, 0, 0); } }
    v4u sa[2][2];
#pragma unroll
    for (int dt = 0; dt < 2; ++dt)
#pragma unroll
        for (int s = 0; s < 2; ++s)
#pragma unroll
            for (int i = 0; i < 4; ++i) sa[dt][s][i] = cvtpk(S[dt][8 * s + 2 * i], S[dt][8 * s + 2 * i + 1]);
#pragma unroll
    for (int tn = 0; tn < 2; ++tn) { const int t = 32 * tn + n32;
#pragma unroll
        for (int r = 0; r < 16; ++r) oT[tn][r] = 0.f;
#pragma unroll
        for (int dt = 0; dt < 2; ++dt)
#pragma unroll
            for (int s = 0; s < 2; ++s) { const int c0 = 4 * dt + 2 * s;
                const v2u q0 = *(const __attribute__((address_space(3))) v2u*)(qp + t * 128 + ((c0 ^ (t & 7)) << 4) + 8 * hi), q1 = *(const __attribute__((address_space(3))) v2u*)(qp + t * 128 + (((c0 + 1) ^ (t & 7)) << 4) + 8 * hi);
                const v4u qq = (v4u){q0[0], q0[1], q1[0], q1[1]};
                oT[tn] = __builtin_amdgcn_mfma_f32_32x32x16_bf16(__builtin_bit_cast(bf16x8, sa[dt][s]), __builtin_bit_cast(bf16x8, qq), oT[tn], 0, 0, 0); } }
    LAS float* red = (LAS float*)(lds + L_RED) + slot * 256;
#pragma unroll
    for (int tn = 0; tn < 2; ++tn) { float ss = 0.f;
#pragma unroll
        for (int r = 0; r < 16; ++r) ss += oT[tn][r] * oT[tn][r];
        { auto rr = __builtin_amdgcn_permlane32_swap(__float_as_uint(ss), __float_as_uint(ss), false, false); ss = __uint_as_float(rr[0]) + __uint_as_float(rr[1]); }
        if (hi == 0) red[sl * 64 + 32 * tn + n32] = ss; }
}
__device__ __forceinline__ void step_b(LAS unsigned char* lds, int slot, int sl, int lane, const f32x16 (&oT)[2], const float (&gg)[16]) {
    const int n32 = lane & 31, hi = lane >> 5;
    const LAS float* red = (const LAS float*)(lds + L_RED) + slot * 256;
#pragma unroll
    for (int tn = 0; tn < 2; ++tn) { const int t = 32 * tn + n32;
        const float tot = (red[t] + red[64 + t]) + (red[128 + t] + red[192 + t]);
        const float rs = 1.0f / sqrtf(tot * (1.0f / 128.0f) + EPS);
        const int toff = sl * 4096 + (t >> 4) * 1024 + (t & 15) * 64 + 8 * hi;
#pragma unroll
        for (int g = 0; g < 4; ++g) { const v2u rw = *(const LAS v2u*)(lds + L_R + slot * 16384 + toff + 16 * g);
            const float y0 = oT[tn][4 * g] * rs * gg[4 * g] * bflo(rw[0]), y1 = oT[tn][4 * g + 1] * rs * gg[4 * g + 1] * bfhi(rw[0]);
            const float y2 = oT[tn][4 * g + 2] * rs * gg[4 * g + 2] * bflo(rw[1]), y3 = oT[tn][4 * g + 3] * rs * gg[4 * g + 3] * bfhi(rw[1]);
            v2u w; w[0] = cvtpk(y0, y1); w[1] = cvtpk(y2, y3); *(LAS v2u*)(lds + L_OST + toff + 16 * g) = w; } }
}
}

__device__ __forceinline__ void gla_scan_mfma(Frame& F, const Args& A) {
    if (F.vcu >= 64) return;
    const gla::Ctx X{WSP(bf16, WS_KDT), WSP(float, WS_DEC), WSP(bf16, WS_QA), WSP(bf16, WS_VA), WSP(bf16, WS_RA), WSP(bf16, WS_OCAT)};
    const int wid = F.wave, lane = F.lane, hi = lane >> 5;
    const int bh = F.vcu, b = bh >> 2, h = bh & 3, c0 = b * NCH;
    const unsigned lds0 = (unsigned)(uintptr_t)F.lds;
    __syncthreads();
    if (wid >= 4) {
        const int ld = wid - 4;
        gla::load_chunk(X, lds0, c0, h, ld, lane, 0);
        float dv = X.DEC[(size_t)c0 * 256 + h * 64 + lane];
        asm volatile("s_waitcnt vmcnt(0)" ::: "memory");
        if (ld == 0) ((LAS float*)(F.lds + gla::L_DEC))[lane] = dv;
        for (int c = 0; c < NCH; ++c) {
            GLA_BAR();
            if (c + 1 < NCH) { gla::load_chunk(X, lds0, c0 + c + 1, h, ld, lane, (c + 1) & 1); dv = X.DEC[(size_t)(c0 + c + 1) * 256 + h * 64 + lane]; }
            if (c > 0) gla::store_chunk(X, F.lds, c0 + c - 1, h, ld, lane);
            GLA_BAR();
            asm volatile("s_waitcnt vmcnt(0)" ::: "memory");
            if (ld == 0 && c + 1 < NCH) ((LAS float*)(F.lds + gla::L_DEC + ((c + 1) & 1) * 256))[lane] = dv;
        }
        GLA_BAR();
        gla::store_chunk(X, F.lds, c0 + NCH - 1, h, ld, lane);
    } else {
        const int sl = wid;
        float gg[16];
#pragma unroll
        for (int r = 0; r < 16; ++r) gg[r] = A.in[IN_GGLA][sl * 32 + (r & 3) + 8 * (r >> 2) + 4 * hi];
        f32x16 S[2], oT[2];
#pragma unroll
        for (int r = 0; r < 16; ++r) { S[0][r] = 0.f; S[1][r] = 0.f; }
        for (int c = 0; c < NCH; ++c) {
            GLA_BAR();
            gla::step_a(F.lds, c & 1, sl, lane, S, oT);
            GLA_BAR();
            gla::step_b(F.lds, c & 1, sl, lane, oT, gg);
        }
        GLA_BAR();
    }
    __syncthreads();
}
__device__ __forceinline__ unsigned f2key(float f) { const unsigned u = __builtin_bit_cast(unsigned, f + 0.0f);     return u ^ ((u >> 31) ? 0xffffffffu : 0x80000000u); }
template <int NREG>
__device__ __forceinline__ unsigned long long radix_select(const unsigned (&key)[NREG], int lane) {
    unsigned prefix = 0u; bool exact = false;
    for (int bit = 31; bit >= 0; --bit) {
        const unsigned cand = prefix | (1u << bit); int cnt = 0;
#pragma unroll
        for (int j = 0; j < NREG; ++j) cnt += __popcll(__ballot(key[j] >= cand));
        if (cnt >= 256) { prefix = cand; if (cnt == 256) { exact = true; break; } }
    }
    int mlo = 0, mhi = 0;
    int cgt = 0;
#pragma unroll
    for (int j = 0; j < NREG; ++j) cgt += __popcll(__ballot(key[j] > prefix));
    int rem = exact ? 0 : 256 - cgt;
#pragma unroll
    for (int j = 0; j < NREG; ++j) {
        const unsigned long long gt = __ballot(exact ? key[j] >= prefix : key[j] > prefix), eq = exact ? 0ull : __ballot(key[j] == prefix);
        unsigned long long w = gt;
        if (eq != 0ull && rem > 0) {
            const int c = __popcll(eq);
            if (c <= rem) { w |= eq; rem -= c; }
            else { const int rank = __popcll(eq & ((1ull << lane) - 1ull)); w |= __ballot(((eq >> lane) & 1ull) && rank < rem); rem = 0; }
        }
        asm volatile("s_nop 4\n\tv_writelane_b32 %0, %2, %4\n\tv_writelane_b32 %1, %3, %4" : "+v"(mlo), "+v"(mhi) : "s"((unsigned)w), "s"((unsigned)(w >> 32)), "i"(j));
    }
    return ((unsigned long long)(unsigned)mhi << 32) | (unsigned)mlo;
}
#define DPP_STEP_U(x, ctrl, rmask) __builtin_amdgcn_update_dpp(0, (int)(x), ctrl, rmask, 0xf, false)
__device__ __forceinline__ unsigned dpp_scan_add(unsigned x) {
    x += (unsigned)DPP_STEP_U(x, 0x111, 0xf); x += (unsigned)DPP_STEP_U(x, 0x112, 0xf); x += (unsigned)DPP_STEP_U(x, 0x114, 0xf); x += (unsigned)DPP_STEP_U(x, 0x118, 0xf);
    x += (unsigned)DPP_STEP_U(x, 0x142, 0xa); x += (unsigned)DPP_STEP_U(x, 0x143, 0xc); return x; }
#define DPP_STEP_F(x, ctrl, rmask) __builtin_bit_cast(float, __builtin_amdgcn_update_dpp((int)0xff800000, __builtin_bit_cast(int, (x)), ctrl, rmask, 0xf, false))
__device__ __forceinline__ float dpp_wave_max(float x) {
    x = fmaxf(x, DPP_STEP_F(x, 0x111, 0xf)); x = fmaxf(x, DPP_STEP_F(x, 0x112, 0xf)); x = fmaxf(x, DPP_STEP_F(x, 0x114, 0xf)); x = fmaxf(x, DPP_STEP_F(x, 0x118, 0xf));
    x = fmaxf(x, DPP_STEP_F(x, 0x142, 0xa)); x = fmaxf(x, DPP_STEP_F(x, 0x143, 0xc));
    return __builtin_bit_cast(float, __builtin_amdgcn_readlane(__builtin_bit_cast(int, x), 63)); }
__device__ __forceinline__ float rl_f(float v, int l) { return __builtin_bit_cast(float, __builtin_amdgcn_readlane(__builtin_bit_cast(int, v), l)); }
__device__ __forceinline__ int rl_i(int v, int l) { return __builtin_amdgcn_readlane(v, l); }
template <int NREG>
__device__ __forceinline__ unsigned long long select_hist(LAS float* sc, int nr_, int lane) {
    const int nr = __builtin_amdgcn_readfirstlane(nr_);
    float s[NREG]; float lo = INFINITY, hi = -INFINITY;
#pragma unroll
    for (int j = 0; j < NREG; ++j) { if (j < NREG - 7 || j < nr) { s[j] = sc[j * 64 + lane]; lo = fminf(lo, s[j]); hi = fmaxf(hi, s[j]); } else s[j] = -INFINITY; }
    hi = dpp_wave_max(hi); lo = -dpp_wave_max(-lo);
    float c1 = 4095.0f / fmaxf(hi - lo, 1e-30f), c0 = -lo * c1;
    LAS unsigned* hist = (LAS unsigned*)sc;
    asm volatile("s_waitcnt lgkmcnt(0)" ::: "memory");
#pragma unroll
    for (int k = 0; k < 16; ++k) *(LAS v4u*)(hist + k * 256 + lane * 4) = (v4u){0u, 0u, 0u, 0u};
    asm volatile("s_waitcnt lgkmcnt(0)" ::: "memory");
#define SEL_BIN(v) ((int)__builtin_amdgcn_fmed3f(__builtin_fmaf((v), c1, c0), 0.0f, 4095.0f))
#pragma unroll
    for (int j = 0; j < NREG; ++j) { if (j < NREG - 7 || j < nr) (void)__hip_atomic_fetch_add(hist + SEL_BIN(s[j]), 1u, __ATOMIC_RELAXED, __HIP_MEMORY_SCOPE_WORKGROUP); }
    asm volatile("s_waitcnt lgkmcnt(0)" ::: "memory");
    unsigned tot = 0u;
#pragma unroll
    for (int k = 0; k < 16; ++k) { const v4u h4 = *(const LAS v4u*)(hist + lane * 64 + k * 4); tot += (h4[0] + h4[1]) + (h4[2] + h4[3]); }
    const unsigned pre = dpp_scan_add(tot); const unsigned all = (unsigned)rl_i((int)pre, 63);
    const unsigned suf = all - pre + tot;
    const unsigned above = suf - tot;
    const unsigned long long m1 = __ballot(above < 256u && suf >= 256u);
    const int Ls = __ffsll((long long)m1) - 1;
    const unsigned aboveL = (unsigned)rl_i((int)above, Ls);
    const unsigned hb = hist[Ls * 64 + lane];
    const unsigned pre2 = dpp_scan_add(hb); const unsigned suf2 = (unsigned)rl_i((int)pre2, 63) - pre2 + hb;
    const unsigned ab2 = aboveL + (suf2 - hb);
    const unsigned long long m2 = __ballot(ab2 < 256u && ab2 + hb >= 256u);
    const int ks = __ffsll((long long)m2) - 1;
    const int bstar = Ls * 64 + ks; const int cab = rl_i((int)ab2, ks); const int nc = rl_i((int)hb, ks); const int need = 256 - cab;
    if (nc > 64) {
        unsigned key[NREG];
#pragma unroll
        for (int j = 0; j < NREG; ++j) key[j] = (s[j] == -INFINITY) ? 0u : f2key(s[j]);
        return radix_select<NREG>(key, lane);
    }
    LAS float* cv = (LAS float*)(hist) ; LAS int* ci = (LAS int*)(hist + 64);
    asm volatile("s_waitcnt lgkmcnt(0)" ::: "memory");
    int base = 0;
    asm volatile("" : "+v"(c0), "+v"(c1));
#pragma unroll
    for (int j = 0; j < NREG; ++j) { if (j < NREG - 7 || j < nr) { const bool inb = SEL_BIN(s[j]) == bstar; const unsigned long long mk = __ballot(inb);
        if (mk) { if (inb) { const int p = base + __popcll(mk & ((1ull << lane) - 1ull)); cv[p] = s[j]; ci[p] = j * 64 + lane; } base += __popcll(mk); } } }
#undef SEL_BIN
    asm volatile("s_waitcnt lgkmcnt(0)" ::: "memory");
    const float myv = lane < nc ? cv[lane] : -INFINITY; const int myi = lane < nc ? ci[lane] : 0x7fffffff;
    int rank = 0;
    for (int k = 0; k < nc; ++k) { const float vk = rl_f(myv, k); const int ik = rl_i(myi, k); rank += (vk > myv || (vk == myv && ik < myi)) ? 1 : 0; }
    const unsigned long long m3 = __ballot(lane < nc && rank == need - 1);
    const int ts = __ffsll((long long)m3) - 1;
    const float vstar = rl_f(myv, ts); const int istar = rl_i(myi, ts);
    const int ties = __popcll(__ballot(lane < nc && myv == vstar));
    int mlo = 0, mhi = 0;
    if (ties == 1) {
#pragma unroll
        for (int j = 0; j < NREG; ++j) { const unsigned long long w = __ballot(s[j] >= vstar);
            asm volatile("s_nop 4\n\tv_writelane_b32 %0, %2, %4\n\tv_writelane_b32 %1, %3, %4" : "+v"(mlo), "+v"(mhi) : "s"((unsigned)w), "s"((unsigned)(w >> 32)), "i"(j)); }
    } else {
#pragma unroll
        for (int j = 0; j < NREG; ++j) { const int idx = j * 64 + lane; const unsigned long long w = __ballot(s[j] > vstar || (s[j] == vstar && idx <= istar));
            asm volatile("s_nop 4\n\tv_writelane_b32 %0, %2, %4\n\tv_writelane_b32 %1, %3, %4" : "+v"(mlo), "+v"(mhi) : "s"((unsigned)w), "s"((unsigned)(w >> 32)), "i"(j)); }
    }
    return ((unsigned long long)(unsigned)mhi << 32) | (unsigned)mlo;
}
__device__ __forceinline__ float dsa_relu(float x) { const int b = __builtin_bit_cast(int, x); return __builtin_bit_cast(float, b > 0 ? b : 0); }
__device__ __forceinline__ void dsa_select_mfma(Frame& F, const Args& A) {
    LAS float* sc = (LAS float*)F.lds;
    const bf16* QI = WSP(bf16, WS_QI); const bf16* KI = WSP(bf16, WS_KI); const float* WI = WSP(float, WS_WI);
    unsigned long long* MASK = WSP(unsigned long long, WS_MASK);
    const int lane = F.lane, n32 = lane & 31, hi = lane >> 5;
    const int qi_m = 2 * ((n32 >> 2) & 1) + (n32 >> 4), hd_m = (n32 & 3) + 4 * ((n32 >> 3) & 1);
    for (int u = F.vcu; u < 8192; u += F.G) {
        const int g = u & 7, rest = u >> 3, b = rest & 15;
        int i = rest >> 4;
        if (F.G == 256) i ^= (u >> 8) & 1;

        const int N = (i + 1) * 64; const size_t seq0 = (size_t)b * SEQ; const size_t q0 = seq0 + (size_t)i * 64 + g * 8;
        if (i < 4) {
            const size_t r = q0 + F.wave; const int nw = N >> 6;
            MASK[r * 64 + lane] = (lane < nw) ? ~0ull : 0ull;
            continue;
        }
        bf16x8 aq[2][2]; f32x4 wv[2][4];
#pragma unroll
        for (int mt = 0; mt < 2; ++mt) {
#pragma unroll
            for (int s = 0; s < 2; ++s) aq[mt][s] = *(const bf16x8*)(QI + (q0 + 4 * mt + qi_m) * 256 + hd_m * 32 + 16 * s + 8 * hi);
#pragma unroll
            for (int c = 0; c < 4; ++c) wv[mt][c] = *(const f32x4*)(WI + (q0 + 4 * mt + 2 * hi) * 8 + 4 * c);
        }
        __syncthreads();
        const int nj = N / 32;
        bf16x8 nb0, nb1;
        { const int key = 32 * F.wave + n32; nb0 = *(const bf16x8*)(KI + (seq0 + key) * 32 + 8 * hi); nb1 = *(const bf16x8*)(KI + (seq0 + key) * 32 + 16 + 8 * hi); }
        for (int j = F.wave; j < nj; j += 8) {
            const int key = 32 * j + n32;
            const bf16x8 bk0 = nb0, bk1 = nb1;
            { const int jn = (j + 8 < nj) ? j + 8 : j; const int kn = 32 * jn + n32; nb0 = *(const bf16x8*)(KI + (seq0 + kn) * 32 + 8 * hi); nb1 = *(const bf16x8*)(KI + (seq0 + kn) * 32 + 16 + 8 * hi); }
            f32x16 a0, a1;
#pragma unroll
            for (int r = 0; r < 16; ++r) { a0[r] = 0.f; a1[r] = 0.f; }
            a0 = __builtin_amdgcn_mfma_f32_32x32x16_bf16(aq[0][0], bk0, a0, 0, 0, 0); a0 = __builtin_amdgcn_mfma_f32_32x32x16_bf16(aq[0][1], bk1, a0, 0, 0, 0);
            a1 = __builtin_amdgcn_mfma_f32_32x32x16_bf16(aq[1][0], bk0, a1, 0, 0, 0); a1 = __builtin_amdgcn_mfma_f32_32x32x16_bf16(aq[1][1], bk1, a1, 0, 0, 0);
            float s00 = 0.f, s01 = 0.f, s10 = 0.f, s11 = 0.f;
#pragma unroll
            for (int r = 0; r < 8; ++r) { s00 += wv[0][r >> 2][r & 3] * dsa_relu(a0[r]); s01 += wv[0][2 + (r >> 2)][r & 3] * dsa_relu(a0[8 + r]);
                                          s10 += wv[1][r >> 2][r & 3] * dsa_relu(a1[r]); s11 += wv[1][2 + (r >> 2)][r & 3] * dsa_relu(a1[8 + r]); }
            sc[(2 * hi) * 4096 + key] = s00 + 0.0f; sc[(2 * hi + 1) * 4096 + key] = s01 + 0.0f; sc[(4 + 2 * hi) * 4096 + key] = s10 + 0.0f; sc[(5 + 2 * hi) * 4096 + key] = s11 + 0.0f;
        }
        __syncthreads();
        unsigned long long w;
        LAS float* my = sc + F.wave * 4096;
        switch ((i + 8) >> 3) {
            case 1: w = select_hist<8>(my, i + 1, lane); break;
            case 2: w = select_hist<16>(my, i + 1, lane); break;
            case 3: w = select_hist<24>(my, i + 1, lane); break;
            case 4: w = select_hist<32>(my, i + 1, lane); break;
            case 5: w = select_hist<40>(my, i + 1, lane); break;
            case 6: w = select_hist<48>(my, i + 1, lane); break;
            case 7: w = select_hist<56>(my, i + 1, lane); break;
            default: w = select_hist<64>(my, i + 1, lane); break;
        }
        MASK[(q0 + F.wave) * 64 + lane] = w;
    }
    __syncthreads();
}

__device__ __forceinline__ int t5_bucket(int rel) {
    const int n = rel < 0 ? -rel : rel;
    const int v = n < 8 ? n : 8 + (n >= 12) + (n >= 16) + (n >= 23) + (n >= 32) + (n >= 46) + (n >= 64) + (n >= 91);
    return (rel > 0 ? 16 : 0) + v;
}
namespace att {
using s16x4 = __attribute__((ext_vector_type(4))) short;
typedef short v4i16_t __attribute__((ext_vector_type(4)));
constexpr int SLOTB = 8192, LDS_K = 0  , LDS_V = 4 * SLOTB  , LDS_TBL = 6 * SLOTB  , LDS_WS = LDS_TBL + 8 * 2048, LDS_OST = LDS_WS + 8 * 64 * 4, LDS_Q = LDS_OST + 8 * 4096  , LDS_END = LDS_Q + 16;
__device__ __forceinline__ int crow(int r, int hi) { return (r & 3) + 8 * (r >> 2) + 4 * hi; }
__device__ __forceinline__ void glds16(const void* gsrc, unsigned lds_dst) { unsigned keep;
    asm volatile("s_mov_b32 %0, m0\n\ts_mov_b32 m0, %2\n\ts_nop 0\n\tglobal_load_lds_dwordx4 %1, off\n\ts_mov_b32 m0, %0" : "=&s"(keep) : "v"(gsrc), "s"(lds_dst) : "memory"); }
__device__ __forceinline__ void gload8(unsigned long long& dst, const void* gsrc) { asm volatile("global_load_dwordx2 %0, %1, off" : "=v"(dst) : "v"(gsrc) : "memory"); }
typedef __attribute__((address_space(3))) const char* lds_cptr;
__device__ __forceinline__ s16x4 vtr(lds_cptr p) { return __builtin_bit_cast(s16x4, __builtin_amdgcn_ds_read_tr16_b64_v4i16((__attribute__((address_space(3))) v4i16_t*)p)); }
__device__ __forceinline__ unsigned cvtpk(float lo, float hi) { return pg8::cvt_pk_bf16(lo, hi); }

__device__ __forceinline__ void tile_qk(f32x16& p0, f32x16& p1, const bf16x8 (&qr)[4], lds_cptr kb, float cinit) {
#pragma unroll
    for (int r = 0; r < 16; ++r) { p0[r] = cinit; p1[r] = cinit; }
#pragma unroll
    for (int d0 = 0; d0 < 4; ++d0) {
        const bf16x8 b0 = *(const __attribute__((address_space(3))) bf16x8*)(kb + d0 * 2048);
        const bf16x8 b1 = *(const __attribute__((address_space(3))) bf16x8*)(kb + d0 * 2048 + 512);
        p0 = __builtin_amdgcn_mfma_f32_32x32x16_bf16(b0, qr[d0], p0, 0, 0, 0);
        p1 = __builtin_amdgcn_mfma_f32_32x32x16_bf16(b1, qr[d0], p1, 0, 0, 0);
    }
}
template <bool NEAR>
__device__ __forceinline__ void tile_sm_pv(f32x16& o0, f32x16& o1, float& l, f32x16& p0, f32x16& p1, lds_cptr vp, unsigned long long wcur, int hi, const LAS float* tb) {
    const unsigned wl = (unsigned)wcur >> (4 * hi), wh = (unsigned)(wcur >> 32) >> (4 * hi);
    float ls = 0.f;
#define ATT_SM_ELEM(r) do { constexpr int bp = ((r) & 3) + 8 * ((r) >> 2); float a = p0[r], b = p1[r]; \
        if (NEAR) { a += tb[bp]; b += tb[32 + bp]; } \
        a = __builtin_amdgcn_exp2f(a); b = __builtin_amdgcn_exp2f(b); \
        int m0, m1; asm("v_bfe_i32 %0, %1, %2, 1" : "=v"(m0) : "v"(wl), "n"(bp)); asm("v_bfe_i32 %0, %1, %2, 1" : "=v"(m1) : "v"(wh), "n"(bp)); \
        a = __builtin_bit_cast(float, __builtin_bit_cast(unsigned, a) & (unsigned)m0); b = __builtin_bit_cast(float, __builtin_bit_cast(unsigned, b) & (unsigned)m1); \
        p0[r] = a; p1[r] = b; ls += a + b; } while (0)
    ATT_SM_ELEM(0); ATT_SM_ELEM(1); ATT_SM_ELEM(2); ATT_SM_ELEM(3); ATT_SM_ELEM(4); ATT_SM_ELEM(5); ATT_SM_ELEM(6); ATT_SM_ELEM(7);
    ATT_SM_ELEM(8); ATT_SM_ELEM(9); ATT_SM_ELEM(10); ATT_SM_ELEM(11); ATT_SM_ELEM(12); ATT_SM_ELEM(13); ATT_SM_ELEM(14); ATT_SM_ELEM(15);
#undef ATT_SM_ELEM
    l += ls;
    v4u pw[4];
#pragma unroll
    for (int i = 0; i < 4; ++i) { pw[0][i] = cvtpk(p0[2 * i], p0[2 * i + 1]); pw[1][i] = cvtpk(p0[8 + 2 * i], p0[9 + 2 * i]); pw[2][i] = cvtpk(p1[2 * i], p1[2 * i + 1]); pw[3][i] = cvtpk(p1[8 + 2 * i], p1[9 + 2 * i]); }
#pragma unroll
    for (int ks = 0; ks < 4; ++ks) {
        const s16x4 a0 = vtr(vp + ks * 1024), a1 = vtr(vp + ks * 1024 + 512), c0 = vtr(vp + 4096 + ks * 1024), c1 = vtr(vp + 4096 + ks * 1024 + 512);
        const bf16x8 v0 = (bf16x8){a0[0], a0[1], a0[2], a0[3], a1[0], a1[1], a1[2], a1[3]}, v1 = (bf16x8){c0[0], c0[1], c0[2], c0[3], c1[0], c1[1], c1[2], c1[3]};
        const bf16x8 pa = __builtin_bit_cast(bf16x8, pw[ks]);
        o0 = __builtin_amdgcn_mfma_f32_32x32x16_bf16(pa, v0, o0, 0, 0, 0);
        o1 = __builtin_amdgcn_mfma_f32_32x32x16_bf16(pa, v1, o1, 0, 0, 0);
    }
}

__device__ __forceinline__ void attn_unit(LAS unsigned char* lds, int b, int h, int qb, float cfar, float cnear, const bf16* QB, const bf16* KB, const bf16* VB, const unsigned long long* MASK, bf16* OC) {
    const int tid = threadIdx.x, lane = tid & 63, r32 = lane & 31, hi = lane >> 5; const int wid = __builtin_amdgcn_readfirstlane(tid >> 6);
    const size_t rowbase = (size_t)b * SEQ; const int q0 = qb * 256; const int myq = q0 + wid * 32 + r32;
    const bf16* Qw = QB + (rowbase + myq) * 512 + h * 64;
    const bf16* ksrc = KB + (rowbase + lane) * 512 + h * 64 + wid * 8;
    const bf16* vsrc = VB + (rowbase + 16 * (wid & 3) + (lane >> 2)) * 512 + h * 64 + (wid >> 2) * 32 + (lane & 3) * 8;
    const unsigned long long* msrc = MASK + (rowbase + myq) * 64;
    const unsigned lds0 = (unsigned)(uintptr_t)lds;
    const unsigned kdst = lds0 + LDS_K + wid * 1024, vdst = lds0 + LDS_V + wid * 1024;
    const lds_cptr l3 = (lds_cptr)lds;
    const lds_cptr kb0 = l3 + LDS_K + hi * 1024 + r32 * 16;
    const lds_cptr vp0 = l3 + LDS_V + ((lane >> 4) & 1) * 32 + (lane & 3) * 8 + (4 * hi + ((lane & 15) >> 2)) * 64;
    const LAS float* tbl = (const LAS float*)(lds + LDS_TBL) + h * 512;
    LAS float* wsf = (LAS float*)(lds + LDS_WS) + wid * 64;
    const int NT = 4 * (qb + 1);
    const int nfar_ = (q0 + 32 * wid - 154 >= 0) ? ((q0 + 32 * wid - 154) >> 6) + 1 : 0; const int nfar = nfar_ < NT ? nfar_ : NT;
    bf16x8 qr[4];
#pragma unroll
    for (int d0 = 0; d0 < 4; ++d0) qr[d0] = *(const bf16x8*)(Qw + d0 * 16 + hi * 8);
    f32x16 o0, o1;
#pragma unroll
    for (int r = 0; r < 16; ++r) { o0[r] = 0.f; o1[r] = 0.f; }
    float l = 0.f;
    unsigned long long wA, wB;
    const unsigned kd0 = (unsigned)__builtin_amdgcn_readfirstlane(kdst), vd0 = (unsigned)__builtin_amdgcn_readfirstlane(vdst);
#define ATT_WAITBAR(w) asm volatile("s_waitcnt vmcnt(0) lgkmcnt(0)\n\ts_barrier" : "+v"(w) :: "memory")
#define ATT_DMA_K(tt) glds16(ksrc + (size_t)(tt) * 64 * 512, kd0 + ((tt) & 3) * SLOTB)
#define ATT_DMA_V(tt) glds16(vsrc + (size_t)(tt) * 64 * 512, vd0 + ((tt) & 1) * SLOTB)
#define ATT_CINIT(tt) (((tt) < nfar) ? cfar : cnear)
#define ATT_SMPV(tt, P0, P1, w) do { if ((tt) < nfar) tile_sm_pv<false>(o0, o1, l, P0, P1, vp0 + ((tt) & 1) * SLOTB, w, hi, tbl); \
        else tile_sm_pv<true>(o0, o1, l, P0, P1, vp0 + ((tt) & 1) * SLOTB, w, hi, tbl + ((tt) * 64 + 4 * hi - myq + 447)); } while (0)
    f32x16 sA0, sA1, sB0, sB1;
    ATT_DMA_K(0); ATT_DMA_V(0); gload8(wA, msrc); ATT_DMA_K(1);
    ATT_WAITBAR(wA);
    tile_qk(sA0, sA1, qr, kb0, ATT_CINIT(0));
    for (int t = 0; t < NT; t += 2) {
        if (t > 0) ATT_WAITBAR(wA);
        if (t + 2 < NT) ATT_DMA_K(t + 2);
        ATT_DMA_V(t + 1); gload8(wB, msrc + (t + 1));
        tile_qk(sB0, sB1, qr, kb0 + ((t + 1) & 3) * SLOTB, ATT_CINIT(t + 1));
        ATT_SMPV(t, sA0, sA1, wA);
        ATT_WAITBAR(wB);
        if (t + 3 < NT) ATT_DMA_K(t + 3);
        if (t + 2 < NT) { ATT_DMA_V(t + 2); gload8(wA, msrc + (t + 2)); tile_qk(sA0, sA1, qr, kb0 + ((t + 2) & 3) * SLOTB, ATT_CINIT(t + 2)); }
        ATT_SMPV(t + 1, sB0, sB1, wB);
    }
#undef ATT_WAITBAR
#undef ATT_DMA_K
#undef ATT_DMA_V
#undef ATT_CINIT
#undef ATT_SMPV
    { auto rr = __builtin_amdgcn_permlane32_swap(__float_as_uint(l), __float_as_uint(l), false, false); l = __uint_as_float(rr[0]) + __uint_as_float(rr[1]); }
    if (hi == 0) wsf[32 + r32] = l; asm volatile("s_waitcnt lgkmcnt(0)" ::: "memory");
    float rli[16];
#pragma unroll
    for (int r = 0; r < 16; ++r) rli[r] = __builtin_amdgcn_rcpf(wsf[32 + crow(r, hi)]);
    bf16* Ow = OC + (rowbase + q0 + wid * 32) * 1024 + 512 + h * 64;
    { LAS bf16* stg = (LAS bf16*)(lds + LDS_OST) + wid * 2048;
#pragma unroll
      for (int r = 0; r < 16; ++r) { const int orow = crow(r, hi); stg[orow * 64 + r32] = (bf16)f2bf(o0[r] * rli[r]); stg[orow * 64 + 32 + r32] = (bf16)f2bf(o1[r] * rli[r]); }
      asm volatile("s_waitcnt lgkmcnt(0)" ::: "memory");
#pragma unroll
      for (int i = 0; i < 4; ++i) { const int row = i * 8 + (lane >> 3), ch = lane & 7; const v4u v = *(const LAS v4u*)(stg + row * 64 + ch * 8); *(v4u*)(Ow + (size_t)row * 1024 + ch * 8) = v; } }
    asm volatile("s_waitcnt lgkmcnt(0)\n\ts_barrier" ::: "memory");
}
}

__device__ __forceinline__ void dsa_attn_mfma(Frame& F, const Args& A) {
    LAS float* tbl = (LAS float*)(F.lds + att::LDS_TBL);
    volatile LAS int* qw = (volatile LAS int*)(F.lds + att::LDS_Q);
    const bf16* QB = WSP(bf16, WS_QB); const bf16* KB = WSP(bf16, WS_KB); const bf16* VB = WSP(bf16, WS_VB);
    const unsigned long long* MASK = WSP(unsigned long long, WS_MASK); bf16* OC = WSP(bf16, WS_OCAT);
    const float* relb = A.in[IN_RELB];
    float mq = 0.f, mk = 0.f, mb = 0.f;
    { mq = fabsf(A.in[IN_GQ][F.lane]); mk = fabsf(A.in[IN_GK][F.lane]); mb = fmaxf(fmaxf(fabsf(relb[F.lane]), fabsf(relb[64 + F.lane])), fmaxf(fabsf(relb[128 + F.lane]), fabsf(relb[192 + F.lane])));
      mq = wave_max(mq); mk = wave_max(mk); mb = wave_max(mb); }
    const float ref = 8.0f * LOG2E * mq * mk + LOG2E * mb;
    __syncthreads();
    for (int i = F.tid; i < 8 * 512; i += 512) { const int hh = i >> 9, j = i & 511; tbl[i] = (j < 511) ? relb[t5_bucket(j - 447) * 8 + hh] * LOG2E : 0.f; }
    __syncthreads();
    gu32* qctr = F.ctl + CW_ATTQ;
    for (;;) {
        if (F.tid == 0) qw[0] = (int)__hip_atomic_fetch_add(qctr, 1u, RLX_AGENT);
        __syncthreads();
        const int u = qw[0];
        __syncthreads();
        if (u >= 2048) break;
        const int qb = 15 - (u >> 7), bh = u & 127, b = bh >> 3, h = bh & 7;
        const float cnear = -ref, cfar = -ref + relb[15 * 8 + h] * LOG2E;
        att::attn_unit(F.lds, b, h, qb, cfar, cnear, QB, KB, VB, MASK, OC);
    }
    __syncthreads();
}
__device__ __forceinline__ void moe_route_mfma(Frame& F, const Args& A) {
    const bf16* XB = WSP(bf16, WS_H2); const bf16* WRH = WSP(bf16, WS_WR); const bf16* WRL = WRH + 64 * D;
    unsigned* ME = WSP(unsigned, WS_META); float* MC = (float*)(F.ws + WS_META + 512 * 1024); float* MRS = WSP(float, WS_MRS);
    const int lane = F.lane, n32 = lane & 31, hi = lane >> 5;
    LAS float* lg = (LAS float*)F.lds + F.wave * 2048;
    LAS int* lcnt = (LAS int*)(F.lds + XTRA_OFF); LAS int* lbase = lcnt + 128; int* POSC = (int*)(F.ws + WS_META + 256 * 1024);
    if (F.tid < 128) lcnt[F.tid] = 0;
    LAS unsigned char* wl = F.lds + RING_OFF; constexpr int WPITCH = 2048;
    for (int tile = F.vcu * NWAVES + F.wave; tile < M / 32; tile += F.G * NWAVES) {
        __syncthreads();
#pragma unroll 4
        for (int i = 0; i < 16; ++i) { const int p = F.tid + 512 * i, row = p >> 7, c16 = p & 127;
            const v4u v = *(const GAS v4u*)((row < 32 ? WRH + (size_t)row * D : WRL + (size_t)(row - 32) * D) + 8 * c16);
            *(LAS v4u*)(wl + row * WPITCH + 16 * (c16 ^ (row & 7))) = v; }
        __syncthreads();
        const size_t t0 = (size_t)tile * 32;
        const bf16* xp = XB + (t0 + n32) * D + 8 * hi;
        const bf16* bh = WRH + (size_t)n32 * D + 8 * hi; const bf16* bl = WRL + (size_t)n32 * D + 8 * hi;
        f32x16 acc0, acc1;
#pragma unroll
        for (int r = 0; r < 16; ++r) { acc0[r] = 0.f; acc1[r] = 0.f; }
        float ss = 0.f;
        float ra; { const unsigned* sl = WSP(const unsigned, WS_SLOT2) + ((t0 + n32) >> 8) * 1024 + ((t0 + n32) & 255);
            ra = fmaxf(fmaxf(__builtin_bit_cast(float, sl[0]), __builtin_bit_cast(float, sl[256])), fmaxf(__builtin_bit_cast(float, sl[512]), __builtin_bit_cast(float, sl[768]))); }
        const float qinv = ra > 0.f ? 127.0f / ra : 0.f;
        if (hi == 0) WSP(float, WS_XS8)[t0 + n32] = ra * (1.0f / 127.0f);
        unsigned char* x8 = F.ws + WS_XB8 + (t0 + n32) * D + 16 * hi; v4u q8;
        v4u xs[4]; bf16x8 wq[4][4];
#define RT_LOAD(sl, s) do { xs[sl] = *(const v4u*)(xp + 16 * (s)); \
                            wq[sl][1] = (bf16x8){0, 0, 0, 0, 0, 0, 0, 0}; wq[sl][3] = (bf16x8){0, 0, 0, 0, 0, 0, 0, 0}; \
                            if (n32 < 4) { wq[sl][1] = *(const bf16x8*)(bh + 32 * D + 16 * (s)); wq[sl][3] = *(const bf16x8*)(bl + 32 * D + 16 * (s)); } } while (0)
        RT_LOAD(0, 0); RT_LOAD(1, 1); RT_LOAD(2, 2);
        for (int s4 = 0; s4 < 64; s4 += 4) {
#pragma unroll
            for (int u4 = 0; u4 < 4; ++u4) { const int s = s4 + u4;
                if (s + 3 < 64) RT_LOAD((u4 + 3) & 3, s + 3);
                asm volatile("" ::: "memory");
                const v4u xw = xs[u4];
                {
                    unsigned b0 = 0u, b1 = 0u;
                    b0 = __builtin_amdgcn_cvt_pk_u8_f32(__builtin_rintf(__builtin_fmaf(bflo(xw[0]), qinv, 128.0f)), 0, b0); b0 = __builtin_amdgcn_cvt_pk_u8_f32(__builtin_rintf(__builtin_fmaf(bfhi(xw[0]), qinv, 128.0f)), 1, b0);
                    b0 = __builtin_amdgcn_cvt_pk_u8_f32(__builtin_rintf(__builtin_fmaf(bflo(xw[1]), qinv, 128.0f)), 2, b0); b0 = __builtin_amdgcn_cvt_pk_u8_f32(__builtin_rintf(__builtin_fmaf(bfhi(xw[1]), qinv, 128.0f)), 3, b0);
                    b1 = __builtin_amdgcn_cvt_pk_u8_f32(__builtin_rintf(__builtin_fmaf(bflo(xw[2]), qinv, 128.0f)), 0, b1); b1 = __builtin_amdgcn_cvt_pk_u8_f32(__builtin_rintf(__builtin_fmaf(bfhi(xw[2]), qinv, 128.0f)), 1, b1);
                    b1 = __builtin_amdgcn_cvt_pk_u8_f32(__builtin_rintf(__builtin_fmaf(bflo(xw[3]), qinv, 128.0f)), 2, b1); b1 = __builtin_amdgcn_cvt_pk_u8_f32(__builtin_rintf(__builtin_fmaf(bfhi(xw[3]), qinv, 128.0f)), 3, b1);
                    if ((u4 & 1) == 0) { q8.x = b0 ^ 0x80808080u; q8.y = b1 ^ 0x80808080u; } else { q8.z = b0 ^ 0x80808080u; q8.w = b1 ^ 0x80808080u; *(v4u*)(x8 + 32 * (s >> 1)) = q8; } }
#pragma unroll
                for (int j = 0; j < 4; ++j) { const float a = bflo(xw[j]), b = bfhi(xw[j]); ss += a * a + b * b; }
                const bf16x8 Ah = __builtin_bit_cast(bf16x8, xw);
                const bf16x8 w0h = *(const LAS bf16x8*)(wl + n32 * WPITCH + 16 * ((2 * s + hi) ^ (n32 & 7))), w0l = *(const LAS bf16x8*)(wl + (32 + n32) * WPITCH + 16 * ((2 * s + hi) ^ (n32 & 7)));
                acc0 = __builtin_amdgcn_mfma_f32_32x32x16_bf16(Ah, w0h, acc0, 0, 0, 0); acc1 = __builtin_amdgcn_mfma_f32_32x32x16_bf16(Ah, wq[u4][1], acc1, 0, 0, 0);
                acc0 = __builtin_amdgcn_mfma_f32_32x32x16_bf16(Ah, w0l, acc0, 0, 0, 0); acc1 = __builtin_amdgcn_mfma_f32_32x32x16_bf16(Ah, wq[u4][3], acc1, 0, 0, 0);
            }
        }
#undef RT_LOAD
        ss += __shfl_xor(ss, 32);
        const float rs = 1.0f / sqrtf(ss * (1.f / D) + EPS);
        __syncthreads();
#pragma unroll
        for (int r = 0; r < 16; ++r) { const int tk = (r & 3) + 8 * (r >> 2) + 4 * hi; lg[tk * 64 + n32] = acc0[r]; lg[tk * 64 + 32 + n32] = acc1[r]; }
        LDS_WAIT(); asm volatile("" ::: "memory");
        if (hi == 0) {
            const size_t r = t0 + n32; const LAS float* my = lg + n32 * 64;
            float gl[4];
#pragma unroll
            for (int c = 0; c < 4; ++c) gl[c] = my[c] * rs + A.in[IN_BRG][c];
            int gs = 0; float gm = gl[0];
#pragma unroll
            for (int c = 1; c < 4; ++c) if (gl[c] > gm) { gm = gl[c]; gs = c; }
            float den = 0.f;
#pragma unroll
            for (int c = 0; c < 4; ++c) den += __expf(gl[c] - gm);
            const float gw = 1.0f / den;
            float el[8];
#pragma unroll
            for (int c = 0; c < 8; ++c) el[c] = my[4 + gs * 8 + c] * rs + A.in[IN_BRE][gs * 8 + c];
            int i0 = 0; float v0 = el[0];
#pragma unroll
            for (int c = 1; c < 8; ++c) if (el[c] > v0) { v0 = el[c]; i0 = c; }
            int i1 = -1; float v1 = -INFINITY;
#pragma unroll
            for (int c = 0; c < 8; ++c) if (c != i0 && el[c] > v1) { v1 = el[c]; i1 = c; }
            const float p1 = 1.0f / (1.0f + __expf(v0 - v1)), p0 = 1.0f - p1;
            const float c0 = p0 * gw, c1 = p1 * gw;
            const int a = i0 < i1 ? i0 : i1, bq = i0 < i1 ? i1 : i0; const float ca = i0 < i1 ? c0 : c1, cb = i0 < i1 ? c1 : c0;
            const int cls = gs * 28 + (a * (15 - a)) / 2 + (bq - a - 1);
            ME[r] = (unsigned)(gs * 8 + a) | ((unsigned)(gs * 8 + bq) << 8) | ((unsigned)cls << 16); MC[r * 2] = ca; MC[r * 2 + 1] = cb; MRS[r] = rs;
            POSC[r] = __hip_atomic_fetch_add(lcnt + cls, 1, __ATOMIC_RELAXED, __HIP_MEMORY_SCOPE_WORKGROUP);
        }
        LDS_WAIT(); asm volatile("" ::: "memory");
    }
    __syncthreads();
    if (F.tid < NCLASS) { const int n = lcnt[F.tid]; lbase[F.tid] = n ? (int)__hip_atomic_fetch_add(F.ctl + CW_CLS + F.tid, (unsigned)n, RLX_AGENT) : 0; }
    __syncthreads();
    for (int tile = F.vcu * NWAVES + F.wave; tile < M / 32; tile += F.G * NWAVES) {
        if (hi == 0) { const size_t r = (size_t)tile * 32 + n32; POSC[r] += lbase[ME[r] >> 16]; } }
    __syncthreads();
}
constexpr size_t WS_TILEE = WS_TOK + 512 * 1024, WS_NT = WS_TOK + 768 * 1024;
__device__ __forceinline__ void moe_assign(Frame& F, const Args& A) {
    LAS int* off_s = (LAS int*)F.lds; LAS int* cnt_s = off_s + 128;
    gu32* cnt = F.ctl + CW_CLS;
    int* TOK = WSP(int, WS_TOK); unsigned* TILEE = WSP(unsigned, WS_TILEE); int* NT = WSP(int, WS_NT); const unsigned* ME = WSP(unsigned, WS_META);
    __syncthreads();
    if (F.tid < NCLASS) cnt_s[F.tid] = (int)__hip_atomic_load(cnt + F.tid, RLX_AGENT);
    __syncthreads();
    if (F.tid == 0) { int o = 0; for (int c = 0; c < NCLASS; ++c) { off_s[c] = o; o += (cnt_s[c] + 255) & ~255; } off_s[NCLASS] = o; }
    __syncthreads();
    for (int r = F.vcu * 512 + F.tid; r < M; r += F.G * 512) { const int cls = (int)(ME[r] >> 16); const int pos = off_s[cls] + WSP(const int, WS_META + 256 * 1024)[r]; TOK[pos] = r; }
    for (int c = F.vcu; c < NCLASS; c += F.G) {
        const int lo = off_s[c] + cnt_s[c], hi = off_s[c + 1];
        for (int p = lo + F.tid; p < hi; p += 512) TOK[p] = -1;
        const int g = c / 28; int pi = c % 28, a = 0; while (pi >= 7 - a) { pi -= 7 - a; ++a; } const int b = a + 1 + pi;
        const unsigned ee = (unsigned)(g * 8 + a) | ((unsigned)(g * 8 + b) << 8);
        for (int t = off_s[c] / 256 + F.tid; t < off_s[c + 1] / 256; t += 512) TILEE[t] = ee;
    }
    if (F.vcu == 0 && F.tid == 0) NT[0] = off_s[NCLASS] / 256;
    __syncthreads();
}
namespace pg8 {
struct MoeUpOrder {
    static constexpr bool GATHER = true, SPLITB = false;
    int nT, G, c; const int* TOK; const unsigned* TILEE; const bf16_t* WGU;
    __device__ bool next(int i, Unit& u) const { const long L = (long)i * G + c; if (L >= 2L * nT) return false; tile_of((int)L, nT, 2, u.pm, u.pn); u.sel = (int)TILEE[u.pm]; return true; }
    __device__ __forceinline__ const char* baseA(const Gemm& g, const Unit&) const { return (const char*)g.A; }
    __device__ __forceinline__ const char* baseB(const Gemm& g, const Unit& u) const { const int e = (u.pn ? (u.sel >> 8) : u.sel) & 255; return (const char*)WGU + (size_t)e * 256 * g.ldb * 2; }
    __device__ __forceinline__ int row(const Unit& u, int r) const { const int t = TOK[u.pm * BM + r]; return t < 0 ? 0 : t; }
};
struct EpiMoeUp {
    static constexpr bool PERM = true;
    const int* TOK; const float* MC; const float* MRS; bf16_t* HID; const float* XS; const float* CSU;
    __device__ __forceinline__ int operator()(const f32x4 (&acc)[2][2][4][2], const Unit& u, int wr, int wc, int fr, int fq) const {
        { int l; asm volatile("v_mbcnt_lo_u32_b32 %0, -1, 0\n\tv_mbcnt_hi_u32_b32 %0, -1, %0" : "=v"(l)); fr = l & 15; fq = l >> 4; }
        const int pos0 = u.pm * BM + wr * 64 + fr; const int e = (u.pn ? (u.sel >> 8) : u.sel) & 255;
        f32x4 csc[2][2];
#pragma unroll
        for (int bj = 0; bj < 2; ++bj)
#pragma unroll
            for (int n = 0; n < 2; ++n) csc[bj][n] = *(const f32x4*)(CSU + e * 256 + bj * HALF + wc * 32 + 8 * fq + 4 * n);
#pragma unroll
        for (int ai = 0; ai < 2; ++ai)
#pragma unroll
            for (int m = 0; m < 4; ++m) { const int pos = pos0 + ai * HALF + m * 16; const int tok = TOK[pos]; const float cw = tok >= 0 ? MC[(size_t)tok * 2 + u.pn] : 0.f; const float rs = tok >= 0 ? MRS[tok] * XS[tok] : 0.f;
                const f32x4 g0 = __builtin_convertvector(__builtin_bit_cast(i32x4, acc[ai][0][m][0]), f32x4) * csc[0][0], g1 = __builtin_convertvector(__builtin_bit_cast(i32x4, acc[ai][0][m][1]), f32x4) * csc[0][1];
                const f32x4 u0 = __builtin_convertvector(__builtin_bit_cast(i32x4, acc[ai][1][m][0]), f32x4) * csc[1][0], u1 = __builtin_convertvector(__builtin_bit_cast(i32x4, acc[ai][1][m][1]), f32x4) * csc[1][1]; float h[8];
#pragma unroll
                for (int j = 0; j < 4; ++j) { h[j] = cw * siluf_(rs * g0[j]) * (rs * u0[j]); h[4 + j] = cw * siluf_(rs * g1[j]) * (rs * u1[j]); }
                u32x4 w; w.x = cvt_pk_bf16(h[0], h[1]); w.y = cvt_pk_bf16(h[2], h[3]); w.z = cvt_pk_bf16(h[4], h[5]); w.w = cvt_pk_bf16(h[6], h[7]);
                *(u32x4*)(HID + (size_t)pos * 256 + u.pn * 128 + wc * 32 + 8 * fq) = w; }
        return 8;
    }
};
struct MoeDownOrder {
    static constexpr bool GATHER = false, SPLITB = true;
    int nT, G, c; const unsigned* TILEE; const bf16_t* WD;
    __device__ bool next(int i, Unit& u) const { const long L = (long)i * G + c; if (L >= 4L * nT) return false; tile_of((int)L, nT, 4, u.pm, u.pn); u.sel = (int)TILEE[u.pm]; return true; }
    __device__ __forceinline__ const char* baseA(const Gemm& g, const Unit& u) const { return (const char*)g.A + (size_t)u.pm * BM * g.lda * 2; }
    __device__ __forceinline__ const char* baseB(const Gemm&, const Unit& u) const { return (const char*)WD + ((size_t)(u.sel & 255) * 1024 + (size_t)u.pn * BM) * 128 * 2; }
    __device__ __forceinline__ const char* baseB2(const Gemm&, const Unit& u) const { return (const char*)WD + ((size_t)((u.sel >> 8) & 255) * 1024 + (size_t)u.pn * BM) * 128 * 2; }
};
struct EpiMoeDown {
    static constexpr bool PERM = true;
    const int* TOK; const bf16_t* XB; float* O; float* DUMP;
    __device__ __forceinline__ int operator()(const f32x4 (&acc)[2][2][4][2], const Unit& u, int wr, int wc, int fr, int fq) const {
        { int l; asm volatile("v_mbcnt_lo_u32_b32 %0, -1, 0\n\tv_mbcnt_hi_u32_b32 %0, -1, %0" : "=v"(l)); fr = l & 15; fq = l >> 4; }
        const int* tp = TOK + u.pm * BM + wr * 64 + fr; const int col0 = u.pn * BM + wc * 32 + 8 * fq;
        int tk[8];
#pragma unroll
        for (int it = 0; it < 8; ++it) tk[it] = tp[(it >> 2) * HALF + (it & 3) * 16];
        u32x4 xw[2][2];
#pragma unroll
        for (int bj = 0; bj < 2; ++bj) xw[0][bj] = *(const u32x4*)(XB + (size_t)(tk[0] >= 0 ? tk[0] : 0) * 1024 + col0 + bj * HALF);
#pragma unroll
        for (int it = 0; it < 8; ++it) { const int ai = it >> 2, m = it & 3, sl = it & 1; const int tok = tk[it];
            if (it + 1 < 8) {
#pragma unroll
                for (int bj = 0; bj < 2; ++bj) xw[sl ^ 1][bj] = *(const u32x4*)(XB + (size_t)(tk[it + 1] >= 0 ? tk[it + 1] : 0) * 1024 + col0 + bj * HALF); }
            asm volatile("" ::: "memory");
            float* rowp = (tok >= 0 ? O + (size_t)tok * 1024 : DUMP) + col0;
#pragma unroll
            for (int bj = 0; bj < 2; ++bj) { const u32x4 x = xw[sl][bj]; f32x4 y0 = acc[ai][bj][m][0], y1 = acc[ai][bj][m][1];
                y0[0] += bflo(x.x); y0[1] += bfhi(x.x); y0[2] += bflo(x.y); y0[3] += bfhi(x.y);
                y1[0] += bflo(x.z); y1[1] += bfhi(x.z); y1[2] += bflo(x.w); y1[3] += bfhi(x.w);
                *(f32x4*)(rowp + bj * HALF) = y0; *(f32x4*)(rowp + bj * HALF + 4) = y1; }
            asm volatile("" ::: "memory"); }
        return 32;
    }
};
}
#ifndef MK_SPLIT
#define MK_SPLIT 0
#endif
constexpr int NPHASE = 12;
__global__ void __launch_bounds__(NWAVES * 64, 2) fwd(Args args) {
    extern __shared__ __attribute__((aligned(16))) unsigned char lds[];
    Frame F;
    F.lds = (LAS unsigned char*)lds;
    F.MISC = (volatile LAS unsigned*)(F.lds + MISC_OFF);
    F.tid = threadIdx.x; F.lane = F.tid & 63; F.wave = __builtin_amdgcn_readfirstlane(F.tid >> 6);
    F.G = gridDim.x; { const int bx = blockIdx.x; F.vcu = (F.G % 8 == 0) ? (bx % 8) * (F.G / 8) + bx / 8 : bx; }
    F.ws = args.ws; F.out = args.out; F.ctl = (gu32*)(args.ws + WS_CTL);
    for (int u = F.tid; u < 256; u += NWAVES * 64) ((LAS unsigned*)(F.lds + LDSCTL_OFF))[u] = 0u;
    __syncthreads();
    const int lo = args.ph_lo, hi = args.ph_hi;
    XcdBarrier bar; bar.bar = (unsigned*)(F.ctl + CW_BAR); bar.x = 0; bar.st = nullptr;
    if (hi - lo > 1) { bar = xcd_barrier_post((unsigned*)(F.ctl + CW_BAR), F.MISC + 8);
        if (F.tid == 0) { const unsigned x = xb_xcc_id(); F.MISC[16] = x; F.MISC[17] = __hip_atomic_fetch_add(F.ctl + CW_XRANK + 64 * x, 1u, RLX_AGENT); } }
    int vid = (int)blockIdx.x;
#ifndef ONLY
#define ONLY -1
#endif
#define IN(k) ((ONLY < 0 || ONLY == (k)) && lo <= (k) && (k) < hi)
#define BOTH(k) (IN(k) && IN((k) + 1))
#ifndef PROBE_FLAG
#define PROBE_FLAG 1
#endif
#ifndef REP_PHASE
#define REP_PHASE -1
#endif
#define NREP(k) 1
#define GRID_BAR() xcd_barrier(bar)

    if (IN(0)) _Pragma("unroll") for (int rep_ = 0; rep_ < NREP(0); ++rep_) { p0_prologue(F, args); if (BOTH(0)) GRID_BAR(); }
    if (IN(1)) { p0_quant(F, args); if (BOTH(1)) GRID_BAR(); }
    if (hi - lo > 1 && lo == 0) {
        bool ok = (F.G % 8) == 0;
#pragma unroll
        for (int j = 0; j < 8; ++j) ok = ok && (__hip_atomic_load(F.ctl + CW_XRANK + 64 * j, RLX_AGENT) == (unsigned)(F.G / 8));
        __syncthreads();
        if (ok) vid = (int)__builtin_amdgcn_readfirstlane((int)(F.MISC[17] * 8u + F.MISC[16]));
    }
    if (IN(2)) _Pragma("unroll") for (int rep_ = 0; rep_ < NREP(2); ++rep_) {
        if (G1_NBF > 0) { pg8::Gemm g{WSP(bf16, WS_HN), WSP(bf16, WS_WIN), D, D, D}; pg8::G1Order S{F.G, vid, 0, 0, G1_NBF};
          pg8::EpiG1<false> E{F.ws, args.in[IN_GQ], args.in[IN_GK], nullptr, nullptr};
          pg8::gemm_phase<pg8::EpiG1<false>, pg8::G1Order>(F.lds + RING_OFF, g, S, E); }
        { pg8::Gemm g{WSP(bf16, WS_HN8), WSP(bf16, WS_WIN8), D / 2, D / 2, D / 2}; pg8::G1Order S{F.G, vid, 0, 1, 22 - G1_NBF};
          pg8::EpiG1<true> E{F.ws, args.in[IN_GQ], args.in[IN_GK], WSP(const float, WS_RS8), WSP(const float, WS_CS8)};
          pg8::gemm_phase<pg8::EpiG1<true>, pg8::G1Order, true>(F.lds + RING_OFF, g, S, E); }
        if (BOTH(2)) GRID_BAR();
    }
    if (IN(3)) _Pragma("unroll") for (int rep_ = 0; rep_ < NREP(3); ++rep_) { gla_prep(F, args); }
    if (IN(4)) _Pragma("unroll") for (int rep_ = 0; rep_ < NREP(4); ++rep_) { dsa_select_mfma(F, args); if (BOTH(4)) GRID_BAR(); }
    if (IN(5)) _Pragma("unroll") for (int rep_ = 0; rep_ < NREP(5); ++rep_) { gla_scan_mfma(F, args); dsa_attn_mfma(F, args); if (BOTH(5)) GRID_BAR(); }
    if (IN(6)) _Pragma("unroll") for (int rep_ = 0; rep_ < NREP(6); ++rep_) {
        pg8::Gemm g{WSP(bf16, WS_OCAT), nullptr, 1024, 512, 512};
        pg8::PairOrder S; S.nM = M / 256; S.nN = D / 256; S.nwg = S.nM * S.nN; S.G = F.G; S.c = vid; S.Wa = WSP(bf16, WS_WA); S.Wb = WSP(bf16, WS_WB);
        pg8::EpiMix E{WSP(bf16, WS_GA), WSP(bf16, WS_GB), WSP(bf16, WS_MIXED), F.ws + WS_MIX8, pg8::PanelX{(LAS float*)(F.lds + XTRA_OFF), WSP(unsigned, WS_SLOT1), F.ctl + CW_PCNT, WSP(float, WS_MS8)}};
        pg8::gemm_phase<pg8::EpiMix, pg8::PairOrder>(F.lds + RING_OFF, g, S, E);
        if (BOTH(6)) GRID_BAR();
    }
    if (IN(7)) _Pragma("unroll") for (int rep_ = 0; rep_ < NREP(7); ++rep_) {
        pg8::Gemm g{WSP(bf16, WS_MIX8), WSP(bf16, WS_WO8), D / 2, D / 2, D / 2}; pg8::StaticOrder S; S.init(M, D, F.G, vid);
        pg8::EpiRes E{args.in[IN_X], WSP(bf16, WS_H2), WSP(const float, WS_MS8), WSP(const float, WS_CSO), (LAS float*)(F.lds + XTRA_OFF), WSP(unsigned, WS_SLOT2)};
        pg8::gemm_phase<pg8::EpiRes, pg8::StaticOrder, true>(F.lds + RING_OFF, g, S, E);
        if (BOTH(7)) GRID_BAR();
    }
    if (IN(8)) _Pragma("unroll") for (int rep_ = 0; rep_ < NREP(8); ++rep_) { moe_route_mfma(F, args); if (BOTH(8)) GRID_BAR(); }
    if (IN(9)) _Pragma("unroll") for (int rep_ = 0; rep_ < NREP(9); ++rep_) { moe_assign(F, args); if (BOTH(9)) GRID_BAR(); }
    if (IN(10)) _Pragma("unroll") for (int rep_ = 0; rep_ < NREP(10); ++rep_) {
        const int nT = __builtin_amdgcn_readfirstlane(*WSP(const int, WS_NT));
        pg8::Gemm g{WSP(bf16, WS_XB8), nullptr, D / 2, D / 2, D / 2};
        pg8::MoeUpOrder S{nT, F.G, vid, WSP(const int, WS_TOK), WSP(const unsigned, WS_TILEE), WSP(bf16, WS_WGU8)};
        pg8::EpiMoeUp E{WSP(const int, WS_TOK), (const float*)(F.ws + WS_META + 512 * 1024), WSP(const float, WS_MRS), WSP(bf16, WS_HID), WSP(const float, WS_XS8), WSP(const float, WS_CSU)};
        pg8::gemm_phase<pg8::EpiMoeUp, pg8::MoeUpOrder, true>(F.lds + RING_OFF, g, S, E);
        if (BOTH(10)) GRID_BAR();
    }
    if (IN(11)) _Pragma("unroll") for (int rep_ = 0; rep_ < NREP(11); ++rep_) {
        const int nT = __builtin_amdgcn_readfirstlane(*WSP(const int, WS_NT));
        pg8::Gemm g{WSP(bf16, WS_HID), nullptr, 256, 128, 256};
        pg8::MoeDownOrder S{nT, F.G, vid, WSP(const unsigned, WS_TILEE), WSP(bf16, WS_WD)};
        pg8::EpiMoeDown E{WSP(const int, WS_TOK), WSP(bf16, WS_H2), F.out, WSP(float, WS_NT + 4096)};
        pg8::gemm_phase<pg8::EpiMoeDown, pg8::MoeDownOrder>(F.lds + RING_OFF, g, S, E);
    }
#undef IN
#undef BOTH
#undef GRID_BAR
}

extern "C" void kernel_launch(void* const* d_in, const int* in_sizes, int n_in, void* d_out, int out_size, void* d_ws, size_t ws_size, hipStream_t stream) {
    static int grid = 0;
    if (grid == 0) {
        if (n_in != 20 || in_sizes[0] != M * D || out_size != M * D || ws_size < WS_END) { fprintf(stderr, "kernel_launch: unexpected shapes (n_in %d, in0 %d, out %d, ws %zu); nothing launched\n", n_in, n_in > 0 ? in_sizes[0] : -1, out_size, ws_size); grid = -1; return; }
        int dev = 0, cus = 0, per_cu = 0;
        if (hipGetDevice(&dev) != hipSuccess || hipDeviceGetAttribute(&cus, hipDeviceAttributeMultiprocessorCount, dev) != hipSuccess) { grid = -1; return; }
        if (hipFuncSetAttribute((const void*)fwd, hipFuncAttributeMaxDynamicSharedMemorySize, LDS_BYTES) != hipSuccess) { fprintf(stderr, "kernel_launch: hipFuncSetAttribute failed\n"); grid = -1; return; }
        if (hipOccupancyMaxActiveBlocksPerMultiprocessor(&per_cu, (const void*)fwd, NWAVES * 64, LDS_BYTES) != hipSuccess || per_cu < 1) fprintf(stderr, "kernel_launch: occupancy query says %d\n", per_cu);
        (void)hipGetLastError();
        grid = cus;
        if (grid > 256) grid = 256;
        if (grid != 256 || per_cu < 1) { fprintf(stderr, "kernel_launch: needs 256 resident workgroups (the merge epilogue's panel exchange); nothing launched\n"); grid = -1; return; }
    }
    if (grid < 0) return;
    if (hipMemsetAsync((char*)d_ws + WS_CTL, 0, CTL_ZERO_BYTES, stream) != hipSuccess) return;
    Args a{};
    for (int i = 0; i < 20; ++i) a.in[i] = (const float*)d_in[i];
    a.out = (float*)d_out; a.ws = (unsigned char*)d_ws;
#if MK_SPLIT
    for (int p = 0; p < NPHASE; ++p) for (int rep = 0; rep < ((p == REP_PHASE) ? 2 : 1); ++rep) { a.ph_lo = p; a.ph_hi = p + 1; a.flag = rep ? PROBE_FLAG : 0; hipLaunchKernelGGL(fwd, dim3(grid), dim3(NWAVES * 64), LDS_BYTES, stream, a); }
#else
    a.ph_lo = 0; a.ph_hi = NPHASE; hipLaunchKernelGGL(fwd, dim3(grid), dim3(NWAVES * 64), LDS_BYTES, stream, a);
#endif
}
```

```cpp
#include <hip/hip_runtime.h>
#include <cstdio>
#include <cstdint>
#include <cmath>
#define MK_SPLIT 0
namespace pg8 {
#define PG8_LAS __attribute__((address_space(3)))
typedef unsigned short bf16_t;
typedef short bf16x8 __attribute__((ext_vector_type(8)));
typedef float f32x4 __attribute__((ext_vector_type(4)));
typedef unsigned u32x4 __attribute__((ext_vector_type(4)));
typedef int i32x4 __attribute__((ext_vector_type(4)));
constexpr int BM = 256, BK = 64, HALF = 128, HTB = HALF * BK * 2  , STAGE_BYTES = 8 * HTB, NXCD = 8, WGM = 8;

__host__ __device__ __forceinline__ int lds_byte(int r, int c) { const int st = (r >> 4) * 2 + (c >> 5), rr = r & 15, cc = c & 31, ob = rr * 64 + cc * 2; return st * 1024 + (ob ^ (((ob >> 9) & 1) << 5)); }
__host__ __device__ __forceinline__ void stage_rc(int b, int& R, int& C) { const int st = b / 1024, sb = b % 1024, swz = sb ^ (((sb >> 9) & 1) << 5); R = (st >> 1) * 16 + swz / 64; C = (st & 1) * 32 + (swz % 64) / 2; }
__host__ __device__ __forceinline__ int perm32(int rho) { const int n = rho >> 4, i = rho & 15; return 8 * (i >> 2) + 4 * n + (i & 3); }

struct Unit { int pm, pn, sel; };
struct Gemm { const bf16_t* A; const bf16_t* Bt; int lda, ldb, K; int nomma = 0; };

__host__ __device__ __forceinline__ void tile_of(int wgid, int nM, int nN, int& pm, int& pn) {
    const int nwg = nM * nN;
    { const int q = nwg / NXCD, r = nwg % NXCD, xcd = wgid % NXCD, off = wgid / NXCD; wgid = (xcd < r ? xcd * (q + 1) : r * (q + 1) + (xcd - r) * q) + off; }
    const int nig = WGM * nN, gid = wgid / nig, fm = gid * WGM, gsz = (nM - fm) < WGM ? (nM - fm) : WGM;
    pm = fm + ((wgid % nig) % gsz); pn = (wgid % nig) / gsz;
}
struct StaticOrder {
    static constexpr bool GATHER = false, SPLITB = false;
    int nM, nN, nwg, G, c;
    __host__ __device__ void init(int M, int N, int G_, int c_) { nM = M / BM; nN = N / BM; nwg = nM * nN; G = G_; c = c_; }
    __host__ __device__ bool next(int i, Unit& u) const {
        const long L = (long)i * G + c; if (L >= nwg) return false;
        tile_of((int)L, nM, nN, u.pm, u.pn); u.sel = 0; return true;
    }
    __device__ __forceinline__ const char* baseA(const Gemm& g, const Unit& u) const { return (const char*)g.A + (size_t)u.pm * BM * g.lda * 2; }
    __device__ __forceinline__ const char* baseB(const Gemm& g, const Unit& u) const { return (const char*)g.Bt + (size_t)u.pn * BM * g.ldb * 2; }
};

typedef float f32x2_t __attribute__((ext_vector_type(2))); typedef __bf16 bf16x2_t __attribute__((ext_vector_type(2)));
__device__ __forceinline__ unsigned cvt_pk_bf16(float lo, float hi) { const f32x2_t v = {lo, hi}; const bf16x2_t b = __builtin_convertvector(v, bf16x2_t); return __builtin_bit_cast(unsigned, b); }

template <class Epi, class Sched, bool I8 = false>
__device__ __forceinline__ void gemm_phase(PG8_LAS unsigned char* lds, const Gemm g, const Sched& S, const Epi& E) {
    const int tid = threadIdx.x, wid = __builtin_amdgcn_readfirstlane(tid >> 6), lane = tid & 63, wr = wid >> 2, wc = wid & 3, fr = lane & 15, fq = lane >> 4;
    const int K = g.K, nt = K / BK;
    unsigned voffA[2][2], voffN[2][2], voffB[2]; int RA_[2], CA_[2];
#pragma unroll
    for (int i = 0; i < 2; ++i) { int R, C; stage_rc(tid * 16 + i * 8192, R, C); const int Rb = Epi::PERM ? ((R & ~31) + perm32(R & 31)) : R; RA_[i] = R; CA_[i] = C;
        voffB[i] = (unsigned)(Rb * g.ldb + C) * 2u;
#pragma unroll
        for (int h = 0; h < 2; ++h) { voffA[h][i] = (unsigned)((R + h * HALF) * g.lda + C) * 2u; voffN[h][i] = voffA[h][i]; } }
    const size_t kstep = (size_t)(BK * 2);
    const size_t hstepB = (size_t)HALF * g.ldb * 2;
    const unsigned ldsw = (unsigned)wid * 1024u;
    const int aoff = lds_byte(wr * 64 + fr, fq * 8), boff = lds_byte(wc * 32 + fr, fq * 8);
#define PG8_SA(b, h) (((b) * 2 + (h)) * HTB)
#define PG8_SB(b, h) ((4 + (b) * 2 + (h)) * HTB)
#define PG8_STAGE(bufoff, gbase, voff) do { _Pragma("unroll") for (int _i = 0; _i < 2; ++_i) \
        __builtin_amdgcn_global_load_lds((const unsigned*)((const char*)(gbase) + (voff)[_i]), (PG8_LAS unsigned*)(lds + (bufoff) + ldsw + _i * 8192), 16, 0, 0); } while (0)
#define PG8_LDA(dst, b, h) do { _Pragma("unroll") for (int m = 0; m < 4; ++m) _Pragma("unroll") for (int k = 0; k < 2; ++k) dst[m][k] = *(const PG8_LAS bf16x8*)(lds + PG8_SA(b, h) + aoff + m * 2048 + k * 1024); } while (0)
#define PG8_LDB(dst, b, h) do { _Pragma("unroll") for (int n = 0; n < 2; ++n) _Pragma("unroll") for (int k = 0; k < 2; ++k) dst[n][k] = *(const PG8_LAS bf16x8*)(lds + PG8_SB(b, h) + boff + n * 2048 + k * 1024); } while (0)
#ifdef PROBE_NOMMA
#define PG8_MMA_GUARD if (!g.nomma)
#else
#define PG8_MMA_GUARD
#endif
#define PG8_MMA(ai, bj, At, Bt) PG8_MMA_GUARD do { __builtin_amdgcn_s_setprio(1); _Pragma("unroll") for (int m = 0; m < 4; ++m) _Pragma("unroll") for (int n = 0; n < 2; ++n) _Pragma("unroll") for (int k = 0; k < 2; ++k) { \
        if constexpr (I8) acc[ai][bj][m][n] = __builtin_bit_cast(f32x4, __builtin_amdgcn_mfma_i32_16x16x64_i8(__builtin_bit_cast(i32x4, Bt[n][k]), __builtin_bit_cast(i32x4, At[m][k]), __builtin_bit_cast(i32x4, acc[ai][bj][m][n]), 0, 0, 0)); \
        else acc[ai][bj][m][n] = __builtin_amdgcn_mfma_f32_16x16x32_bf16(Bt[n][k], At[m][k], acc[ai][bj][m][n], 0, 0, 0); } __builtin_amdgcn_s_setprio(0); } while (0)
#define PG8_WAIT_V(n) asm volatile("s_waitcnt vmcnt(" #n ")" ::: "memory")
#define PG8_WAIT_L(n) asm volatile("s_waitcnt lgkmcnt(" #n ")" ::: "memory")
#define PG8_WAIT_VE() PG8_WAIT_V(8)
#define PG8_BAR __builtin_amdgcn_s_barrier()
#define PG8_SCHED __builtin_amdgcn_sched_barrier(0)
#define PG8_GATHER(dst, u) do { if constexpr (Sched::GATHER) { _Pragma("unroll") for (int _h = 0; _h < 2; ++_h) _Pragma("unroll") for (int _i = 0; _i < 2; ++_i) \
        dst[_h][_i] = (unsigned)S.row(u, _h * HALF + RA_[_i]) * (unsigned)(g.lda * 2) + (unsigned)(CA_[_i] * 2); } } while (0)
    Unit cur, nxt, nn; int ui = 0, en = 0;
    if (!S.next(0, cur)) return;
    bool has_next = S.next(1, nxt);
    f32x4 acc[2][2][4][2];
#pragma unroll
    for (int a = 0; a < 2; ++a)
#pragma unroll
        for (int b = 0; b < 2; ++b)
#pragma unroll
            for (int m = 0; m < 4; ++m)
#pragma unroll
                for (int n = 0; n < 2; ++n) acc[a][b][m][n] = (f32x4){0.f, 0.f, 0.f, 0.f};
    bf16x8 At[4][2], B0[2][2], B1[2][2];
    const char* cA = S.baseA(g, cur); const char* cB = S.baseB(g, cur);
    PG8_GATHER(voffA, cur);
    if constexpr (Sched::GATHER) { if (has_next) { PG8_GATHER(voffN, nxt); } else {
#pragma unroll
        for (int h = 0; h < 2; ++h)
#pragma unroll
            for (int i = 0; i < 2; ++i) voffN[h][i] = voffA[h][i]; } }
    PG8_STAGE(PG8_SB(0, 0), cB, voffB); PG8_STAGE(PG8_SB(0, 1), cB + hstepB, voffB); PG8_STAGE(PG8_SA(0, 0), cA, voffA[0]); PG8_STAGE(PG8_SA(0, 1), cA, voffA[1]);
    if (wr == 1) PG8_BAR;
    PG8_WAIT_V(2); PG8_BAR;
    PG8_STAGE(PG8_SB(1, 0), cB + kstep, voffB); PG8_STAGE(PG8_SA(1, 0), cA + kstep, voffA[0]); PG8_STAGE(PG8_SB(1, 1), cB + hstepB + kstep, voffB);
    PG8_WAIT_V(6); PG8_BAR;
    for (;;) {
        const char* nA = has_next ? S.baseA(g, nxt) : cA; const char* nB = has_next ? S.baseB(g, nxt) : cB;
        const char* cB2 = cB; if constexpr (Sched::SPLITB) cB2 = S.baseB2(g, cur);
        for (int t = 0; t < nt; t += 2) {
            const bool last = (t == nt - 2);
            const char* a1 = cA + (size_t)(t + 1) * kstep;
            const char* a2 = last ? nA : cA + (size_t)(t + 2) * kstep;
            const char* b2 = last ? nB : (Sched::SPLITB ? cB2 + (size_t)t * kstep : cB + (size_t)(t + 2) * kstep);
            const char* a3 = a2 + kstep; const char* b3 = b2 + kstep;
            unsigned v2[2][2];
#pragma unroll
            for (int h = 0; h < 2; ++h)
#pragma unroll
                for (int i = 0; i < 2; ++i) v2[h][i] = (Sched::GATHER && last) ? voffN[h][i] : voffA[h][i];
            PG8_LDB(B0, 0, 0); PG8_LDB(B1, 0, 1); PG8_SCHED; PG8_LDA(At, 0, 0); PG8_STAGE(PG8_SA(1, 1), a1, voffA[1]);
            PG8_WAIT_VE(); PG8_WAIT_L(0); PG8_BAR; PG8_MMA(0, 0, At, B0); PG8_MMA(0, 1, At, B1); PG8_BAR; PG8_SCHED;
            PG8_LDA(At, 0, 1); PG8_STAGE(PG8_SB(0, 0), b2, voffB); PG8_STAGE(PG8_SB(0, 1), b2 + hstepB, voffB); PG8_STAGE(PG8_SA(0, 0), a2, v2[0]);
            PG8_WAIT_VE(); PG8_WAIT_L(0); PG8_BAR; PG8_MMA(1, 0, At, B0); PG8_MMA(1, 1, At, B1); PG8_BAR; PG8_SCHED;
            PG8_LDB(B0, 1, 0); PG8_LDB(B1, 1, 1); PG8_SCHED; PG8_LDA(At, 1, 0); PG8_STAGE(PG8_SA(0, 1), a2, v2[1]);
            PG8_WAIT_V(8); PG8_WAIT_L(0); PG8_BAR; PG8_MMA(0, 0, At, B0); PG8_MMA(0, 1, At, B1); PG8_BAR; PG8_SCHED;
            PG8_LDA(At, 1, 1); PG8_STAGE(PG8_SB(1, 0), b3, voffB); PG8_STAGE(PG8_SB(1, 1), b3 + hstepB, voffB); PG8_STAGE(PG8_SA(1, 0), a3, v2[0]);
            PG8_WAIT_V(8); PG8_WAIT_L(0); PG8_BAR; PG8_MMA(1, 0, At, B0); PG8_MMA(1, 1, At, B1); PG8_BAR; PG8_SCHED;
        }
        const bool has_nn = has_next && S.next(ui + 2, nn);
        int trow[2][2];
        if constexpr (Sched::GATHER) { if (has_nn) {
#pragma unroll
            for (int h = 0; h < 2; ++h)
#pragma unroll
                for (int i = 0; i < 2; ++i) trow[h][i] = S.row(nn, h * HALF + RA_[i]); } }
        if (wr == 0) PG8_BAR;
        en = __builtin_amdgcn_readfirstlane(E(acc, cur, wr, wc, fr, fq));
        if (!has_next) break;
        if (!(Epi::CARRY && cur.sel == 0)) {
#pragma unroll
        for (int a = 0; a < 2; ++a)
#pragma unroll
            for (int b = 0; b < 2; ++b)
#pragma unroll
                for (int m = 0; m < 4; ++m)
#pragma unroll
                    for (int n = 0; n < 2; ++n) acc[a][b][m][n] = (f32x4){0.f, 0.f, 0.f, 0.f};
        }
        cur = nxt; cA = nA; cB = nB; ++ui; nxt = nn; has_next = has_nn;
        if constexpr (Sched::GATHER) {
#pragma unroll
            for (int h = 0; h < 2; ++h)
#pragma unroll
                for (int i = 0; i < 2; ++i) { voffA[h][i] = voffN[h][i]; if (has_nn) voffN[h][i] = (unsigned)trow[h][i] * (unsigned)(g.lda * 2) + (unsigned)(CA_[i] * 2); } }
        if (wr == 1) PG8_BAR;
    }
    PG8_WAIT_V(0);
    PG8_BAR;
#undef PG8_SA
#undef PG8_SB
#undef PG8_STAGE
#undef PG8_LDA
#undef PG8_LDB
#undef PG8_MMA
#undef PG8_WAIT_V
#undef PG8_WAIT_L
#undef PG8_WAIT_VE
#undef PG8_BAR
#undef PG8_SCHED
#undef PG8_GATHER
}
}
constexpr int NWAVES = 8;
constexpr int BATCH = 16, SEQ = 4096, D = 1024, M = BATCH * SEQ;
constexpr int CH = 64, NCH = SEQ / CH, NCHUNK = M / CH;
constexpr int NP = 5632;
constexpr float EPS = 1e-6f;
constexpr float LOG2E = 1.4426950408889634f;
constexpr int L_QA = 0, L_KA = 256, L_VA = 512, L_RA = 1024, L_ALR = 1536, L_QB = 1552, L_KB = 2064, L_VB = 2576, L_QI = 3088, L_KI = 3344, L_WI = 3376, L_GA = 3384, L_GB = 4408, D_IN = 5432;
constexpr int NEXP = 32, DEXP = 128, NCLASS = 112;

constexpr size_t MiB = 1u << 20;
constexpr size_t WS_CTL = 0, CTL_ZERO_BYTES = 1 * MiB;
constexpr size_t WS_WIN = 2 * MiB;
constexpr size_t WS_WA = 13 * MiB;
constexpr size_t WS_WB = 14 * MiB;
constexpr size_t WS_WO = 15 * MiB;
constexpr size_t WS_WGU = 17 * MiB;
constexpr size_t WS_WD = 33 * MiB;
constexpr size_t WS_META = 41 * MiB;
constexpr size_t WS_WR = 43 * MiB;
constexpr size_t WS_MRS = 44 * MiB;
constexpr size_t WS_TOK = 42 * MiB;
constexpr size_t WS_R0 = 48 * MiB;
constexpr size_t WS_HN = WS_R0, WS_KDT = WS_R0, WS_MASK = WS_R0 + 32 * MiB, WS_MIXED = WS_R0;
constexpr size_t WS_QA = 176 * MiB, WS_KA = 208 * MiB, WS_VA = 240 * MiB, WS_RA = 304 * MiB, WS_QB = 368 * MiB, WS_KB = 432 * MiB, WS_VB = 496 * MiB, WS_QI = 560 * MiB;
constexpr size_t WS_KI = 592 * MiB, WS_WI = 596 * MiB, WS_ALR = 598 * MiB, WS_DEC = 602 * MiB;
constexpr size_t WS_GA = 608 * MiB, WS_GB = 736 * MiB, WS_OCAT = 864 * MiB, WS_END = 992 * MiB;
constexpr size_t WS_HN8 = 672 * MiB;
constexpr size_t WS_WIN8 = 800 * MiB;
constexpr size_t WS_RS8 = 808 * MiB, WS_CS8 = 809 * MiB;
constexpr size_t WS_WGU8 = 812 * MiB, WS_CSU = 820 * MiB;
constexpr size_t WS_XB8 = WS_R0, WS_XS8 = WS_R0 + 64 * MiB;
constexpr size_t WS_WO8 = 821 * MiB, WS_CSO = 822 * MiB;
constexpr size_t WS_MIX8 = 368 * MiB, WS_MS8 = 432 * MiB;
constexpr size_t WS_SLOT1 = 824 * MiB, WS_SLOT2 = 826 * MiB;
constexpr size_t WS_H2 = 176 * MiB;
constexpr size_t WS_HID = 304 * MiB;
constexpr int CW_TMO = 0, CW_CODE = 1;
constexpr int CW_BAR = 4096;
constexpr int CW_XRANK = 9216;
constexpr int CW_ATTQ = 8448;
constexpr int CW_CMAX = 16384;
constexpr int CW_ROWMAX2 = 131072;
constexpr int CW_PCNT = 196608;
constexpr int CW_ROWMAX = 65536;
constexpr int CW_CLS = 8192;

constexpr int RING_OFF = 0, RING_BYTES = 131072;
constexpr int LDSCTL_OFF = RING_BYTES, MISC_OFF = LDSCTL_OFF + 320;
constexpr int XTRA_OFF = RING_BYTES + 1024;
constexpr int LDS_BYTES = 147456;

#define GAS __attribute__((address_space(1)))
#define LAS __attribute__((address_space(3)))
typedef unsigned short bf16;
typedef unsigned v4u __attribute__((ext_vector_type(4)));
typedef unsigned v2u __attribute__((ext_vector_type(2)));
typedef float f32x4 __attribute__((ext_vector_type(4)));
typedef float f32x16 __attribute__((ext_vector_type(16)));
typedef short bf16x8 __attribute__((ext_vector_type(8)));
typedef GAS unsigned gu32;
#define RLX_AGENT __ATOMIC_RELAXED, __HIP_MEMORY_SCOPE_AGENT
#define LDS_WAIT() asm volatile("s_waitcnt lgkmcnt(0)" ::: "memory")
#define VM_WAIT() asm volatile("s_waitcnt vmcnt(0)" ::: "memory")
__device__ __forceinline__ unsigned f2bf(float f) { unsigned u = __builtin_bit_cast(unsigned, f); return (u + 0x7fffu + ((u >> 16) & 1u)) >> 16; }
__device__ __forceinline__ unsigned pk2(float lo, float hi) { return f2bf(lo) | (f2bf(hi) << 16); }
__device__ __forceinline__ float bf2f(unsigned short b) { return __builtin_bit_cast(float, ((unsigned)b) << 16); }
__device__ __forceinline__ float bflo(unsigned w) { return __builtin_bit_cast(float, w << 16); }
__device__ __forceinline__ float bfhi(unsigned w) { return __builtin_bit_cast(float, w & 0xffff0000u); }
__device__ __forceinline__ float fast_exp2(float x) { return __builtin_amdgcn_exp2f(x); }
__device__ __forceinline__ float sigmoidf_(float x) { return __builtin_amdgcn_rcpf(1.0f + __builtin_amdgcn_exp2f(-x * LOG2E)); }
__device__ __forceinline__ float siluf_(float x) { return x * sigmoidf_(x); }

#define XB_TMO      128
#define XB_XCNT(j)  (256  + 64 * (j))
#define XB_XSUB(j)  (1280 + 64 * (j))
#define XB_XGEN(j)  (2304 + 64 * (j))
#define XB_TOP      3328
#define XB_TOPGEN   3392
#define XCD_BAR_WORDS 3456
#define XB_SPIN_CAP (1u << 18)
__device__ __forceinline__ unsigned xb_ld(unsigned* p)              { return __hip_atomic_load(p, __ATOMIC_RELAXED, __HIP_MEMORY_SCOPE_AGENT); }
__device__ __forceinline__ unsigned xb_add(unsigned* p, unsigned v) { return __hip_atomic_fetch_add(p, v, __ATOMIC_RELAXED, __HIP_MEMORY_SCOPE_AGENT); }
__device__ __forceinline__ unsigned xb_xcc_id() { return (unsigned)__builtin_amdgcn_s_getreg((3 << 11) | 20) & 0xFu; }
#define XB_SPIN(cond, bar) do { unsigned _sp = 0; while (cond) { __builtin_amdgcn_s_sleep(1); \
    if ((++_sp & 255u) == 0u) { if (xb_ld(&(bar)[XB_TMO])) break; if (_sp > XB_SPIN_CAP) { atomicAdd(&(bar)[XB_TMO], 1u); break; } } } } while (0)
struct XcdBarrier { unsigned* bar; unsigned x; volatile LAS unsigned* st; };
__device__ __forceinline__ XcdBarrier xcd_barrier_post(unsigned* bar, volatile LAS unsigned* st) {
    XcdBarrier b; b.bar = bar; b.x = xb_xcc_id(); b.st = st;
    if (threadIdx.x == 0) (void)xb_add(&bar[XB_XCNT(b.x)], 1u);
    return b;
}
__device__ __forceinline__ void xcd_barrier_complete(unsigned* bar, unsigned x, unsigned& nloc, unsigned& nx) {
    const unsigned G = gridDim.x * gridDim.y * gridDim.z;
    unsigned sum, cnt, mine, sp = 0u;
    for (;;) {
        sum = 0u; cnt = 0u; mine = 0u;
#pragma unroll
        for (unsigned j = 0; j < 16; ++j) { const unsigned c = xb_ld(&bar[XB_XCNT(j)]); sum += c; cnt += (c > 0u) ? 1u : 0u; mine = (j == x) ? c : mine; }
        if (sum == G) break;
        __builtin_amdgcn_s_sleep(1);
        if ((++sp & 255u) == 0u) { if (xb_ld(&bar[XB_TMO])) break; if (sp > XB_SPIN_CAP) { atomicAdd(&bar[XB_TMO], 1u); break; } }
    }
    nloc = mine > 0u ? mine : 1u; nx = cnt > 0u ? cnt : 1u;
}
__device__ __forceinline__ void xcd_barrier(const XcdBarrier& b) {
    asm volatile("s_waitcnt vmcnt(0)" ::: "memory");
    __syncthreads();
    if (threadIdx.x == 0) {
        unsigned* bar = b.bar;
        __builtin_amdgcn_s_waitcnt(0);
        unsigned nloc = b.st[0], nx = b.st[1];
        if (nloc == 0u) { xcd_barrier_complete(bar, b.x, nloc, nx); b.st[0] = nloc; b.st[1] = nx; }
        const unsigned old = xb_add(&bar[XB_XSUB(b.x)], 1u);
        const unsigned gen = old / nloc;
        if (old + 1u == (gen + 1u) * nloc) {
            __builtin_amdgcn_fence(__ATOMIC_RELEASE, "agent");
            asm volatile("s_waitcnt vmcnt(0)" ::: "memory");
            const unsigned og = xb_add(&bar[XB_TOP], 1u);
            const unsigned tg = og / nx;
            if (og + 1u == (tg + 1u) * nx) xb_add(&bar[XB_TOPGEN], 1u);
            else XB_SPIN(xb_ld(&bar[XB_TOPGEN]) == tg, bar);
            __builtin_amdgcn_fence(__ATOMIC_ACQUIRE, "agent");
            xb_add(&bar[XB_XGEN(b.x)], 1u);
            asm volatile("s_waitcnt vmcnt(0)" ::: "memory");
        } else {
            XB_SPIN(xb_ld(&bar[XB_XGEN(b.x)]) == gen, bar);
            __builtin_amdgcn_fence(__ATOMIC_ACQUIRE, "agent");
            asm volatile("s_waitcnt vmcnt(0)" ::: "memory");
        }
    }
    __syncthreads();
}

struct Args { const float* in[20]; float* out; unsigned char* ws; int ph_lo, ph_hi, flag, pad; };
struct Frame {
    LAS unsigned char* lds;
    volatile LAS unsigned* MISC;
    gu32* ctl;
    int tid, lane, wave;
    int vcu, G;
    float* out; unsigned char* ws;
};
#define IN_X 0
#define IN_GMIX 1
#define IN_WIN 2
#define IN_WA2 3
#define IN_BA 4
#define IN_GGLA 5
#define IN_WBRG 6
#define IN_GQ 7
#define IN_GK 8
#define IN_RELB 9
#define IN_WBRA 10
#define IN_WOUT 11
#define IN_GFFN 12
#define IN_WRG 13
#define IN_BRG 14
#define IN_WRE 15
#define IN_BRE 16
#define IN_WGATE 17
#define IN_WUP 18
#define IN_WDOWN 19
#define WSP(T, off) ((T*)(F.ws + (off)))

__device__ __forceinline__ float wave_sum(float v) {
#pragma unroll
    for (int o = 1; o < 64; o <<= 1) v += __shfl_xor(v, o);
    return v;
}
__device__ __forceinline__ float wave_max(float v) {
#pragma unroll
    for (int o = 1; o < 64; o <<= 1) v = fmaxf(v, __shfl_xor(v, o));
    return v;
}
__device__ __forceinline__ void win_map(int p, int& c, float& s) {
    const int tile = p >> 8, j = p & 255; s = 1.f;
    if (tile == 0) { c = L_QA + j; s = 0.125f; }
    else if (tile == 1) c = L_KA + j;
    else if (tile < 4) c = L_VA + (p - 512);
    else if (tile < 6) c = L_RA + (p - 1024);
    else if (tile < 10) {
        const int pl = (p - 1536) & 511, t2 = pl >> 8, jj = pl & 255, bj = jj >> 7, wc = (jj >> 5) & 3, x = jj & 31;
        c = (tile < 8 ? L_QB : L_KB) + t2 * 256 + 64 * wc + 32 * bj + x;
    }
    else if (tile < 12) c = L_VB + (p - 2560);
    else if (tile == 12) c = L_QI + j;
    else if (tile == 13) { if (j < 32) c = L_KI + j; else if (j < 40) { c = L_WI + (j - 32); s = 0.0625f; } else if (j < 56) c = L_ALR + (j - 40); else c = -1; }
    else {
        const int pl = (p - 3584) & 1023, t4 = pl >> 8, jj = pl & 255, bj = jj >> 7, wc = (jj >> 5) & 3, fq = (jj >> 3) & 3, j2 = jj & 7;
        c = (tile < 18 ? L_GA : L_GB) + t4 * 256 + 64 * wc + 16 * fq + 8 * bj + j2;
    }
}
#ifndef G1_NBF
#define G1_NBF 0
#endif
__host__ __device__ __forceinline__ int g1_tile(int set, int j) {
#if G1_NBF == 8
    return set ? (j < 4 ? j + 2 : (j < 6 ? j + 6 : j + 8)) : (j < 2 ? j : (j < 6 ? j + 4 : j + 6));
#elif G1_NBF == 2
    return set ? (j < 12 ? j : j + 2) : 12 + j;
#else
    return j;
#endif
}
__device__ __forceinline__ bool win_is8(int tile) {
#if G1_NBF == 8
    return (tile >= 2 && tile < 6) || tile == 10 || tile == 11 || tile >= 14;
#elif G1_NBF == 2
    return tile != 12 && tile != 13;
#else
    return true;
#endif
}
template <int MAP>
__device__ __forceinline__ void p0_transpose_item(const float* W, int K, int N, bf16* WT, int row_off, int nrows, LAS float* scr, int item, int lane, const float* ksc = nullptr, gu32* cmax = nullptr) {
    const int nblk = nrows / 32, kb = item / nblk, nb = item % nblk, k0 = 64 * kb, n0 = 32 * nb;
    const int c4 = lane & 7, kk8 = lane >> 3;
    int c = n0 + 4 * c4; float s = 1.f;
    if (MAP == 1) win_map(n0 + 4 * c4, c, s);
#pragma unroll
    for (int i = 0; i < 8; ++i) { const int kk = 8 * i + kk8; f32x4 v = {0.f, 0.f, 0.f, 0.f};
        if (c >= 0) v = *(const GAS f32x4*)(W + (size_t)(k0 + kk) * N + c) * (ksc ? s * ksc[k0 + kk] : s);
        LAS float* d = scr + kk * 33 + 4 * c4; d[0] = v.x; d[1] = v.y; d[2] = v.z; d[3] = v.w; }
    LDS_WAIT(); asm volatile("" ::: "memory");
    if (cmax) { if (MAP == 0 || win_is8(n0 >> 8)) {
        float mx = 0.f;
#pragma unroll 8
        for (int i = 0; i < 32; ++i) mx = fmaxf(mx, fabsf(scr[(2 * i + (lane >> 5)) * 33 + (lane & 31)]));
        mx = fmaxf(mx, __shfl_xor(mx, 32));
        if (lane < 32) __hip_atomic_fetch_max(cmax + row_off + n0 + lane, f2bf(mx) << 16, RLX_AGENT); } }
    const int ch = lane & 7;
#pragma unroll
    for (int j = 0; j < 4; ++j) { const int n = (lane >> 3) + 8 * j; const LAS float* sp = scr + (8 * ch) * 33 + n;
        v4u o; o.x = pk2(sp[0 * 33], sp[1 * 33]); o.y = pk2(sp[2 * 33], sp[3 * 33]); o.z = pk2(sp[4 * 33], sp[5 * 33]); o.w = pk2(sp[6 * 33], sp[7 * 33]);
        *(GAS v4u*)(WT + (size_t)(row_off + n0 + n) * K + k0 + 8 * ch) = o; }
    LDS_WAIT(); asm volatile("" ::: "memory");
}
__device__ __forceinline__ void rms_row_to_bf16(const float* xrow, const float* g, bf16* orow, int lane) {
    const GAS f32x4* xr = (const GAS f32x4*)xrow + lane; const GAS f32x4* gr = (const GAS f32x4*)g + lane;
    f32x4 v[4]; float s = 0.f;
#pragma unroll
    for (int j = 0; j < 4; ++j) { v[j] = xr[64 * j]; s += (v[j].x * v[j].x + v[j].y * v[j].y) + (v[j].z * v[j].z + v[j].w * v[j].w); }
    const float rs = 1.0f / sqrtf(wave_sum(s) * (1.f / D) + EPS);
    GAS unsigned long long* o8 = (GAS unsigned long long*)orow + lane;
#pragma unroll
    for (int j = 0; j < 4; ++j) { const f32x4 gg = gr[64 * j]; o8[64 * j] = (unsigned long long)pk2(v[j].x * rs * gg.x, v[j].y * rs * gg.y) | ((unsigned long long)pk2(v[j].z * rs * gg.z, v[j].w * rs * gg.w) << 32); }
}
__device__ __forceinline__ void p0_prologue(Frame& F, const Args& A) {
    LAS float* scr = (LAS float*)(F.lds + RING_OFF + F.wave * 16384);
    const int gw = F.vcu * NWAVES + F.wave, NGW = F.G * NWAVES;
    constexpr int I_IN = (D / 64) * (NP / 32);
    constexpr int I_AB = (512 / 64) * (D / 32);
    constexpr int I_O = (D / 64) * (D / 32);
    constexpr int I_GU = (D / 64) * (DEXP / 32);
    constexpr int I_DN = (DEXP / 64) * (D / 32);
    constexpr int NITEMS = I_IN + 2 * I_AB + I_O + NEXP * (2 * I_GU + I_DN);
    for (int it = gw; it < NITEMS; it += NGW) {
        int r = it;
        if (r < I_IN) { p0_transpose_item<1>(A.in[IN_WIN], D, D_IN, WSP(bf16, WS_WIN), 0, NP, scr, r, F.lane, nullptr, F.ctl + CW_CMAX); continue; } r -= I_IN;
        if (r < I_AB) { p0_transpose_item<0>(A.in[IN_WBRG], 512, D, WSP(bf16, WS_WA), 0, D, scr, r, F.lane); continue; } r -= I_AB;
        if (r < I_AB) { p0_transpose_item<0>(A.in[IN_WBRA], 512, D, WSP(bf16, WS_WB), 0, D, scr, r, F.lane); continue; } r -= I_AB;
        if (r < I_O) { p0_transpose_item<0>(A.in[IN_WOUT], D, D, WSP(bf16, WS_WO), 0, D, scr, r, F.lane, nullptr, F.ctl + CW_CMAX + NP + NEXP * 256); continue; } r -= I_O;
        const int e = r / (2 * I_GU + I_DN); r -= e * (2 * I_GU + I_DN);
        if (r < I_GU) { p0_transpose_item<0>(A.in[IN_WGATE] + (size_t)e * D * DEXP, D, DEXP, WSP(bf16, WS_WGU) + (size_t)e * 256 * D, 0, DEXP, scr, r, F.lane, A.in[IN_GFFN], F.ctl + CW_CMAX + NP + e * 256); continue; } r -= I_GU;
        if (r < I_GU) { p0_transpose_item<0>(A.in[IN_WUP] + (size_t)e * D * DEXP, D, DEXP, WSP(bf16, WS_WGU) + (size_t)e * 256 * D, 128, DEXP, scr, r, F.lane, A.in[IN_GFFN], F.ctl + CW_CMAX + NP + e * 256); continue; } r -= I_GU;
        p0_transpose_item<0>(A.in[IN_WDOWN] + (size_t)e * DEXP * D, DEXP, D, WSP(bf16, WS_WD) + (size_t)e * D * DEXP, 0, D, scr, r, F.lane);
    }
    { bf16* WRH = WSP(bf16, WS_WR); bf16* WRL = WRH + 64 * D;
      for (int i = F.vcu * 512 + F.tid; i < 64 * D; i += F.G * 512) { const int c = i >> 10, k = i & 1023;
          float v = 0.f; if (c < 4) v = A.in[IN_WRG][k * 4 + c]; else if (c < 36) v = A.in[IN_WRE][k * 32 + (c - 4)];
          v *= A.in[IN_GFFN][k]; const unsigned hb = f2bf(v); const float lo = v - __builtin_bit_cast(float, hb << 16);
          WRH[i] = (bf16)hb; WRL[i] = (bf16)f2bf(lo); } }
    for (int m = gw * 8; m < M; m += NGW * 8) {
        const GAS f32x4* gr = (const GAS f32x4*)A.in[IN_GMIX] + F.lane;
        f32x4 v[8][4]; float ss[8], am[8];
#pragma unroll
        for (int r = 0; r < 8; ++r) { const GAS f32x4* xr = (const GAS f32x4*)(A.in[IN_X] + (size_t)(m + r) * D) + F.lane; ss[r] = 0.f; am[r] = 0.f;
#pragma unroll
            for (int j = 0; j < 4; ++j) { v[r][j] = __builtin_nontemporal_load(xr + 64 * j); } }
#pragma unroll
        for (int r = 0; r < 8; ++r) {
#pragma unroll
            for (int j = 0; j < 4; ++j) ss[r] += (v[r][j].x * v[r][j].x + v[r][j].y * v[r][j].y) + (v[r][j].z * v[r][j].z + v[r][j].w * v[r][j].w);
            ss[r] = 1.0f / sqrtf(wave_sum(ss[r]) * (1.f / D) + EPS); }
#pragma unroll
        for (int j = 0; j < 4; ++j) { const f32x4 gg = gr[64 * j];
#pragma unroll
            for (int r = 0; r < 8; ++r) { GAS unsigned long long* o8 = (GAS unsigned long long*)(WSP(bf16, WS_HN) + (size_t)(m + r) * D) + F.lane; const float rs = ss[r];
                const f32x4 y = {v[r][j].x * rs * gg.x, v[r][j].y * rs * gg.y, v[r][j].z * rs * gg.z, v[r][j].w * rs * gg.w}; v[r][j] = y;
                am[r] = fmaxf(fmaxf(am[r], fmaxf(fabsf(y.x), fabsf(y.y))), fmaxf(fabsf(y.z), fabsf(y.w)));
                if (G1_NBF > 0) o8[64 * j] = (unsigned long long)pk2(y.x, y.y) | ((unsigned long long)pk2(y.z, y.w) << 32); } }
#pragma unroll
        for (int r = 0; r < 8; ++r) { const float a = wave_max(am[r]); const float inv = a > 0.f ? 127.0f / a : 0.f;
            if (F.lane == 0) WSP(float, WS_RS8)[m + r] = a * (1.0f / 127.0f);
            v4u q;
#pragma unroll
            for (int j = 0; j < 4; ++j) { unsigned b = 0u;
                b = __builtin_amdgcn_cvt_pk_u8_f32(__builtin_rintf(__builtin_fmaf(v[r][j].x, inv, 128.0f)), 0, b); b = __builtin_amdgcn_cvt_pk_u8_f32(__builtin_rintf(__builtin_fmaf(v[r][j].y, inv, 128.0f)), 1, b);
                b = __builtin_amdgcn_cvt_pk_u8_f32(__builtin_rintf(__builtin_fmaf(v[r][j].z, inv, 128.0f)), 2, b); b = __builtin_amdgcn_cvt_pk_u8_f32(__builtin_rintf(__builtin_fmaf(v[r][j].w, inv, 128.0f)), 3, b);
                q[j] = b ^ 0x80808080u; }
            *(GAS v4u*)(F.ws + WS_HN8 + (size_t)(m + r) * D + 16 * F.lane) = q; }
    }
}
__device__ __forceinline__ void p0_quant(Frame& F, const Args& A) {
    const int gw = F.vcu * NWAVES + F.wave, NGW = F.G * NWAVES;
    for (int idx = gw; idx < (22 - G1_NBF) * 256; idx += NGW) {
        const int tile = g1_tile(1, idx >> 8), p = tile * 256 + (idx & 255);
        const float a = __builtin_bit_cast(float, __hip_atomic_load(F.ctl + CW_CMAX + p, RLX_AGENT)); const float inv = a > 0.f ? 127.0f / a : 0.f;
        if (F.lane == 0) WSP(float, WS_CS8)[p] = a * (1.0f / 127.0f);
        const GAS v2u* row = (const GAS v2u*)(WSP(bf16, WS_WIN) + (size_t)p * D) + F.lane;
        v4u q;
#pragma unroll
        for (int j = 0; j < 4; ++j) { const v2u w = row[64 * j]; unsigned b = 0u;
            b = __builtin_amdgcn_cvt_pk_u8_f32(__builtin_rintf(__builtin_fmaf(bflo(w[0]), inv, 128.0f)), 0, b); b = __builtin_amdgcn_cvt_pk_u8_f32(__builtin_rintf(__builtin_fmaf(bfhi(w[0]), inv, 128.0f)), 1, b);
            b = __builtin_amdgcn_cvt_pk_u8_f32(__builtin_rintf(__builtin_fmaf(bflo(w[1]), inv, 128.0f)), 2, b); b = __builtin_amdgcn_cvt_pk_u8_f32(__builtin_rintf(__builtin_fmaf(bfhi(w[1]), inv, 128.0f)), 3, b);
            q[j] = b ^ 0x80808080u; }
        *(GAS v4u*)(F.ws + WS_WIN8 + (size_t)p * D + 16 * F.lane) = q;
    }
    for (int r = gw; r < NEXP * 256; r += NGW) {
        const float a = __builtin_bit_cast(float, __hip_atomic_load(F.ctl + CW_CMAX + NP + r, RLX_AGENT)); const float inv = a > 0.f ? 127.0f / a : 0.f;
        if (F.lane == 0) WSP(float, WS_CSU)[r] = a * (1.0f / 127.0f);
        const GAS v4u* row = (const GAS v4u*)(WSP(bf16, WS_WGU) + (size_t)r * D + 32 * (F.lane >> 1) + 8 * (F.lane & 1));
        v4u q;
#pragma unroll
        for (int c = 0; c < 2; ++c) { const v4u w = row[2 * c];
#pragma unroll
            for (int j = 0; j < 2; ++j) { unsigned b = 0u;
                b = __builtin_amdgcn_cvt_pk_u8_f32(__builtin_rintf(__builtin_fmaf(bflo(w[2 * j]), inv, 128.0f)), 0, b); b = __builtin_amdgcn_cvt_pk_u8_f32(__builtin_rintf(__builtin_fmaf(bfhi(w[2 * j]), inv, 128.0f)), 1, b);
                b = __builtin_amdgcn_cvt_pk_u8_f32(__builtin_rintf(__builtin_fmaf(bflo(w[2 * j + 1]), inv, 128.0f)), 2, b); b = __builtin_amdgcn_cvt_pk_u8_f32(__builtin_rintf(__builtin_fmaf(bfhi(w[2 * j + 1]), inv, 128.0f)), 3, b);
                q[2 * c + j] = b ^ 0x80808080u; } }
        *(GAS v4u*)(F.ws + WS_WGU8 + (size_t)r * D + 16 * F.lane) = q;
    }
    for (int r = gw; r < D; r += NGW) {
        const float a = __builtin_bit_cast(float, __hip_atomic_load(F.ctl + CW_CMAX + NP + NEXP * 256 + r, RLX_AGENT)); const float inv = a > 0.f ? 127.0f / a : 0.f;
        if (F.lane == 0) WSP(float, WS_CSO)[r] = a * (1.0f / 127.0f);
        const GAS v4u* row = (const GAS v4u*)(WSP(bf16, WS_WO) + (size_t)r * D + 256 * (F.lane >> 4) + 32 * ((F.lane >> 2) & 3) + 8 * (F.lane & 3));
        v4u q;
#pragma unroll
        for (int c = 0; c < 2; ++c) { const v4u w = row[16 * c];
#pragma unroll
            for (int j = 0; j < 2; ++j) { unsigned b = 0u;
                b = __builtin_amdgcn_cvt_pk_u8_f32(__builtin_rintf(__builtin_fmaf(bflo(w[2 * j]), inv, 128.0f)), 0, b); b = __builtin_amdgcn_cvt_pk_u8_f32(__builtin_rintf(__builtin_fmaf(bfhi(w[2 * j]), inv, 128.0f)), 1, b);
                b = __builtin_amdgcn_cvt_pk_u8_f32(__builtin_rintf(__builtin_fmaf(bflo(w[2 * j + 1]), inv, 128.0f)), 2, b); b = __builtin_amdgcn_cvt_pk_u8_f32(__builtin_rintf(__builtin_fmaf(bfhi(w[2 * j + 1]), inv, 128.0f)), 3, b);
                q[2 * c + j] = b ^ 0x80808080u; } }
        *(GAS v4u*)(F.ws + WS_WO8 + (size_t)r * D + 16 * F.lane) = q;
    }
}
namespace pg8 {
template <bool I8>
struct EpiG1 {
    static constexpr bool PERM = true, CARRY = false;
    unsigned char* ws; const float *gq, *gk; const float *RS, *CS;
    __device__ __forceinline__ int operator()(const f32x4 (&acc)[2][2][4][2], const Unit& u, int wr, int wc, int fr, int fq) const {
        { int l; asm volatile("v_mbcnt_lo_u32_b32 %0, -1, 0\n\tv_mbcnt_hi_u32_b32 %0, -1, %0" : "=v"(l)); fr = l & 15; fq = l >> 4; }
        const int pn = u.pn; const size_t row0 = (size_t)u.pm * BM + wr * 64 + fr;
        float rsc[2][4]; f32x4 csc[2][2];
        if constexpr (I8) {
#pragma unroll
            for (int ai = 0; ai < 2; ++ai)
#pragma unroll
                for (int m = 0; m < 4; ++m) rsc[ai][m] = RS[row0 + ai * HALF + m * 16];
#pragma unroll
            for (int bj = 0; bj < 2; ++bj)
#pragma unroll
                for (int n = 0; n < 2; ++n) csc[bj][n] = *(const f32x4*)(CS + pn * BM + bj * HALF + wc * 32 + 8 * fq + 4 * n);
        }
        auto DQ = [&](int ai, int bj, int m, int n) -> f32x4 {
            if constexpr (I8) return __builtin_convertvector(__builtin_bit_cast(i32x4, acc[ai][bj][m][n]), f32x4) * csc[bj][n] * rsc[ai][m];
            else return acc[ai][bj][m][n]; };
        if (pn >= 6 && pn < 10) {
            const bool isq = pn < 8; const int t2 = pn - (isq ? 6 : 8); bf16_t* out = (bf16_t*)(ws + (isq ? WS_QB : WS_KB)); const float* g = isq ? gq : gk; const float sc = isq ? 0.125f * 1.4426950408889634f : 1.0f;
            f32x4 gl[2][2];
#pragma unroll
            for (int bj = 0; bj < 2; ++bj)
#pragma unroll
                for (int n = 0; n < 2; ++n) gl[bj][n] = *(const f32x4*)(g + 32 * bj + 8 * fq + 4 * n) * sc;
#pragma unroll
            for (int ai = 0; ai < 2; ++ai)
#pragma unroll
                for (int m = 0; m < 4; ++m) {
                    float ss = 0.f; f32x4 xv[2][2];
#pragma unroll
                    for (int bj = 0; bj < 2; ++bj)
#pragma unroll
                        for (int n = 0; n < 2; ++n) { const f32x4 x = DQ(ai, bj, m, n); xv[bj][n] = x; ss += (x[0] * x[0] + x[1] * x[1]) + (x[2] * x[2] + x[3] * x[3]); }
                    ss += __shfl_xor(ss, 16); ss += __shfl_xor(ss, 32);
                    const float rs = 1.0f / sqrtf(ss * (1.0f / 64.0f) + 1e-6f);
                    bf16_t* rowp = out + (row0 + ai * HALF + m * 16) * 512 + t2 * 256 + 64 * wc + 8 * fq;
#pragma unroll
                    for (int bj = 0; bj < 2; ++bj) { const f32x4 v0 = xv[bj][0] * rs * gl[bj][0], v1 = xv[bj][1] * rs * gl[bj][1];
                        u32x4 w; w.x = cvt_pk_bf16(v0[0], v0[1]); w.y = cvt_pk_bf16(v0[2], v0[3]); w.z = cvt_pk_bf16(v1[0], v1[1]); w.w = cvt_pk_bf16(v1[2], v1[3]);
                        __builtin_nontemporal_store(w, (u32x4*)(rowp + 32 * bj)); }
                }
            return 16;
        }
        if (pn == 13) {
            if (wc == 0) {
#pragma unroll
                for (int ai = 0; ai < 2; ++ai)
#pragma unroll
                    for (int m = 0; m < 4; ++m) { const f32x4 v0 = DQ(ai, 0, m, 0), v1 = DQ(ai, 0, m, 1);
                        u32x4 w; w.x = cvt_pk_bf16(v0[0], v0[1]); w.y = cvt_pk_bf16(v0[2], v0[3]); w.z = cvt_pk_bf16(v1[0], v1[1]); w.w = cvt_pk_bf16(v1[2], v1[3]);
                        *(u32x4*)((bf16_t*)(ws + WS_KI) + (row0 + ai * HALF + m * 16) * 32 + 8 * fq) = w; }
            } else if (wc == 1 && fq < 3) {
#pragma unroll
                for (int ai = 0; ai < 2; ++ai)
#pragma unroll
                    for (int m = 0; m < 4; ++m) { const size_t r = row0 + ai * HALF + m * 16;
                        float* dst = (fq == 0) ? ((float*)(ws + WS_WI) + r * 8) : ((float*)(ws + WS_ALR) + r * 16 + 8 * (fq - 1));
                        *(f32x4*)dst = DQ(ai, 0, m, 0); *(f32x4*)(dst + 4) = DQ(ai, 0, m, 1); }
            }
            return wc == 0 ? 8 : (wc == 1 ? 16 : 0);
        }
        if (pn >= 14) {
            unsigned char* gb = ws + (pn < 18 ? WS_GA : WS_GB) + ((pn - 14) & 3) * 256 + 64 * wc + 16 * fq;
#pragma unroll
            for (int ai = 0; ai < 2; ++ai)
#pragma unroll
                for (int m = 0; m < 4; ++m) { u32x4 w;
#pragma unroll
                    for (int bj = 0; bj < 2; ++bj) { const f32x4 v0 = DQ(ai, bj, m, 0), v1 = DQ(ai, bj, m, 1); unsigned b0 = 0u, b1 = 0u;
#pragma unroll
                        for (int j = 0; j < 4; ++j) { b0 = __builtin_amdgcn_cvt_pk_u8_f32(sigmoidf_(v0[j]) * 255.0f, j, b0); b1 = __builtin_amdgcn_cvt_pk_u8_f32(sigmoidf_(v1[j]) * 255.0f, j, b1); }
                        if (bj == 0) { w.x = b0; w.y = b1; } else { w.z = b0; w.w = b1; } }
                    __builtin_nontemporal_store(w, (u32x4*)(gb + (row0 + ai * HALF + m * 16) * (size_t)1024)); }
            return 8;
        }
        const bool act = (pn == 4 || pn == 5);
        const size_t ob = pn == 0 ? WS_QA : (pn == 1 ? WS_KA : (pn < 4 ? WS_VA : (pn < 6 ? WS_RA : (pn < 12 ? WS_VB : WS_QI))));
        const int ld = (pn < 2 || pn == 12) ? 256 : 512, cb = (pn < 2 || pn == 12) ? 0 : ((pn < 4 ? pn - 2 : (pn < 6 ? pn - 4 : pn - 10)) * 256);
        bf16_t* base = (bf16_t*)(ws + ob);
        const int col0 = cb + wc * 32 + 8 * fq;
#pragma unroll
        for (int ai = 0; ai < 2; ++ai)
#pragma unroll
            for (int m = 0; m < 4; ++m) { bf16_t* rowp = base + (row0 + ai * HALF + m * 16) * ld + col0;
#pragma unroll
                for (int bj = 0; bj < 2; ++bj) { f32x4 v0 = DQ(ai, bj, m, 0), v1 = DQ(ai, bj, m, 1);
                    if (act) {
#pragma unroll
                        for (int j = 0; j < 4; ++j) { v0[j] = siluf_(v0[j]); v1[j] = siluf_(v1[j]); } }
                    u32x4 w; w.x = cvt_pk_bf16(v0[0], v0[1]); w.y = cvt_pk_bf16(v0[2], v0[3]); w.z = cvt_pk_bf16(v1[0], v1[1]); w.w = cvt_pk_bf16(v1[2], v1[3]);
                    __builtin_nontemporal_store(w, (u32x4*)(rowp + bj * HALF)); } }
        return 16;
    }
};
struct G1Order {
    static constexpr bool GATHER = false, SPLITB = false;
    int G, c, ns, set, cnt;
    __device__ bool next(int i, Unit& u) const {
        u.sel = 0;
        if (c < ns) return false;
        const long L = (long)i * (G - ns) + (c - ns); if (L >= 256L * cnt) return false;
        int j; tile_of((int)L, 256, cnt, u.pm, j);
        u.pn = g1_tile(set, j); return true;
    }
    __device__ __forceinline__ const char* baseA(const Gemm& g, const Unit& u) const { return (const char*)g.A + (size_t)u.pm * BM * g.lda * 2; }
    __device__ __forceinline__ const char* baseB(const Gemm& g, const Unit& u) const { return (const char*)g.Bt + (size_t)u.pn * BM * g.ldb * 2; }
};
struct PairOrder {
    static constexpr bool GATHER = false, SPLITB = false;
    int nM, nN, nwg, G, c; const bf16_t* Wa; const bf16_t* Wb;
    __device__ bool next(int i, Unit& u) const {
        const long L = (long)(i >> 1) * G + c; if (L >= nwg) return false;
        tile_of((int)L, nM, nN, u.pm, u.pn); u.sel = i & 1; return true;
    }
    __device__ __forceinline__ const char* baseA(const Gemm& g, const Unit& u) const { return (const char*)g.A + ((size_t)u.pm * BM * g.lda + (u.sel ? 512 : 0)) * 2; }
    __device__ __forceinline__ const char* baseB(const Gemm& g, const Unit& u) const { return (const char*)(u.sel ? Wb : Wa) + (size_t)u.pn * BM * g.ldb * 2; }
};
struct PanelX { PG8_LAS float* xl; unsigned* slots; gu32* cnt; float* scale; };
__device__ __forceinline__ void panel_rowmax(const PanelX& P, int pm, int pn, int wr, int wc, int fr, int fq, float (&mx)[8]) {
    const int tid = threadIdx.x;
#pragma unroll
    for (int it = 0; it < 8; ++it) { mx[it] = fmaxf(mx[it], __shfl_xor(mx[it], 16)); mx[it] = fmaxf(mx[it], __shfl_xor(mx[it], 32)); }
    if (fq == 0) {
#pragma unroll
        for (int it = 0; it < 8; ++it) P.xl[wc * 256 + (it >> 2) * HALF + wr * 64 + (it & 3) * 16 + fr] = mx[it]; }
    __syncthreads();
    if (tid < 256) { const float v = fmaxf(fmaxf(P.xl[tid], P.xl[256 + tid]), fmaxf(P.xl[512 + tid], P.xl[768 + tid]));
        __hip_atomic_store(P.slots + (pm * 4 + pn) * 256 + tid, __builtin_bit_cast(unsigned, v), RLX_AGENT); }
    asm volatile("s_waitcnt vmcnt(0)" ::: "memory");
    __syncthreads();
    if (tid == 0) { __hip_atomic_fetch_add(P.cnt + pm, 1u, __ATOMIC_RELEASE, __HIP_MEMORY_SCOPE_AGENT);
        while (__hip_atomic_load(P.cnt + pm, __ATOMIC_ACQUIRE, __HIP_MEMORY_SCOPE_AGENT) < 4u) __builtin_amdgcn_s_sleep(2); }
    __syncthreads();
    if (tid < 256) { unsigned s[4];
#pragma unroll
        for (int j = 0; j < 4; ++j) s[j] = __hip_atomic_load(P.slots + (pm * 4 + j) * 256 + tid, RLX_AGENT);
        const float v = fmaxf(fmaxf(__builtin_bit_cast(float, s[0]), __builtin_bit_cast(float, s[1])), fmaxf(__builtin_bit_cast(float, s[2]), __builtin_bit_cast(float, s[3])));
        P.xl[1024 + tid] = v; if (pn == 0) P.scale[(size_t)pm * 256 + tid] = v * (1.0f / 127.0f); }
    __syncthreads();
#pragma unroll
    for (int it = 0; it < 8; ++it) mx[it] = P.xl[1024 + (it >> 2) * HALF + wr * 64 + (it & 3) * 16 + fr];
}
struct EpiMix {
    static constexpr bool PERM = true, CARRY = true;
    const bf16_t *GA, *GB; unsigned char* M8; PanelX PX;
    __device__ __forceinline__ int operator()(f32x4 (&acc)[2][2][4][2], const Unit& u, int wr, int wc, int fr, int fq) const {
        { int l; asm volatile("v_mbcnt_lo_u32_b32 %0, -1, 0\n\tv_mbcnt_hi_u32_b32 %0, -1, %0" : "=v"(l)); fr = l & 15; fq = l >> 4; }
        const size_t row0 = (size_t)u.pm * BM + wr * 64 + fr; const int col0 = u.pn * BM + wc * 32 + 8 * fq;
        const unsigned char* ga = (const unsigned char*)GA; const unsigned char* gb = (const unsigned char*)GB;
        float mx[8]; v2u wbb[2][2], wab[2][2];
#pragma unroll
        for (int bj = 0; bj < 2; ++bj) { const size_t off = row0 * 1024 + col0 + bj * HALF; wbb[0][bj] = *(const v2u*)(gb + off); wab[0][bj] = (v2u){0u, 0u}; if (!u.sel) wab[0][bj] = *(const v2u*)(ga + off); }
#pragma unroll
        for (int it = 0; it < 8; ++it) { const int ai = it >> 2, m = it & 3, sl = it & 1;
            if (it + 1 < 8) { const size_t offn = (row0 + ((it + 1) >> 2) * HALF + ((it + 1) & 3) * 16) * 1024 + col0;
#pragma unroll
                for (int bj = 0; bj < 2; ++bj) { wbb[sl ^ 1][bj] = *(const v2u*)(gb + offn + bj * HALF); wab[sl ^ 1][bj] = (v2u){0u, 0u}; if (!u.sel) wab[sl ^ 1][bj] = *(const v2u*)(ga + offn + bj * HALF); } }
            asm volatile("" ::: "memory");
            mx[it] = 0.f;
#pragma unroll
            for (int bj = 0; bj < 2; ++bj) { const v2u wb = wbb[sl][bj]; f32x4 v0 = acc[ai][bj][m][0], v1 = acc[ai][bj][m][1];
                float b[8];
#pragma unroll
                for (int j = 0; j < 4; ++j) { b[j] = fmaxf((float)((wb[0] >> (8 * j)) & 255u), 1.0f); b[4 + j] = fmaxf((float)((wb[1] >> (8 * j)) & 255u), 1.0f); }
                if (!u.sel) { const v2u wa = wab[sl][bj];
#pragma unroll
                    for (int j = 0; j < 4; ++j) { v0[j] *= (float)((wa[0] >> (8 * j)) & 255u) * __builtin_amdgcn_rcpf(b[j]); v1[j] *= (float)((wa[1] >> (8 * j)) & 255u) * __builtin_amdgcn_rcpf(b[4 + j]); } }
                else {
#pragma unroll
                    for (int j = 0; j < 4; ++j) { v0[j] *= b[j] * (1.0f / 255.0f); v1[j] *= b[4 + j] * (1.0f / 255.0f); }
                    mx[it] = fmaxf(fmaxf(mx[it], fmaxf(fmaxf(fabsf(v0[0]), fabsf(v0[1])), fmaxf(fabsf(v0[2]), fabsf(v0[3])))), fmaxf(fmaxf(fabsf(v1[0]), fabsf(v1[1])), fmaxf(fabsf(v1[2]), fabsf(v1[3])))); }
                acc[ai][bj][m][0] = v0; acc[ai][bj][m][1] = v1; } }
        if (!u.sel) return 0;
        panel_rowmax(PX, u.pm, u.pn, wr, wc, fr, fq, mx);
        unsigned char* o8 = M8 + row0 * 1024 + u.pn * BM + 64 * wc + 16 * fq;
#pragma unroll
        for (int it = 0; it < 8; ++it) { const int ai = it >> 2, m = it & 3; const float a = mx[it]; const float inv = a > 0.f ? 127.0f / a : 0.f;
            u32x4 w;
#pragma unroll
            for (int bj = 0; bj < 2; ++bj) { const f32x4 v0 = acc[ai][bj][m][0], v1 = acc[ai][bj][m][1]; unsigned b0 = 0u, b1 = 0u;
#pragma unroll
                for (int j = 0; j < 4; ++j) { b0 = __builtin_amdgcn_cvt_pk_u8_f32(__builtin_rintf(__builtin_fmaf(v0[j], inv, 128.0f)), j, b0); b1 = __builtin_amdgcn_cvt_pk_u8_f32(__builtin_rintf(__builtin_fmaf(v1[j], inv, 128.0f)), j, b1); }
                if (bj == 0) { w.x = b0 ^ 0x80808080u; w.y = b1 ^ 0x80808080u; } else { w.z = b0 ^ 0x80808080u; w.w = b1 ^ 0x80808080u; } }
            *(u32x4*)(o8 + (size_t)(ai * HALF + m * 16) * 1024) = w; }
        return 8;
    }
};
struct EpiRes {
    static constexpr bool PERM = true, CARRY = false;
    const float* X; bf16_t* XB; const float *MS, *CSO; PG8_LAS float* xl; unsigned* slots;
    __device__ __forceinline__ int operator()(const f32x4 (&acc)[2][2][4][2], const Unit& u, int wr, int wc, int fr, int fq) const {
        { int l; asm volatile("v_mbcnt_lo_u32_b32 %0, -1, 0\n\tv_mbcnt_hi_u32_b32 %0, -1, %0" : "=v"(l)); fr = l & 15; fq = l >> 4; }
        const size_t row0 = (size_t)u.pm * BM + wr * 64 + fr; const int col0 = u.pn * BM + wc * 32 + 8 * fq;
        f32x4 csc[2][2];
#pragma unroll
        for (int bj = 0; bj < 2; ++bj)
#pragma unroll
            for (int n = 0; n < 2; ++n) csc[bj][n] = *(const f32x4*)(CSO + col0 + bj * HALF + 4 * n);
        f32x4 xb[2][2][2];
#pragma unroll
        for (int bj = 0; bj < 2; ++bj) { const size_t off = row0 * 1024 + col0 + bj * HALF; xb[0][bj][0] = *(const f32x4*)(X + off); xb[0][bj][1] = *(const f32x4*)(X + off + 4); }
#pragma unroll
        for (int it = 0; it < 8; ++it) { const int ai = it >> 2, m = it & 3, sl = it & 1; const size_t off = (row0 + ai * HALF + m * 16) * 1024 + col0;
            if (it + 1 < 8) { const size_t offn = (row0 + ((it + 1) >> 2) * HALF + ((it + 1) & 3) * 16) * 1024 + col0;
#pragma unroll
                for (int bj = 0; bj < 2; ++bj) { xb[sl ^ 1][bj][0] = *(const f32x4*)(X + offn + bj * HALF); xb[sl ^ 1][bj][1] = *(const f32x4*)(X + offn + bj * HALF + 4); } }
            asm volatile("" ::: "memory");
            const float rsc = MS[row0 + ai * HALF + m * 16]; float mx = 0.f;
#pragma unroll
            for (int bj = 0; bj < 2; ++bj) { const f32x4 y0 = xb[sl][bj][0] + __builtin_convertvector(__builtin_bit_cast(i32x4, acc[ai][bj][m][0]), f32x4) * csc[bj][0] * rsc, y1 = xb[sl][bj][1] + __builtin_convertvector(__builtin_bit_cast(i32x4, acc[ai][bj][m][1]), f32x4) * csc[bj][1] * rsc;
                mx = fmaxf(fmaxf(mx, fmaxf(fmaxf(fabsf(y0[0]), fabsf(y0[1])), fmaxf(fabsf(y0[2]), fabsf(y0[3])))), fmaxf(fmaxf(fabsf(y1[0]), fabsf(y1[1])), fmaxf(fabsf(y1[2]), fabsf(y1[3]))));
                u32x4 w; w.x = cvt_pk_bf16(y0[0], y0[1]); w.y = cvt_pk_bf16(y0[2], y0[3]); w.z = cvt_pk_bf16(y1[0], y1[1]); w.w = cvt_pk_bf16(y1[2], y1[3]);
                *(u32x4*)(XB + off + bj * HALF) = w; }
            mx = fmaxf(mx, __shfl_xor(mx, 16)); mx = fmaxf(mx, __shfl_xor(mx, 32));
            if (fq == 0) xl[wc * 256 + ai * HALF + wr * 64 + m * 16 + fr] = __builtin_bit_cast(float, f2bf(mx) << 16);
            asm volatile("" ::: "memory"); }
        __syncthreads();
        { const int tid = threadIdx.x;
          if (tid < 256) { const float v = fmaxf(fmaxf(xl[tid], xl[256 + tid]), fmaxf(xl[512 + tid], xl[768 + tid])); slots[(u.pm * 4 + u.pn) * 256 + tid] = __builtin_bit_cast(unsigned, v); } }
        __syncthreads();
        return 16;
    }
};
}
__device__ __forceinline__ void gla_prep(Frame& F, const Args& A) {
    const int half = F.tid >> 8, dcol = F.tid & 255;
    LAS float* alr_s = (LAS float*)(F.lds) + half * 1024;
    const float* W2 = A.in[IN_WA2]; const float* ALR = WSP(float, WS_ALR); const bf16* KA = WSP(bf16, WS_KA);
    bf16* KDT = WSP(bf16, WS_KDT); float* DEC = WSP(float, WS_DEC);
    float w2[16];
#pragma unroll
    for (int r = 0; r < 16; ++r) w2[r] = W2[r * 256 + dcol];
    const float bb = A.in[IN_BA][dcol];
    for (int it = F.vcu; it < NCHUNK / 2; it += F.G) {
        const int chunk = it * 2 + half; const size_t row0 = (size_t)chunk * CH;
        __syncthreads();
        *(LAS f32x4*)(alr_s + dcol * 4) = *(const f32x4*)(ALR + row0 * 16 + dcol * 4);
        __syncthreads();
        float cum[64]; float run = 0.f;
#pragma unroll
        for (int t = 0; t < 64; ++t) {
            float z = bb;
#pragma unroll
            for (int r4 = 0; r4 < 4; ++r4) { const f32x4 a = *(const LAS f32x4*)(alr_s + t * 16 + r4 * 4); z += a[0] * w2[r4 * 4] + a[1] * w2[r4 * 4 + 1] + a[2] * w2[r4 * 4 + 2] + a[3] * w2[r4 * 4 + 3]; }
            const float ls = fminf(z, 0.f) - 0.6931471805599453f * __builtin_amdgcn_logf(1.0f + __builtin_amdgcn_exp2f(-fabsf(z) * LOG2E));
            run += ls * (1.0f / 16.0f); cum[t] = run;
        }
        const float total = run;
        DEC[(size_t)chunk * 256 + dcol] = __builtin_amdgcn_exp2f(total * LOG2E);
        const int h = dcol >> 6, d = dcol & 63;
        bf16* dst = KDT + (((size_t)chunk * 4 + h) * 64 + d) * 64;
        const bf16* ksrc = KA + row0 * 256 + dcol;
#pragma unroll
        for (int t8 = 0; t8 < 8; ++t8) {
            float kv[8];
#pragma unroll
            for (int j = 0; j < 8; ++j) { const int t = t8 * 8 + j; kv[j] = bf2f(ksrc[(size_t)t * 256]) * __builtin_amdgcn_exp2f((total - cum[t]) * LOG2E); }
            v4u o; o.x = pk2(kv[0], kv[1]); o.y = pk2(kv[2], kv[3]); o.z = pk2(kv[4], kv[5]); o.w = pk2(kv[6], kv[7]);
            *(GAS v4u*)(dst + t8 * 8) = o;
        }
    }
    __syncthreads();
}
namespace gla {
using s16x4 = __attribute__((ext_vector_type(4))) short;
typedef short v4i16_t __attribute__((ext_vector_type(4)));
typedef __attribute__((address_space(3))) const char* lds_cptr;
__device__ __forceinline__ s16x4 vtr(lds_cptr p) { return __builtin_bit_cast(s16x4, __builtin_amdgcn_ds_read_tr16_b64_v4i16((__attribute__((address_space(3))) v4i16_t*)p)); }
__device__ __forceinline__ void glds16(const void* gsrc, unsigned lds_dst) { unsigned keep;
    asm volatile("s_mov_b32 %0, m0\n\ts_mov_b32 m0, %2\n\ts_nop 0\n\tglobal_load_lds_dwordx4 %1, off\n\ts_mov_b32 m0, %0" : "=&s"(keep) : "v"(gsrc), "s"(lds_dst) : "memory"); }
__device__ __forceinline__ unsigned cvtpk(float lo, float hi) { return pg8::cvt_pk_bf16(lo, hi); }
constexpr int L_Q = 0, L_KD = 16384, L_V = 32768, L_R = 65536, L_DEC = 98304, L_OST = 98816, L_RED = 115200, L_END = L_RED + 2048;
struct Ctx { const bf16* KDT; const float* DEC; const bf16* QA; const bf16* VA; const bf16* RA; bf16* OC; };
#define GLA_BAR() asm volatile("s_waitcnt lgkmcnt(0)\n\ts_barrier" ::: "memory")

__device__ __forceinline__ void load_chunk(const Ctx& X, unsigned lds0, int chunk, int h, int ld, int lane, int slot) {
    const size_t row0 = (size_t)chunk * 64;
#pragma unroll
    for (int i = 0; i < 2; ++i) { const int p = 128 * ld + 64 * i + lane, r = p >> 3, cg = (p & 7) ^ (r & 7);
        glds16(X.QA + (row0 + r) * 256 + h * 64 + cg * 8, (unsigned)__builtin_amdgcn_readfirstlane(lds0 + L_Q + slot * 8192 + (128 * ld + 64 * i) * 16));
        glds16(X.KDT + (((size_t)chunk * 4 + h) * 64 + r) * 64 + cg * 8, (unsigned)__builtin_amdgcn_readfirstlane(lds0 + L_KD + slot * 8192 + (128 * ld + 64 * i) * 16)); }
    const size_t voff = (row0 + (lane >> 2)) * 512 + h * 128 + ld * 32 + (lane & 3) * 8;
#pragma unroll
    for (int p = 0; p < 4; ++p) { glds16(X.VA + voff + (size_t)p * 16 * 512, (unsigned)__builtin_amdgcn_readfirstlane(lds0 + L_V + slot * 16384 + ld * 4096 + p * 1024));
                                  glds16(X.RA + voff + (size_t)p * 16 * 512, (unsigned)__builtin_amdgcn_readfirstlane(lds0 + L_R + slot * 16384 + ld * 4096 + p * 1024)); }
}
__device__ __forceinline__ void store_chunk(const Ctx& X, LAS unsigned char* lds, int chunk, int h, int ld, int lane) {
    const size_t row0 = (size_t)chunk * 64; v4u v[4];
#pragma unroll
    for (int p = 0; p < 4; ++p) v[p] = *(const LAS v4u*)(lds + L_OST + ld * 4096 + p * 1024 + lane * 16);
    asm volatile("s_waitcnt lgkmcnt(0)" ::: "memory");
#pragma unroll
    for (int p = 0; p < 4; ++p) *(v4u*)(X.OC + (row0 + 16 * p + (lane >> 2)) * 1024 + h * 128 + ld * 32 + (lane & 3) * 8) = v[p];
}
__device__ __forceinline__ void step_a(LAS unsigned char* lds, int slot, int sl, int lane, f32x16 (&S)[2], f32x16 (&oT)[2]) {
    const int n32 = lane & 31, hi = lane >> 5;
    const LAS float* dsc = (const LAS float*)(lds + L_DEC + slot * 256);
#pragma unroll
    for (int dt = 0; dt < 2; ++dt)
#pragma unroll
        for (int g = 0; g < 4; ++g) { const f32x4 dv = *(const LAS f32x4*)(dsc + 32 * dt + 8 * g + 4 * hi);
#pragma unroll
            for (int j = 0; j < 4; ++j) S[dt][4 * g + j] *= dv[j]; }
    const lds_cptr kdp = (lds_cptr)lds + L_KD + slot * 8192, qp = (lds_cptr)lds + L_Q + slot * 8192;
    const lds_cptr vp = (lds_cptr)lds + L_V + slot * 16384 + sl * 4096 + ((lane >> 4) & 1) * 32 + (lane & 3) * 8 + (8 * hi + ((lane & 15) >> 2)) * 64;
#pragma unroll
    for (int s = 0; s < 4; ++s) { const s16x4 a0 = vtr(vp + s * 1024), a1 = vtr(vp + s * 1024 + 256);
        const bf16x8 vf = (bf16x8){a0[0], a0[1], a0[2], a0[3], a1[0], a1[1], a1[2], a1[3]};
#pragma unroll
        for (int dt = 0; dt < 2; ++dt) { const int d = 32 * dt + n32; const bf16x8 kf = *(const __attribute__((address_space(3))) bf16x8*)(kdp + d * 128 + (((2 * s + hi) ^ (d & 7)) << 4));
            S[dt] = __builtin_amdgcn_mfma_f32_32x32x16_bf16(kf, vf, S[dt], 0, 0, 0); } }
    v4u sa[2][2];
#pragma unroll
    for (int dt = 0; dt < 2; ++dt)
#pragma unroll
        for (int s = 0; s < 2; ++s)
#pragma unroll
            for (int i = 0; i < 4; ++i) sa[dt][s][i] = cvtpk(S[dt][8 * s + 2 * i], S[dt][8 * s + 2 * i + 1]);
#pragma unroll
    for (int tn = 0; tn < 2; ++tn) { const int t = 32 * tn + n32;
#pragma unroll
        for (int r = 0; r < 16; ++r) oT[tn][r] = 0.f;
#pragma unroll
        for (int dt = 0; dt < 2; ++dt)
#pragma unroll
            for (int s = 0; s < 2; ++s) { const int c0 = 4 * dt + 2 * s;
                const v2u q0 = *(const __attribute__((address_space(3))) v2u*)(qp + t * 128 + ((c0 ^ (t & 7)) << 4) + 8 * hi), q1 = *(const __attribute__((address_space(3))) v2u*)(qp + t * 128 + (((c0 + 1) ^ (t & 7)) << 4) + 8 * hi);
                const v4u qq = (v4u){q0[0], q0[1], q1[0], q1[1]};
                oT[tn] = __builtin_amdgcn_mfma_f32_32x32x16_bf16(__builtin_bit_cast(bf16x8, sa[dt][s]), __builtin_bit_cast(bf16x8, qq), oT[tn], 0, 0, 0); } }
    LAS float* red = (LAS float*)(lds + L_RED) + slot * 256;
#pragma unroll
    for (int tn = 0; tn < 2; ++tn) { float ss = 0.f;
#pragma unroll
        for (int r = 0; r < 16; ++r) ss += oT[tn][r] * oT[tn][r];
        { auto rr = __builtin_amdgcn_permlane32_swap(__float_as_uint(ss), __float_as_uint(ss), false, false); ss = __uint_as_float(rr[0]) + __uint_as_float(rr[1]); }
        if (hi == 0) red[sl * 64 + 32 * tn + n32] = ss; }
}
__device__ __forceinline__ void step_b(LAS unsigned char* lds, int slot, int sl, int lane, const f32x16 (&oT)[2], const float (&gg)[16]) {
    const int n32 = lane & 31, hi = lane >> 5;
    const LAS float* red = (const LAS float*)(lds + L_RED) + slot * 256;
#pragma unroll
    for (int tn = 0; tn < 2; ++tn) { const int t = 32 * tn + n32;
        const float tot = (red[t] + red[64 + t]) + (red[128 + t] + red[192 + t]);
        const float rs = 1.0f / sqrtf(tot * (1.0f / 128.0f) + EPS);
        const int toff = sl * 4096 + (t >> 4) * 1024 + (t & 15) * 64 + 8 * hi;
#pragma unroll
        for (int g = 0; g < 4; ++g) { const v2u rw = *(const LAS v2u*)(lds + L_R + slot * 16384 + toff + 16 * g);
            const float y0 = oT[tn][4 * g] * rs * gg[4 * g] * bflo(rw[0]), y1 = oT[tn][4 * g + 1] * rs * gg[4 * g + 1] * bfhi(rw[0]);
            const float y2 = oT[tn][4 * g + 2] * rs * gg[4 * g + 2] * bflo(rw[1]), y3 = oT[tn][4 * g + 3] * rs * gg[4 * g + 3] * bfhi(rw[1]);
            v2u w; w[0] = cvtpk(y0, y1); w[1] = cvtpk(y2, y3); *(LAS v2u*)(lds + L_OST + toff + 16 * g) = w; } }
}
}

__device__ __forceinline__ void gla_scan_mfma(Frame& F, const Args& A) {
    if (F.vcu >= 64) return;
    const gla::Ctx X{WSP(bf16, WS_KDT), WSP(float, WS_DEC), WSP(bf16, WS_QA), WSP(bf16, WS_VA), WSP(bf16, WS_RA), WSP(bf16, WS_OCAT)};
    const int wid = F.wave, lane = F.lane, hi = lane >> 5;
    const int bh = F.vcu, b = bh >> 2, h = bh & 3, c0 = b * NCH;
    const unsigned lds0 = (unsigned)(uintptr_t)F.lds;
    __syncthreads();
    if (wid >= 4) {
        const int ld = wid - 4;
        gla::load_chunk(X, lds0, c0, h, ld, lane, 0);
        float dv = X.DEC[(size_t)c0 * 256 + h * 64 + lane];
        asm volatile("s_waitcnt vmcnt(0)" ::: "memory");
        if (ld == 0) ((LAS float*)(F.lds + gla::L_DEC))[lane] = dv;
        for (int c = 0; c < NCH; ++c) {
            GLA_BAR();
            if (c + 1 < NCH) { gla::load_chunk(X, lds0, c0 + c + 1, h, ld, lane, (c + 1) & 1); dv = X.DEC[(size_t)(c0 + c + 1) * 256 + h * 64 + lane]; }
            if (c > 0) gla::store_chunk(X, F.lds, c0 + c - 1, h, ld, lane);
            GLA_BAR();
            asm volatile("s_waitcnt vmcnt(0)" ::: "memory");
            if (ld == 0 && c + 1 < NCH) ((LAS float*)(F.lds + gla::L_DEC + ((c + 1) & 1) * 256))[lane] = dv;
        }
        GLA_BAR();
        gla::store_chunk(X, F.lds, c0 + NCH - 1, h, ld, lane);
    } else {
        const int sl = wid;
        float gg[16];
#pragma unroll
        for (int r = 0; r < 16; ++r) gg[r] = A.in[IN_GGLA][sl * 32 + (r & 3) + 8 * (r >> 2) + 4 * hi];
        f32x16 S[2], oT[2];
#pragma unroll
        for (int r = 0; r < 16; ++r) { S[0][r] = 0.f; S[1][r] = 0.f; }
        for (int c = 0; c < NCH; ++c) {
            GLA_BAR();
            gla::step_a(F.lds, c & 1, sl, lane, S, oT);
            GLA_BAR();
            gla::step_b(F.lds, c & 1, sl, lane, oT, gg);
        }
        GLA_BAR();
    }
    __syncthreads();
}
__device__ __forceinline__ unsigned f2key(float f) { const unsigned u = __builtin_bit_cast(unsigned, f + 0.0f);     return u ^ ((u >> 31) ? 0xffffffffu : 0x80000000u); }
template <int NREG>
__device__ __forceinline__ unsigned long long radix_select(const unsigned (&key)[NREG], int lane) {
    unsigned prefix = 0u; bool exact = false;
    for (int bit = 31; bit >= 0; --bit) {
        const unsigned cand = prefix | (1u << bit); int cnt = 0;
#pragma unroll
        for (int j = 0; j < NREG; ++j) cnt += __popcll(__ballot(key[j] >= cand));
        if (cnt >= 256) { prefix = cand; if (cnt == 256) { exact = true; break; } }
    }
    int mlo = 0, mhi = 0;
    int cgt = 0;
#pragma unroll
    for (int j = 0; j < NREG; ++j) cgt += __popcll(__ballot(key[j] > prefix));
    int rem = exact ? 0 : 256 - cgt;
#pragma unroll
    for (int j = 0; j < NREG; ++j) {
        const unsigned long long gt = __ballot(exact ? key[j] >= prefix : key[j] > prefix), eq = exact ? 0ull : __ballot(key[j] == prefix);
        unsigned long long w = gt;
        if (eq != 0ull && rem > 0) {
            const int c = __popcll(eq);
            if (c <= rem) { w |= eq; rem -= c; }
            else { const int rank = __popcll(eq & ((1ull << lane) - 1ull)); w |= __ballot(((eq >> lane) & 1ull) && rank < rem); rem = 0; }
        }
        asm volatile("s_nop 4\n\tv_writelane_b32 %0, %2, %4\n\tv_writelane_b32 %1, %3, %4" : "+v"(mlo), "+v"(mhi) : "s"((unsigned)w), "s"((unsigned)(w >> 32)), "i"(j));
    }
    return ((unsigned long long)(unsigned)mhi << 32) | (unsigned)mlo;
}
#define DPP_STEP_U(x, ctrl, rmask) __builtin_amdgcn_update_dpp(0, (int)(x), ctrl, rmask, 0xf, false)
__device__ __forceinline__ unsigned dpp_scan_add(unsigned x) {
    x += (unsigned)DPP_STEP_U(x, 0x111, 0xf); x += (unsigned)DPP_STEP_U(x, 0x112, 0xf); x += (unsigned)DPP_STEP_U(x, 0x114, 0xf); x += (unsigned)DPP_STEP_U(x, 0x118, 0xf);
    x += (unsigned)DPP_STEP_U(x, 0x142, 0xa); x += (unsigned)DPP_STEP_U(x, 0x143, 0xc); return x; }
#define DPP_STEP_F(x, ctrl, rmask) __builtin_bit_cast(float, __builtin_amdgcn_update_dpp((int)0xff800000, __builtin_bit_cast(int, (x)), ctrl, rmask, 0xf, false))
__device__ __forceinline__ float dpp_wave_max(float x) {
    x = fmaxf(x, DPP_STEP_F(x, 0x111, 0xf)); x = fmaxf(x, DPP_STEP_F(x, 0x112, 0xf)); x = fmaxf(x, DPP_STEP_F(x, 0x114, 0xf)); x = fmaxf(x, DPP_STEP_F(x, 0x118, 0xf));
    x = fmaxf(x, DPP_STEP_F(x, 0x142, 0xa)); x = fmaxf(x, DPP_STEP_F(x, 0x143, 0xc));
    return __builtin_bit_cast(float, __builtin_amdgcn_readlane(__builtin_bit_cast(int, x), 63)); }
__device__ __forceinline__ float rl_f(float v, int l) { return __builtin_bit_cast(float, __builtin_amdgcn_readlane(__builtin_bit_cast(int, v), l)); }
__device__ __forceinline__ int rl_i(int v, int l) { return __builtin_amdgcn_readlane(v, l); }
template <int NREG>
__device__ __forceinline__ unsigned long long select_hist(LAS float* sc, int nr_, int lane) {
    const int nr = __builtin_amdgcn_readfirstlane(nr_);
    float s[NREG]; float lo = INFINITY, hi = -INFINITY;
#pragma unroll
    for (int j = 0; j < NREG; ++j) { if (j < NREG - 7 || j < nr) { s[j] = sc[j * 64 + lane]; lo = fminf(lo, s[j]); hi = fmaxf(hi, s[j]); } else s[j] = -INFINITY; }
    hi = dpp_wave_max(hi); lo = -dpp_wave_max(-lo);
    float c1 = 4095.0f / fmaxf(hi - lo, 1e-30f), c0 = -lo * c1;
    LAS unsigned* hist = (LAS unsigned*)sc;
    asm volatile("s_waitcnt lgkmcnt(0)" ::: "memory");
#pragma unroll
    for (int k = 0; k < 16; ++k) *(LAS v4u*)(hist + k * 256 + lane * 4) = (v4u){0u, 0u, 0u, 0u};
    asm volatile("s_waitcnt lgkmcnt(0)" ::: "memory");
#define SEL_BIN(v) ((int)__builtin_amdgcn_fmed3f(__builtin_fmaf((v), c1, c0), 0.0f, 4095.0f))
#pragma unroll
    for (int j = 0; j < NREG; ++j) { if (j < NREG - 7 || j < nr) (void)__hip_atomic_fetch_add(hist + SEL_BIN(s[j]), 1u, __ATOMIC_RELAXED, __HIP_MEMORY_SCOPE_WORKGROUP); }
    asm volatile("s_waitcnt lgkmcnt(0)" ::: "memory");
    unsigned tot = 0u;
#pragma unroll
    for (int k = 0; k < 16; ++k) { const v4u h4 = *(const LAS v4u*)(hist + lane * 64 + k * 4); tot += (h4[0] + h4[1]) + (h4[2] + h4[3]); }
    const unsigned pre = dpp_scan_add(tot); const unsigned all = (unsigned)rl_i((int)pre, 63);
    const unsigned suf = all - pre + tot;
    const unsigned above = suf - tot;
    const unsigned long long m1 = __ballot(above < 256u && suf >= 256u);
    const int Ls = __ffsll((long long)m1) - 1;
    const unsigned aboveL = (unsigned)rl_i((int)above, Ls);
    const unsigned hb = hist[Ls * 64 + lane];
    const unsigned pre2 = dpp_scan_add(hb); const unsigned suf2 = (unsigned)rl_i((int)pre2, 63) - pre2 + hb;
    const unsigned ab2 = aboveL + (suf2 - hb);
    const unsigned long long m2 = __ballot(ab2 < 256u && ab2 + hb >= 256u);
    const int ks = __ffsll((long long)m2) - 1;
    const int bstar = Ls * 64 + ks; const int cab = rl_i((int)ab2, ks); const int nc = rl_i((int)hb, ks); const int need = 256 - cab;
    if (nc > 64) {
        unsigned key[NREG];
#pragma unroll
        for (int j = 0; j < NREG; ++j) key[j] = (s[j] == -INFINITY) ? 0u : f2key(s[j]);
        return radix_select<NREG>(key, lane);
    }
    LAS float* cv = (LAS float*)(hist) ; LAS int* ci = (LAS int*)(hist + 64);
    asm volatile("s_waitcnt lgkmcnt(0)" ::: "memory");
    int base = 0;
    asm volatile("" : "+v"(c0), "+v"(c1));
#pragma unroll
    for (int j = 0; j < NREG; ++j) { if (j < NREG - 7 || j < nr) { const bool inb = SEL_BIN(s[j]) == bstar; const unsigned long long mk = __ballot(inb);
        if (mk) { if (inb) { const int p = base + __popcll(mk & ((1ull << lane) - 1ull)); cv[p] = s[j]; ci[p] = j * 64 + lane; } base += __popcll(mk); } } }
#undef SEL_BIN
    asm volatile("s_waitcnt lgkmcnt(0)" ::: "memory");
    const float myv = lane < nc ? cv[lane] : -INFINITY; const int myi = lane < nc ? ci[lane] : 0x7fffffff;
    int rank = 0;
    for (int k = 0; k < nc; ++k) { const float vk = rl_f(myv, k); const int ik = rl_i(myi, k); rank += (vk > myv || (vk == myv && ik < myi)) ? 1 : 0; }
    const unsigned long long m3 = __ballot(lane < nc && rank == need - 1);
    const int ts = __ffsll((long long)m3) - 1;
    const float vstar = rl_f(myv, ts); const int istar = rl_i(myi, ts);
    const int ties = __popcll(__ballot(lane < nc && myv == vstar));
    int mlo = 0, mhi = 0;
    if (ties == 1) {
#pragma unroll
        for (int j = 0; j < NREG; ++j) { const unsigned long long w = __ballot(s[j] >= vstar);
            asm volatile("s_nop 4\n\tv_writelane_b32 %0, %2, %4\n\tv_writelane_b32 %1, %3, %4" : "+v"(mlo), "+v"(mhi) : "s"((unsigned)w), "s"((unsigned)(w >> 32)), "i"(j)); }
    } else {
#pragma unroll
        for (int j = 0; j < NREG; ++j) { const int idx = j * 64 + lane; const unsigned long long w = __ballot(s[j] > vstar || (s[j] == vstar && idx <= istar));
            asm volatile("s_nop 4\n\tv_writelane_b32 %0, %2, %4\n\tv_writelane_b32 %1, %3, %4" : "+v"(mlo), "+v"(mhi) : "s"((unsigned)w), "s"((unsigned)(w >> 32)), "i"(j)); }
    }
    return ((unsigned long long)(unsigned)mhi << 32) | (unsigned)mlo;
}
__device__ __forceinline__ float dsa_relu(float x) { const int b = __builtin_bit_cast(int, x); return __builtin_bit_cast(float, b > 0 ? b : 0); }
__device__ __forceinline__ void dsa_select_mfma(Frame& F, const Args& A) {
    LAS float* sc = (LAS float*)F.lds;
    const bf16* QI = WSP(bf16, WS_QI); const bf16* KI = WSP(bf16, WS_KI); const float* WI = WSP(float, WS_WI);
    unsigned long long* MASK = WSP(unsigned long long, WS_MASK);
    const int lane = F.lane, n32 = lane & 31, hi = lane >> 5;
    const int qi_m = 2 * ((n32 >> 2) & 1) + (n32 >> 4), hd_m = (n32 & 3) + 4 * ((n32 >> 3) & 1);
    for (int u = F.vcu; u < 8192; u += F.G) {
        const int g = u & 7, rest = u >> 3, b = rest & 15;
        int i = rest >> 4;
        if (F.G == 256) i ^= (u >> 8) & 1;

        const int N = (i + 1) * 64; const size_t seq0 = (size_t)b * SEQ; const size_t q0 = seq0 + (size_t)i * 64 + g * 8;
        if (i < 4) {
            const size_t r = q0 + F.wave; const int nw = N >> 6;
            MASK[r * 64 + lane] = (lane < nw) ? ~0ull : 0ull;
            continue;
        }
        bf16x8 aq[2][2]; f32x4 wv[2][4];
#pragma unroll
        for (int mt = 0; mt < 2; ++mt) {
#pragma unroll
            for (int s = 0; s < 2; ++s) aq[mt][s] = *(const bf16x8*)(QI + (q0 + 4 * mt + qi_m) * 256 + hd_m * 32 + 16 * s + 8 * hi);
#pragma unroll
            for (int c = 0; c < 4; ++c) wv[mt][c] = *(const f32x4*)(WI + (q0 + 4 * mt + 2 * hi) * 8 + 4 * c);
        }
        __syncthreads();
        const int nj = N / 32;
        bf16x8 nb0, nb1;
        { const int key = 32 * F.wave + n32; nb0 = *(const bf16x8*)(KI + (seq0 + key) * 32 + 8 * hi); nb1 = *(const bf16x8*)(KI + (seq0 + key) * 32 + 16 + 8 * hi); }
        for (int j = F.wave; j < nj; j += 8) {
            const int key = 32 * j + n32;
            const bf16x8 bk0 = nb0, bk1 = nb1;
            { const int jn = (j + 8 < nj) ? j + 8 : j; const int kn = 32 * jn + n32; nb0 = *(const bf16x8*)(KI + (seq0 + kn) * 32 + 8 * hi); nb1 = *(const bf16x8*)(KI + (seq0 + kn) * 32 + 16 + 8 * hi); }
            f32x16 a0, a1;
#pragma unroll
            for (int r = 0; r < 16; ++r) { a0[r] = 0.f; a1[r] = 0.f; }
            a0 = __builtin_amdgcn_mfma_f32_32x32x16_bf16(aq[0][0], bk0, a0, 0, 0, 0); a0 = __builtin_amdgcn_mfma_f32_32x32x16_bf16(aq[0][1], bk1, a0, 0, 0, 0);
            a1 = __builtin_amdgcn_mfma_f32_32x32x16_bf16(aq[1][0], bk0, a1, 0, 0, 0); a1 = __builtin_amdgcn_mfma_f32_32x32x16_bf16(aq[1][1], bk1, a1, 0, 0, 0);
            float s00 = 0.f, s01 = 0.f, s10 = 0.f, s11 = 0.f;
#pragma unroll
            for (int r = 0; r < 8; ++r) { s00 += wv[0][r >> 2][r & 3] * dsa_relu(a0[r]); s01 += wv[0][2 + (r >> 2)][r & 3] * dsa_relu(a0[8 + r]);
                                          s10 += wv[1][r >> 2][r & 3] * dsa_relu(a1[r]); s11 += wv[1][2 + (r >> 2)][r & 3] * dsa_relu(a1[8 + r]); }
            sc[(2 * hi) * 4096 + key] = s00 + 0.0f; sc[(2 * hi + 1) * 4096 + key] = s01 + 0.0f; sc[(4 + 2 * hi) * 4096 + key] = s10 + 0.0f; sc[(5 + 2 * hi) * 4096 + key] = s11 + 0.0f;
        }
        __syncthreads();
        unsigned long long w;
        LAS float* my = sc + F.wave * 4096;
        switch ((i + 8) >> 3) {
            case 1: w = select_hist<8>(my, i + 1, lane); break;
            case 2: w = select_hist<16>(my, i + 1, lane); break;
            case 3: w = select_hist<24>(my, i + 1, lane); break;
            case 4: w = select_hist<32>(my, i + 1, lane); break;
            case 5: w = select_hist<40>(my, i + 1, lane); break;
            case 6: w = select_hist<48>(my, i + 1, lane); break;
            case 7: w = select_hist<56>(my, i + 1, lane); break;
            default: w = select_hist<64>(my, i + 1, lane); break;
        }
        MASK[(q0 + F.wave) * 64 + lane] = w;
    }
    __syncthreads();
}

__device__ __forceinline__ int t5_bucket(int rel) {
    const int n = rel < 0 ? -rel : rel;
    const int v = n < 8 ? n : 8 + (n >= 12) + (n >= 16) + (n >= 23) + (n >= 32) + (n >= 46) + (n >= 64) + (n >= 91);
    return (rel > 0 ? 16 : 0) + v;
}
namespace att {
using s16x4 = __attribute__((ext_vector_type(4))) short;
typedef short v4i16_t __attribute__((ext_vector_type(4)));
constexpr int SLOTB = 8192, LDS_K = 0  , LDS_V = 4 * SLOTB  , LDS_TBL = 6 * SLOTB  , LDS_WS = LDS_TBL + 8 * 2048, LDS_OST = LDS_WS + 8 * 64 * 4, LDS_Q = LDS_OST + 8 * 4096  , LDS_END = LDS_Q + 16;
__device__ __forceinline__ int crow(int r, int hi) { return (r & 3) + 8 * (r >> 2) + 4 * hi; }
__device__ __forceinline__ void glds16(const void* gsrc, unsigned lds_dst) { unsigned keep;
    asm volatile("s_mov_b32 %0, m0\n\ts_mov_b32 m0, %2\n\ts_nop 0\n\tglobal_load_lds_dwordx4 %1, off\n\ts_mov_b32 m0, %0" : "=&s"(keep) : "v"(gsrc), "s"(lds_dst) : "memory"); }
__device__ __forceinline__ void gload8(unsigned long long& dst, const void* gsrc) { asm volatile("global_load_dwordx2 %0, %1, off" : "=v"(dst) : "v"(gsrc) : "memory"); }
typedef __attribute__((address_space(3))) const char* lds_cptr;
__device__ __forceinline__ s16x4 vtr(lds_cptr p) { return __builtin_bit_cast(s16x4, __builtin_amdgcn_ds_read_tr16_b64_v4i16((__attribute__((address_space(3))) v4i16_t*)p)); }
__device__ __forceinline__ unsigned cvtpk(float lo, float hi) { return pg8::cvt_pk_bf16(lo, hi); }

__device__ __forceinline__ void tile_qk(f32x16& p0, f32x16& p1, const bf16x8 (&qr)[4], lds_cptr kb, float cinit) {
#pragma unroll
    for (int r = 0; r < 16; ++r) { p0[r] = cinit; p1[r] = cinit; }
#pragma unroll
    for (int d0 = 0; d0 < 4; ++d0) {
        const bf16x8 b0 = *(const __attribute__((address_space(3))) bf16x8*)(kb + d0 * 2048);
        const bf16x8 b1 = *(const __attribute__((address_space(3))) bf16x8*)(kb + d0 * 2048 + 512);
        p0 = __builtin_amdgcn_mfma_f32_32x32x16_bf16(b0, qr[d0], p0, 0, 0, 0);
        p1 = __builtin_amdgcn_mfma_f32_32x32x16_bf16(b1, qr[d0], p1, 0, 0, 0);
    }
}
template <bool NEAR>
__device__ __forceinline__ void tile_sm_pv(f32x16& o0, f32x16& o1, float& l, f32x16& p0, f32x16& p1, lds_cptr vp, unsigned long long wcur, int hi, const LAS float* tb) {
    const unsigned wl = (unsigned)wcur >> (4 * hi), wh = (unsigned)(wcur >> 32) >> (4 * hi);
    float ls = 0.f;
#define ATT_SM_ELEM(r) do { constexpr int bp = ((r) & 3) + 8 * ((r) >> 2); float a = p0[r], b = p1[r]; \
        if (NEAR) { a += tb[bp]; b += tb[32 + bp]; } \
        a = __builtin_amdgcn_exp2f(a); b = __builtin_amdgcn_exp2f(b); \
        int m0, m1; asm("v_bfe_i32 %0, %1, %2, 1" : "=v"(m0) : "v"(wl), "n"(bp)); asm("v_bfe_i32 %0, %1, %2, 1" : "=v"(m1) : "v"(wh), "n"(bp)); \
        a = __builtin_bit_cast(float, __builtin_bit_cast(unsigned, a) & (unsigned)m0); b = __builtin_bit_cast(float, __builtin_bit_cast(unsigned, b) & (unsigned)m1); \
        p0[r] = a; p1[r] = b; ls += a + b; } while (0)
    ATT_SM_ELEM(0); ATT_SM_ELEM(1); ATT_SM_ELEM(2); ATT_SM_ELEM(3); ATT_SM_ELEM(4); ATT_SM_ELEM(5); ATT_SM_ELEM(6); ATT_SM_ELEM(7);
    ATT_SM_ELEM(8); ATT_SM_ELEM(9); ATT_SM_ELEM(10); ATT_SM_ELEM(11); ATT_SM_ELEM(12); ATT_SM_ELEM(13); ATT_SM_ELEM(14); ATT_SM_ELEM(15);
#undef ATT_SM_ELEM
    l += ls;
    v4u pw[4];
#pragma unroll
    for (int i = 0; i < 4; ++i) { pw[0][i] = cvtpk(p0[2 * i], p0[2 * i + 1]); pw[1][i] = cvtpk(p0[8 + 2 * i], p0[9 + 2 * i]); pw[2][i] = cvtpk(p1[2 * i], p1[2 * i + 1]); pw[3][i] = cvtpk(p1[8 + 2 * i], p1[9 + 2 * i]); }
#pragma unroll
    for (int ks = 0; ks < 4; ++ks) {
        const s16x4 a0 = vtr(vp + ks * 1024), a1 = vtr(vp + ks * 1024 + 512), c0 = vtr(vp + 4096 + ks * 1024), c1 = vtr(vp + 4096 + ks * 1024 + 512);
        const bf16x8 v0 = (bf16x8){a0[0], a0[1], a0[2], a0[3], a1[0], a1[1], a1[2], a1[3]}, v1 = (bf16x8){c0[0], c0[1], c0[2], c0[3], c1[0], c1[1], c1[2], c1[3]};
        const bf16x8 pa = __builtin_bit_cast(bf16x8, pw[ks]);
        o0 = __builtin_amdgcn_mfma_f32_32x32x16_bf16(pa, v0, o0, 0, 0, 0);
        o1 = __builtin_amdgcn_mfma_f32_32x32x16_bf16(pa, v1, o1, 0, 0, 0);
    }
}

__device__ __forceinline__ void attn_unit(LAS unsigned char* lds, int b, int h, int qb, float cfar, float cnear, const bf16* QB, const bf16* KB, const bf16* VB, const unsigned long long* MASK, bf16* OC) {
    const int tid = threadIdx.x, lane = tid & 63, r32 = lane & 31, hi = lane >> 5; const int wid = __builtin_amdgcn_readfirstlane(tid >> 6);
    const size_t rowbase = (size_t)b * SEQ; const int q0 = qb * 256; const int myq = q0 + wid * 32 + r32;
    const bf16* Qw = QB + (rowbase + myq) * 512 + h * 64;
    const bf16* ksrc = KB + (rowbase + lane) * 512 + h * 64 + wid * 8;
    const bf16* vsrc = VB + (rowbase + 16 * (wid & 3) + (lane >> 2)) * 512 + h * 64 + (wid >> 2) * 32 + (lane & 3) * 8;
    const unsigned long long* msrc = MASK + (rowbase + myq) * 64;
    const unsigned lds0 = (unsigned)(uintptr_t)lds;
    const unsigned kdst = lds0 + LDS_K + wid * 1024, vdst = lds0 + LDS_V + wid * 1024;
    const lds_cptr l3 = (lds_cptr)lds;
    const lds_cptr kb0 = l3 + LDS_K + hi * 1024 + r32 * 16;
    const lds_cptr vp0 = l3 + LDS_V + ((lane >> 4) & 1) * 32 + (lane & 3) * 8 + (4 * hi + ((lane & 15) >> 2)) * 64;
    const LAS float* tbl = (const LAS float*)(lds + LDS_TBL) + h * 512;
    LAS float* wsf = (LAS float*)(lds + LDS_WS) + wid * 64;
    const int NT = 4 * (qb + 1);
    const int nfar_ = (q0 + 32 * wid - 154 >= 0) ? ((q0 + 32 * wid - 154) >> 6) + 1 : 0; const int nfar = nfar_ < NT ? nfar_ : NT;
    bf16x8 qr[4];
#pragma unroll
    for (int d0 = 0; d0 < 4; ++d0) qr[d0] = *(const bf16x8*)(Qw + d0 * 16 + hi * 8);
    f32x16 o0, o1;
#pragma unroll
    for (int r = 0; r < 16; ++r) { o0[r] = 0.f; o1[r] = 0.f; }
    float l = 0.f;
    unsigned long long wA, wB;
    const unsigned kd0 = (unsigned)__builtin_amdgcn_readfirstlane(kdst), vd0 = (unsigned)__builtin_amdgcn_readfirstlane(vdst);
#define ATT_WAITBAR(w) asm volatile("s_waitcnt vmcnt(0) lgkmcnt(0)\n\ts_barrier" : "+v"(w) :: "memory")
#define ATT_DMA_K(tt) glds16(ksrc + (size_t)(tt) * 64 * 512, kd0 + ((tt) & 3) * SLOTB)
#define ATT_DMA_V(tt) glds16(vsrc + (size_t)(tt) * 64 * 512, vd0 + ((tt) & 1) * SLOTB)
#define ATT_CINIT(tt) (((tt) < nfar) ? cfar : cnear)
#define ATT_SMPV(tt, P0, P1, w) do { if ((tt) < nfar) tile_sm_pv<false>(o0, o1, l, P0, P1, vp0 + ((tt) & 1) * SLOTB, w, hi, tbl); \
        else tile_sm_pv<true>(o0, o1, l, P0, P1, vp0 + ((tt) & 1) * SLOTB, w, hi, tbl + ((tt) * 64 + 4 * hi - myq + 447)); } while (0)
    f32x16 sA0, sA1, sB0, sB1;
    ATT_DMA_K(0); ATT_DMA_V(0); gload8(wA, msrc); ATT_DMA_K(1);
    ATT_WAITBAR(wA);
    tile_qk(sA0, sA1, qr, kb0, ATT_CINIT(0));
    for (int t = 0; t < NT; t += 2) {
        if (t > 0) ATT_WAITBAR(wA);
        if (t + 2 < NT) ATT_DMA_K(t + 2);
        ATT_DMA_V(t + 1); gload8(wB, msrc + (t + 1));
        tile_qk(sB0, sB1, qr, kb0 + ((t + 1) & 3) * SLOTB, ATT_CINIT(t + 1));
        ATT_SMPV(t, sA0, sA1, wA);
        ATT_WAITBAR(wB);
        if (t + 3 < NT) ATT_DMA_K(t + 3);
        if (t + 2 < NT) { ATT_DMA_V(t + 2); gload8(wA, msrc + (t + 2)); tile_qk(sA0, sA1, qr, kb0 + ((t + 2) & 3) * SLOTB, ATT_CINIT(t + 2)); }
        ATT_SMPV(t + 1, sB0, sB1, wB);
    }
#undef ATT_WAITBAR
#undef ATT_DMA_K
#undef ATT_DMA_V
#undef ATT_CINIT
#undef ATT_SMPV
    { auto rr = __builtin_amdgcn_permlane32_swap(__float_as_uint(l), __float_as_uint(l), false, false); l = __uint_as_float(rr[0]) + __uint_as_float(rr[1]); }
    if (hi == 0) wsf[32 + r32] = l; asm volatile("s_waitcnt lgkmcnt(0)" ::: "memory");
    float rli[16];
#pragma unroll
    for (int r = 0; r < 16; ++r) rli[r] = __builtin_amdgcn_rcpf(wsf[32 + crow(r, hi)]);
    bf16* Ow = OC + (rowbase + q0 + wid * 32) * 1024 + 512 + h * 64;
    { LAS bf16* stg = (LAS bf16*)(lds + LDS_OST) + wid * 2048;
#pragma unroll
      for (int r = 0; r < 16; ++r) { const int orow = crow(r, hi); stg[orow * 64 + r32] = (bf16)f2bf(o0[r] * rli[r]); stg[orow * 64 + 32 + r32] = (bf16)f2bf(o1[r] * rli[r]); }
      asm volatile("s_waitcnt lgkmcnt(0)" ::: "memory");
#pragma unroll
      for (int i = 0; i < 4; ++i) { const int row = i * 8 + (lane >> 3), ch = lane & 7; const v4u v = *(const LAS v4u*)(stg + row * 64 + ch * 8); *(v4u*)(Ow + (size_t)row * 1024 + ch * 8) = v; } }
    asm volatile("s_waitcnt lgkmcnt(0)\n\ts_barrier" ::: "memory");
}
}

__device__ __forceinline__ void dsa_attn_mfma(Frame& F, const Args& A) {
    LAS float* tbl = (LAS float*)(F.lds + att::LDS_TBL);
    volatile LAS int* qw = (volatile LAS int*)(F.lds + att::LDS_Q);
    const bf16* QB = WSP(bf16, WS_QB); const bf16* KB = WSP(bf16, WS_KB); const bf16* VB = WSP(bf16, WS_VB);
    const unsigned long long* MASK = WSP(unsigned long long, WS_MASK); bf16* OC = WSP(bf16, WS_OCAT);
    const float* relb = A.in[IN_RELB];
    float mq = 0.f, mk = 0.f, mb = 0.f;
    { mq = fabsf(A.in[IN_GQ][F.lane]); mk = fabsf(A.in[IN_GK][F.lane]); mb = fmaxf(fmaxf(fabsf(relb[F.lane]), fabsf(relb[64 + F.lane])), fmaxf(fabsf(relb[128 + F.lane]), fabsf(relb[192 + F.lane])));
      mq = wave_max(mq); mk = wave_max(mk); mb = wave_max(mb); }
    const float ref = 8.0f * LOG2E * mq * mk + LOG2E * mb;
    __syncthreads();
    for (int i = F.tid; i < 8 * 512; i += 512) { const int hh = i >> 9, j = i & 511; tbl[i] = (j < 511) ? relb[t5_bucket(j - 447) * 8 + hh] * LOG2E : 0.f; }
    __syncthreads();
    gu32* qctr = F.ctl + CW_ATTQ;
    for (;;) {
        if (F.tid == 0) qw[0] = (int)__hip_atomic_fetch_add(qctr, 1u, RLX_AGENT);
        __syncthreads();
        const int u = qw[0];
        __syncthreads();
        if (u >= 2048) break;
        const int qb = 15 - (u >> 7), bh = u & 127, b = bh >> 3, h = bh & 7;
        const float cnear = -ref, cfar = -ref + relb[15 * 8 + h] * LOG2E;
        att::attn_unit(F.lds, b, h, qb, cfar, cnear, QB, KB, VB, MASK, OC);
    }
    __syncthreads();
}
__device__ __forceinline__ void moe_route_mfma(Frame& F, const Args& A) {
    const bf16* XB = WSP(bf16, WS_H2); const bf16* WRH = WSP(bf16, WS_WR); const bf16* WRL = WRH + 64 * D;
    unsigned* ME = WSP(unsigned, WS_META); float* MC = (float*)(F.ws + WS_META + 512 * 1024); float* MRS = WSP(float, WS_MRS);
    const int lane = F.lane, n32 = lane & 31, hi = lane >> 5;
    LAS float* lg = (LAS float*)F.lds + F.wave * 2048;
    LAS int* lcnt = (LAS int*)(F.lds + XTRA_OFF); LAS int* lbase = lcnt + 128; int* POSC = (int*)(F.ws + WS_META + 256 * 1024);
    if (F.tid < 128) lcnt[F.tid] = 0;
    LAS unsigned char* wl = F.lds + RING_OFF; constexpr int WPITCH = 2048;
    for (int tile = F.vcu * NWAVES + F.wave; tile < M / 32; tile += F.G * NWAVES) {
        __syncthreads();
#pragma unroll 4
        for (int i = 0; i < 16; ++i) { const int p = F.tid + 512 * i, row = p >> 7, c16 = p & 127;
            const v4u v = *(const GAS v4u*)((row < 32 ? WRH + (size_t)row * D : WRL + (size_t)(row - 32) * D) + 8 * c16);
            *(LAS v4u*)(wl + row * WPITCH + 16 * (c16 ^ (row & 7))) = v; }
        __syncthreads();
        const size_t t0 = (size_t)tile * 32;
        const bf16* xp = XB + (t0 + n32) * D + 8 * hi;
        const bf16* bh = WRH + (size_t)n32 * D + 8 * hi; const bf16* bl = WRL + (size_t)n32 * D + 8 * hi;
        f32x16 acc0, acc1;
#pragma unroll
        for (int r = 0; r < 16; ++r) { acc0[r] = 0.f; acc1[r] = 0.f; }
        float ss = 0.f;
        float ra; { const unsigned* sl = WSP(const unsigned, WS_SLOT2) + ((t0 + n32) >> 8) * 1024 + ((t0 + n32) & 255);
            ra = fmaxf(fmaxf(__builtin_bit_cast(float, sl[0]), __builtin_bit_cast(float, sl[256])), fmaxf(__builtin_bit_cast(float, sl[512]), __builtin_bit_cast(float, sl[768]))); }
        const float qinv = ra > 0.f ? 127.0f / ra : 0.f;
        if (hi == 0) WSP(float, WS_XS8)[t0 + n32] = ra * (1.0f / 127.0f);
        unsigned char* x8 = F.ws + WS_XB8 + (t0 + n32) * D + 16 * hi; v4u q8;
        v4u xs[4]; bf16x8 wq[4][4];
#define RT_LOAD(sl, s) do { xs[sl] = *(const v4u*)(xp + 16 * (s)); \
                            wq[sl][1] = (bf16x8){0, 0, 0, 0, 0, 0, 0, 0}; wq[sl][3] = (bf16x8){0, 0, 0, 0, 0, 0, 0, 0}; \
                            if (n32 < 4) { wq[sl][1] = *(const bf16x8*)(bh + 32 * D + 16 * (s)); wq[sl][3] = *(const bf16x8*)(bl + 32 * D + 16 * (s)); } } while (0)
        RT_LOAD(0, 0); RT_LOAD(1, 1); RT_LOAD(2, 2);
        for (int s4 = 0; s4 < 64; s4 += 4) {
#pragma unroll
            for (int u4 = 0; u4 < 4; ++u4) { const int s = s4 + u4;
                if (s + 3 < 64) RT_LOAD((u4 + 3) & 3, s + 3);
                asm volatile("" ::: "memory");
                const v4u xw = xs[u4];
                {
                    unsigned b0 = 0u, b1 = 0u;
                    b0 = __builtin_amdgcn_cvt_pk_u8_f32(__builtin_rintf(__builtin_fmaf(bflo(xw[0]), qinv, 128.0f)), 0, b0); b0 = __builtin_amdgcn_cvt_pk_u8_f32(__builtin_rintf(__builtin_fmaf(bfhi(xw[0]), qinv, 128.0f)), 1, b0);
                    b0 = __builtin_amdgcn_cvt_pk_u8_f32(__builtin_rintf(__builtin_fmaf(bflo(xw[1]), qinv, 128.0f)), 2, b0); b0 = __builtin_amdgcn_cvt_pk_u8_f32(__builtin_rintf(__builtin_fmaf(bfhi(xw[1]), qinv, 128.0f)), 3, b0);
                    b1 = __builtin_amdgcn_cvt_pk_u8_f32(__builtin_rintf(__builtin_fmaf(bflo(xw[2]), qinv, 128.0f)), 0, b1); b1 = __builtin_amdgcn_cvt_pk_u8_f32(__builtin_rintf(__builtin_fmaf(bfhi(xw[2]), qinv, 128.0f)), 1, b1);
                    b1 = __builtin_amdgcn_cvt_pk_u8_f32(__builtin_rintf(__builtin_fmaf(bflo(xw[3]), qinv, 128.0f)), 2, b1); b1 = __builtin_amdgcn_cvt_pk_u8_f32(__builtin_rintf(__builtin_fmaf(bfhi(xw[3]), qinv, 128.0f)), 3, b1);
                    if ((u4 & 1) == 0) { q8.x = b0 ^ 0x80808080u; q8.y = b1 ^ 0x80808080u; } else { q8.z = b0 ^ 0x80808080u; q8.w = b1 ^ 0x80808080u; *(v4u*)(x8 + 32 * (s >> 1)) = q8; } }
#pragma unroll
                for (int j = 0; j < 4; ++j) { const float a = bflo(xw[j]), b = bfhi(xw[j]); ss += a * a + b * b; }
                const bf16x8 Ah = __builtin_bit_cast(bf16x8, xw);
                const bf16x8 w0h = *(const LAS bf16x8*)(wl + n32 * WPITCH + 16 * ((2 * s + hi) ^ (n32 & 7))), w0l = *(const LAS bf16x8*)(wl + (32 + n32) * WPITCH + 16 * ((2 * s + hi) ^ (n32 & 7)));
                acc0 = __builtin_amdgcn_mfma_f32_32x32x16_bf16(Ah, w0h, acc0, 0, 0, 0); acc1 = __builtin_amdgcn_mfma_f32_32x32x16_bf16(Ah, wq[u4][1], acc1, 0, 0, 0);
                acc0 = __builtin_amdgcn_mfma_f32_32x32x16_bf16(Ah, w0l, acc0, 0, 0, 0); acc1 = __builtin_amdgcn_mfma_f32_32x32x16_bf16(Ah, wq[u4][3], acc1, 0, 0, 0);
            }
        }
#undef RT_LOAD
        ss += __shfl_xor(ss, 32);
        const float rs = 1.0f / sqrtf(ss * (1.f / D) + EPS);
        __syncthreads();
#pragma unroll
        for (int r = 0; r < 16; ++r) { const int tk = (r & 3) + 8 * (r >> 2) + 4 * hi; lg[tk * 64 + n32] = acc0[r]; lg[tk * 64 + 32 + n32] = acc1[r]; }
        LDS_WAIT(); asm volatile("" ::: "memory");
        if (hi == 0) {
            const size_t r = t0 + n32; const LAS float* my = lg + n32 * 64;
            float gl[4];
#pragma unroll
            for (int c = 0; c < 4; ++c) gl[c] = my[c] * rs + A.in[IN_BRG][c];
            int gs = 0; float gm = gl[0];
#pragma unroll
            for (int c = 1; c < 4; ++c) if (gl[c] > gm) { gm = gl[c]; gs = c; }
            float den = 0.f;
#pragma unroll
            for (int c = 0; c < 4; ++c) den += __expf(gl[c] - gm);
            const float gw = 1.0f / den;
            float el[8];
#pragma unroll
            for (int c = 0; c < 8; ++c) el[c] = my[4 + gs * 8 + c] * rs + A.in[IN_BRE][gs * 8 + c];
            int i0 = 0; float v0 = el[0];
#pragma unroll
            for (int c = 1; c < 8; ++c) if (el[c] > v0) { v0 = el[c]; i0 = c; }
            int i1 = -1; float v1 = -INFINITY;
#pragma unroll
            for (int c = 0; c < 8; ++c) if (c != i0 && el[c] > v1) { v1 = el[c]; i1 = c; }
            const float p1 = 1.0f / (1.0f + __expf(v0 - v1)), p0 = 1.0f - p1;
            const float c0 = p0 * gw, c1 = p1 * gw;
            const int a = i0 < i1 ? i0 : i1, bq = i0 < i1 ? i1 : i0; const float ca = i0 < i1 ? c0 : c1, cb = i0 < i1 ? c1 : c0;
            const int cls = gs * 28 + (a * (15 - a)) / 2 + (bq - a - 1);
            ME[r] = (unsigned)(gs * 8 + a) | ((unsigned)(gs * 8 + bq) << 8) | ((unsigned)cls << 16); MC[r * 2] = ca; MC[r * 2 + 1] = cb; MRS[r] = rs;
            POSC[r] = __hip_atomic_fetch_add(lcnt + cls, 1, __ATOMIC_RELAXED, __HIP_MEMORY_SCOPE_WORKGROUP);
        }
        LDS_WAIT(); asm volatile("" ::: "memory");
    }
    __syncthreads();
    if (F.tid < NCLASS) { const int n = lcnt[F.tid]; lbase[F.tid] = n ? (int)__hip_atomic_fetch_add(F.ctl + CW_CLS + F.tid, (unsigned)n, RLX_AGENT) : 0; }
    __syncthreads();
    for (int tile = F.vcu * NWAVES + F.wave; tile < M / 32; tile += F.G * NWAVES) {
        if (hi == 0) { const size_t r = (size_t)tile * 32 + n32; POSC[r] += lbase[ME[r] >> 16]; } }
    __syncthreads();
}
constexpr size_t WS_TILEE = WS_TOK + 512 * 1024, WS_NT = WS_TOK + 768 * 1024;
__device__ __forceinline__ void moe_assign(Frame& F, const Args& A) {
    LAS int* off_s = (LAS int*)F.lds; LAS int* cnt_s = off_s + 128;
    gu32* cnt = F.ctl + CW_CLS;
    int* TOK = WSP(int, WS_TOK); unsigned* TILEE = WSP(unsigned, WS_TILEE); int* NT = WSP(int, WS_NT); const unsigned* ME = WSP(unsigned, WS_META);
    __syncthreads();
    if (F.tid < NCLASS) cnt_s[F.tid] = (int)__hip_atomic_load(cnt + F.tid, RLX_AGENT);
    __syncthreads();
    if (F.tid == 0) { int o = 0; for (int c = 0; c < NCLASS; ++c) { off_s[c] = o; o += (cnt_s[c] + 255) & ~255; } off_s[NCLASS] = o; }
    __syncthreads();
    for (int r = F.vcu * 512 + F.tid; r < M; r += F.G * 512) { const int cls = (int)(ME[r] >> 16); const int pos = off_s[cls] + WSP(const int, WS_META + 256 * 1024)[r]; TOK[pos] = r; }
    for (int c = F.vcu; c < NCLASS; c += F.G) {
        const int lo = off_s[c] + cnt_s[c], hi = off_s[c + 1];
        for (int p = lo + F.tid; p < hi; p += 512) TOK[p] = -1;
        const int g = c / 28; int pi = c % 28, a = 0; while (pi >= 7 - a) { pi -= 7 - a; ++a; } const int b = a + 1 + pi;
        const unsigned ee = (unsigned)(g * 8 + a) | ((unsigned)(g * 8 + b) << 8);
        for (int t = off_s[c] / 256 + F.tid; t < off_s[c + 1] / 256; t += 512) TILEE[t] = ee;
    }
    if (F.vcu == 0 && F.tid == 0) NT[0] = off_s[NCLASS] / 256;
    __syncthreads();
}
namespace pg8 {
struct MoeUpOrder {
    static constexpr bool GATHER = true, SPLITB = false;
    int nT, G, c; const int* TOK; const unsigned* TILEE; const bf16_t* WGU;
    __device__ bool next(int i, Unit& u) const { const long L = (long)i * G + c; if (L >= 2L * nT) return false; tile_of((int)L, nT, 2, u.pm, u.pn); u.sel = (int)TILEE[u.pm]; return true; }
    __device__ __forceinline__ const char* baseA(const Gemm& g, const Unit&) const { return (const char*)g.A; }
    __device__ __forceinline__ const char* baseB(const Gemm& g, const Unit& u) const { const int e = (u.pn ? (u.sel >> 8) : u.sel) & 255; return (const char*)WGU + (size_t)e * 256 * g.ldb * 2; }
    __device__ __forceinline__ int row(const Unit& u, int r) const { const int t = TOK[u.pm * BM + r]; return t < 0 ? 0 : t; }
};
struct EpiMoeUp {
    static constexpr bool PERM = true, CARRY = false;
    const int* TOK; const float* MC; const float* MRS; bf16_t* HID; const float* XS; const float* CSU;
    __device__ __forceinline__ int operator()(const f32x4 (&acc)[2][2][4][2], const Unit& u, int wr, int wc, int fr, int fq) const {
        { int l; asm volatile("v_mbcnt_lo_u32_b32 %0, -1, 0\n\tv_mbcnt_hi_u32_b32 %0, -1, %0" : "=v"(l)); fr = l & 15; fq = l >> 4; }
        const int pos0 = u.pm * BM + wr * 64 + fr; const int e = (u.pn ? (u.sel >> 8) : u.sel) & 255;
        f32x4 csc[2][2];
#pragma unroll
        for (int bj = 0; bj < 2; ++bj)
#pragma unroll
            for (int n = 0; n < 2; ++n) csc[bj][n] = *(const f32x4*)(CSU + e * 256 + bj * HALF + wc * 32 + 8 * fq + 4 * n);
#pragma unroll
        for (int ai = 0; ai < 2; ++ai)
#pragma unroll
            for (int m = 0; m < 4; ++m) { const int pos = pos0 + ai * HALF + m * 16; const int tok = TOK[pos]; const float cw = tok >= 0 ? MC[(size_t)tok * 2 + u.pn] : 0.f; const float rs = tok >= 0 ? MRS[tok] * XS[tok] : 0.f;
                const f32x4 g0 = __builtin_convertvector(__builtin_bit_cast(i32x4, acc[ai][0][m][0]), f32x4) * csc[0][0], g1 = __builtin_convertvector(__builtin_bit_cast(i32x4, acc[ai][0][m][1]), f32x4) * csc[0][1];
                const f32x4 u0 = __builtin_convertvector(__builtin_bit_cast(i32x4, acc[ai][1][m][0]), f32x4) * csc[1][0], u1 = __builtin_convertvector(__builtin_bit_cast(i32x4, acc[ai][1][m][1]), f32x4) * csc[1][1]; float h[8];
#pragma unroll
                for (int j = 0; j < 4; ++j) { h[j] = cw * siluf_(rs * g0[j]) * (rs * u0[j]); h[4 + j] = cw * siluf_(rs * g1[j]) * (rs * u1[j]); }
                u32x4 w; w.x = cvt_pk_bf16(h[0], h[1]); w.y = cvt_pk_bf16(h[2], h[3]); w.z = cvt_pk_bf16(h[4], h[5]); w.w = cvt_pk_bf16(h[6], h[7]);
                *(u32x4*)(HID + (size_t)pos * 256 + u.pn * 128 + wc * 32 + 8 * fq) = w; }
        return 8;
    }
};
struct MoeDownOrder {
    static constexpr bool GATHER = false, SPLITB = true;
    int nT, G, c; const unsigned* TILEE; const bf16_t* WD;
    __device__ bool next(int i, Unit& u) const { const long L = (long)i * G + c; if (L >= 4L * nT) return false; tile_of((int)L, nT, 4, u.pm, u.pn); u.sel = (int)TILEE[u.pm]; return true; }
    __device__ __forceinline__ const char* baseA(const Gemm& g, const Unit& u) const { return (const char*)g.A + (size_t)u.pm * BM * g.lda * 2; }
    __device__ __forceinline__ const char* baseB(const Gemm&, const Unit& u) const { return (const char*)WD + ((size_t)(u.sel & 255) * 1024 + (size_t)u.pn * BM) * 128 * 2; }
    __device__ __forceinline__ const char* baseB2(const Gemm&, const Unit& u) const { return (const char*)WD + ((size_t)((u.sel >> 8) & 255) * 1024 + (size_t)u.pn * BM) * 128 * 2; }
};
struct EpiMoeDown {
    static constexpr bool PERM = true, CARRY = false;
    const int* TOK; const bf16_t* XB; float* O; float* DUMP;
    __device__ __forceinline__ int operator()(const f32x4 (&acc)[2][2][4][2], const Unit& u, int wr, int wc, int fr, int fq) const {
        { int l; asm volatile("v_mbcnt_lo_u32_b32 %0, -1, 0\n\tv_mbcnt_hi_u32_b32 %0, -1, %0" : "=v"(l)); fr = l & 15; fq = l >> 4; }
        const int* tp = TOK + u.pm * BM + wr * 64 + fr; const int col0 = u.pn * BM + wc * 32 + 8 * fq;
        int tk[8];
#pragma unroll
        for (int it = 0; it < 8; ++it) tk[it] = tp[(it >> 2) * HALF + (it & 3) * 16];
        u32x4 xw[2][2];
#pragma unroll
        for (int bj = 0; bj < 2; ++bj) xw[0][bj] = *(const u32x4*)(XB + (size_t)(tk[0] >= 0 ? tk[0] : 0) * 1024 + col0 + bj * HALF);
#pragma unroll
        for (int it = 0; it < 8; ++it) { const int ai = it >> 2, m = it & 3, sl = it & 1; const int tok = tk[it];
            if (it + 1 < 8) {
#pragma unroll
                for (int bj = 0; bj < 2; ++bj) xw[sl ^ 1][bj] = *(const u32x4*)(XB + (size_t)(tk[it + 1] >= 0 ? tk[it + 1] : 0) * 1024 + col0 + bj * HALF); }
            asm volatile("" ::: "memory");
            float* rowp = (tok >= 0 ? O + (size_t)tok * 1024 : DUMP) + col0;
#pragma unroll
            for (int bj = 0; bj < 2; ++bj) { const u32x4 x = xw[sl][bj]; f32x4 y0 = acc[ai][bj][m][0], y1 = acc[ai][bj][m][1];
                y0[0] += bflo(x.x); y0[1] += bfhi(x.x); y0[2] += bflo(x.y); y0[3] += bfhi(x.y);
                y1[0] += bflo(x.z); y1[1] += bfhi(x.z); y1[2] += bflo(x.w); y1[3] += bfhi(x.w);
                *(f32x4*)(rowp + bj * HALF) = y0; *(f32x4*)(rowp + bj * HALF + 4) = y1; }
            asm volatile("" ::: "memory"); }
        return 32;
    }
};
}
#ifndef MK_SPLIT
#define MK_SPLIT 0
#endif
constexpr int NPHASE = 12;
__global__ void __launch_bounds__(NWAVES * 64, 2) fwd(Args args) {
    extern __shared__ __attribute__((aligned(16))) unsigned char lds[];
    Frame F;
    F.lds = (LAS unsigned char*)lds;
    F.MISC = (volatile LAS unsigned*)(F.lds + MISC_OFF);
    F.tid = threadIdx.x; F.lane = F.tid & 63; F.wave = __builtin_amdgcn_readfirstlane(F.tid >> 6);
    F.G = gridDim.x; { const int bx = blockIdx.x; F.vcu = (F.G % 8 == 0) ? (bx % 8) * (F.G / 8) + bx / 8 : bx; }
    F.ws = args.ws; F.out = args.out; F.ctl = (gu32*)(args.ws + WS_CTL);
    for (int u = F.tid; u < 256; u += NWAVES * 64) ((LAS unsigned*)(F.lds + LDSCTL_OFF))[u] = 0u;
    __syncthreads();
    const int lo = args.ph_lo, hi = args.ph_hi;
    XcdBarrier bar; bar.bar = (unsigned*)(F.ctl + CW_BAR); bar.x = 0; bar.st = nullptr;
    if (hi - lo > 1) { bar = xcd_barrier_post((unsigned*)(F.ctl + CW_BAR), F.MISC + 8);
        if (F.tid == 0) { const unsigned x = xb_xcc_id(); F.MISC[16] = x; F.MISC[17] = __hip_atomic_fetch_add(F.ctl + CW_XRANK + 64 * x, 1u, RLX_AGENT); } }
    int vid = (int)blockIdx.x;
#ifndef ONLY
#define ONLY -1
#endif
#define IN(k) ((ONLY < 0 || ONLY == (k)) && lo <= (k) && (k) < hi)
#define BOTH(k) (IN(k) && IN((k) + 1))
#ifndef PROBE_FLAG
#define PROBE_FLAG 1
#endif
#ifndef REP_PHASE
#define REP_PHASE -1
#endif
#define NREP(k) 1
#define GRID_BAR() xcd_barrier(bar)

    if (IN(0)) _Pragma("unroll") for (int rep_ = 0; rep_ < NREP(0); ++rep_) { p0_prologue(F, args); if (BOTH(0)) GRID_BAR(); }
    if (IN(1)) { p0_quant(F, args); if (BOTH(1)) GRID_BAR(); }
    if (hi - lo > 1 && lo == 0) {
        bool ok = (F.G % 8) == 0;
#pragma unroll
        for (int j = 0; j < 8; ++j) ok = ok && (__hip_atomic_load(F.ctl + CW_XRANK + 64 * j, RLX_AGENT) == (unsigned)(F.G / 8));
        __syncthreads();
        if (ok) vid = (int)__builtin_amdgcn_readfirstlane((int)(F.MISC[17] * 8u + F.MISC[16]));
    }
    if (IN(2)) _Pragma("unroll") for (int rep_ = 0; rep_ < NREP(2); ++rep_) {
        if (G1_NBF > 0) { pg8::Gemm g{WSP(bf16, WS_HN), WSP(bf16, WS_WIN), D, D, D}; pg8::G1Order S{F.G, vid, 0, 0, G1_NBF};
          pg8::EpiG1<false> E{F.ws, args.in[IN_GQ], args.in[IN_GK], nullptr, nullptr};
          pg8::gemm_phase<pg8::EpiG1<false>, pg8::G1Order>(F.lds + RING_OFF, g, S, E); }
        { pg8::Gemm g{WSP(bf16, WS_HN8), WSP(bf16, WS_WIN8), D / 2, D / 2, D / 2}; pg8::G1Order S{F.G, vid, 0, 1, 22 - G1_NBF};
          pg8::EpiG1<true> E{F.ws, args.in[IN_GQ], args.in[IN_GK], WSP(const float, WS_RS8), WSP(const float, WS_CS8)};
          pg8::gemm_phase<pg8::EpiG1<true>, pg8::G1Order, true>(F.lds + RING_OFF, g, S, E); }
        if (BOTH(2)) GRID_BAR();
    }
    if (IN(3)) _Pragma("unroll") for (int rep_ = 0; rep_ < NREP(3); ++rep_) { gla_prep(F, args); }
    if (IN(4)) _Pragma("unroll") for (int rep_ = 0; rep_ < NREP(4); ++rep_) { dsa_select_mfma(F, args); if (BOTH(4)) GRID_BAR(); }
    if (IN(5)) _Pragma("unroll") for (int rep_ = 0; rep_ < NREP(5); ++rep_) { gla_scan_mfma(F, args); dsa_attn_mfma(F, args); if (BOTH(5)) GRID_BAR(); }
    if (IN(6)) _Pragma("unroll") for (int rep_ = 0; rep_ < NREP(6); ++rep_) {
        pg8::Gemm g{WSP(bf16, WS_OCAT), nullptr, 1024, 512, 512};
        pg8::PairOrder S; S.nM = M / 256; S.nN = D / 256; S.nwg = S.nM * S.nN; S.G = F.G; S.c = vid; S.Wa = WSP(bf16, WS_WA); S.Wb = WSP(bf16, WS_WB);
        pg8::EpiMix E{WSP(bf16, WS_GA), WSP(bf16, WS_GB), F.ws + WS_MIX8, pg8::PanelX{(LAS float*)(F.lds + XTRA_OFF), WSP(unsigned, WS_SLOT1), F.ctl + CW_PCNT, WSP(float, WS_MS8)}};
        pg8::gemm_phase<pg8::EpiMix, pg8::PairOrder>(F.lds + RING_OFF, g, S, E);
        if (BOTH(6)) GRID_BAR();
    }
    if (IN(7)) _Pragma("unroll") for (int rep_ = 0; rep_ < NREP(7); ++rep_) {
        pg8::Gemm g{WSP(bf16, WS_MIX8), WSP(bf16, WS_WO8), D / 2, D / 2, D / 2}; pg8::StaticOrder S; S.init(M, D, F.G, vid);
        pg8::EpiRes E{args.in[IN_X], WSP(bf16, WS_H2), WSP(const float, WS_MS8), WSP(const float, WS_CSO), (LAS float*)(F.lds + XTRA_OFF), WSP(unsigned, WS_SLOT2)};
        pg8::gemm_phase<pg8::EpiRes, pg8::StaticOrder, true>(F.lds + RING_OFF, g, S, E);
        if (BOTH(7)) GRID_BAR();
    }
    if (IN(8)) _Pragma("unroll") for (int rep_ = 0; rep_ < NREP(8); ++rep_) { moe_route_mfma(F, args); if (BOTH(8)) GRID_BAR(); }
    if (IN(9)) _Pragma("unroll") for (int rep_ = 0; rep_ < NREP(9); ++rep_) { moe_assign(F, args); if (BOTH(9)) GRID_BAR(); }
    if (IN(10)) _Pragma("unroll") for (int rep_ = 0; rep_ < NREP(10); ++rep_) {
        const int nT = __builtin_amdgcn_readfirstlane(*WSP(const int, WS_NT));
        pg8::Gemm g{WSP(bf16, WS_XB8), nullptr, D / 2, D / 2, D / 2};
        pg8::MoeUpOrder S{nT, F.G, vid, WSP(const int, WS_TOK), WSP(const unsigned, WS_TILEE), WSP(bf16, WS_WGU8)};
        pg8::EpiMoeUp E{WSP(const int, WS_TOK), (const float*)(F.ws + WS_META + 512 * 1024), WSP(const float, WS_MRS), WSP(bf16, WS_HID), WSP(const float, WS_XS8), WSP(const float, WS_CSU)};
        pg8::gemm_phase<pg8::EpiMoeUp, pg8::MoeUpOrder, true>(F.lds + RING_OFF, g, S, E);
        if (BOTH(10)) GRID_BAR();
    }
    if (IN(11)) _Pragma("unroll") for (int rep_ = 0; rep_ < NREP(11); ++rep_) {
        const int nT = __builtin_amdgcn_readfirstlane(*WSP(const int, WS_NT));
        pg8::Gemm g{WSP(bf16, WS_HID), nullptr, 256, 128, 256};
        pg8::MoeDownOrder S{nT, F.G, vid, WSP(const unsigned, WS_TILEE), WSP(bf16, WS_WD)};
        pg8::EpiMoeDown E{WSP(const int, WS_TOK), WSP(bf16, WS_H2), F.out, WSP(float, WS_NT + 4096)};
        pg8::gemm_phase<pg8::EpiMoeDown, pg8::MoeDownOrder>(F.lds + RING_OFF, g, S, E);
    }
#undef IN
#undef BOTH
#undef GRID_BAR
}

extern "C" void kernel_launch(void* const* d_in, const int* in_sizes, int n_in, void* d_out, int out_size, void* d_ws, size_t ws_size, hipStream_t stream) {
    static int grid = 0;
    if (grid == 0) {
        if (n_in != 20 || in_sizes[0] != M * D || out_size != M * D || ws_size < WS_END) { fprintf(stderr, "kernel_launch: unexpected shapes (n_in %d, in0 %d, out %d, ws %zu); nothing launched\n", n_in, n_in > 0 ? in_sizes[0] : -1, out_size, ws_size); grid = -1; return; }
        int dev = 0, cus = 0, per_cu = 0;
        if (hipGetDevice(&dev) != hipSuccess || hipDeviceGetAttribute(&cus, hipDeviceAttributeMultiprocessorCount, dev) != hipSuccess) { grid = -1; return; }
        if (hipFuncSetAttribute((const void*)fwd, hipFuncAttributeMaxDynamicSharedMemorySize, LDS_BYTES) != hipSuccess) { fprintf(stderr, "kernel_launch: hipFuncSetAttribute failed\n"); grid = -1; return; }
        if (hipOccupancyMaxActiveBlocksPerMultiprocessor(&per_cu, (const void*)fwd, NWAVES * 64, LDS_BYTES) != hipSuccess || per_cu < 1) fprintf(stderr, "kernel_launch: occupancy query says %d\n", per_cu);
        (void)hipGetLastError();
        grid = cus;
        if (grid > 256) grid = 256;
        if (grid != 256 || per_cu < 1) { fprintf(stderr, "kernel_launch: needs 256 resident workgroups (the merge epilogue's panel exchange); nothing launched\n"); grid = -1; return; }
    }
    if (grid < 0) return;
    if (hipMemsetAsync((char*)d_ws + WS_CTL, 0, CTL_ZERO_BYTES, stream) != hipSuccess) return;
    Args a{};
    for (int i = 0; i < 20; ++i) a.in[i] = (const float*)d_in[i];
    a.out = (float*)d_out; a.ws = (unsigned char*)d_ws;
#if MK_SPLIT
    for (int p = 0; p < NPHASE; ++p) for (int rep = 0; rep < ((p == REP_PHASE) ? 2 : 1); ++rep) { a.ph_lo = p; a.ph_hi = p + 1; a.flag = rep ? PROBE_FLAG : 0; hipLaunchKernelGGL(fwd, dim3(grid), dim3(NWAVES * 64), LDS_BYTES, stream, a); }
#else
    a.ph_lo = 0; a.ph_hi = NPHASE; hipLaunchKernelGGL(fwd, dim3(grid), dim3(NWAVES * 64), LDS_BYTES, stream, a);
#endif
}
```

```cpp
#include <hip/hip_runtime.h>
#include <cstdio>
#include <cstdint>
#include <cmath>
#define MK_SPLIT 0
namespace pg8 {
#define PG8_LAS __attribute__((address_space(3)))
typedef unsigned short bf16_t;
typedef short bf16x8 __attribute__((ext_vector_type(8)));
typedef float f32x4 __attribute__((ext_vector_type(4)));
typedef unsigned u32x4 __attribute__((ext_vector_type(4)));
typedef int i32x4 __attribute__((ext_vector_type(4)));
constexpr int BM = 256, BK = 64, HALF = 128, HTB = HALF * BK * 2  , STAGE_BYTES = 8 * HTB, NXCD = 8, WGM = 8;

__host__ __device__ __forceinline__ int lds_byte(int r, int c) { const int st = (r >> 4) * 2 + (c >> 5), rr = r & 15, cc = c & 31, ob = rr * 64 + cc * 2; return st * 1024 + (ob ^ (((ob >> 9) & 1) << 5)); }
__host__ __device__ __forceinline__ void stage_rc(int b, int& R, int& C) { const int st = b / 1024, sb = b % 1024, swz = sb ^ (((sb >> 9) & 1) << 5); R = (st >> 1) * 16 + swz / 64; C = (st & 1) * 32 + (swz % 64) / 2; }
__host__ __device__ __forceinline__ int perm32(int rho) { const int n = rho >> 4, i = rho & 15; return 8 * (i >> 2) + 4 * n + (i & 3); }

struct Unit { int pm, pn, sel; };
struct Gemm { const bf16_t* A; const bf16_t* Bt; int lda, ldb, K; int nomma = 0; };

__host__ __device__ __forceinline__ void tile_of(int wgid, int nM, int nN, int& pm, int& pn) {
    const int nwg = nM * nN;
    { const int q = nwg / NXCD, r = nwg % NXCD, xcd = wgid % NXCD, off = wgid / NXCD; wgid = (xcd < r ? xcd * (q + 1) : r * (q + 1) + (xcd - r) * q) + off; }
    const int nig = WGM * nN, gid = wgid / nig, fm = gid * WGM, gsz = (nM - fm) < WGM ? (nM - fm) : WGM;
    pm = fm + ((wgid % nig) % gsz); pn = (wgid % nig) / gsz;
}
struct StaticOrder {
    static constexpr bool GATHER = false, SPLITB = false;
    int nM, nN, nwg, G, c;
    __host__ __device__ void init(int M, int N, int G_, int c_) { nM = M / BM; nN = N / BM; nwg = nM * nN; G = G_; c = c_; }
    __host__ __device__ bool next(int i, Unit& u) const {
        const long L = (long)i * G + c; if (L >= nwg) return false;
        tile_of((int)L, nM, nN, u.pm, u.pn); u.sel = 0; return true;
    }
    __device__ __forceinline__ const char* baseA(const Gemm& g, const Unit& u) const { return (const char*)g.A + (size_t)u.pm * BM * g.lda * 2; }
    __device__ __forceinline__ const char* baseB(const Gemm& g, const Unit& u) const { return (const char*)g.Bt + (size_t)u.pn * BM * g.ldb * 2; }
};

typedef float f32x2_t __attribute__((ext_vector_type(2))); typedef __bf16 bf16x2_t __attribute__((ext_vector_type(2)));
__device__ __forceinline__ unsigned cvt_pk_bf16(float lo, float hi) { const f32x2_t v = {lo, hi}; const bf16x2_t b = __builtin_convertvector(v, bf16x2_t); return __builtin_bit_cast(unsigned, b); }

template <class Epi, class Sched, bool I8 = false>
__device__ __forceinline__ void gemm_phase(PG8_LAS unsigned char* lds, const Gemm g, const Sched& S, const Epi& E) {
    const int tid = threadIdx.x, wid = __builtin_amdgcn_readfirstlane(tid >> 6), lane = tid & 63, wr = wid >> 2, wc = wid & 3, fr = lane & 15, fq = lane >> 4;
    const int K = g.K, nt = K / BK;
    unsigned voffA[2][2], voffN[2][2], voffB[2]; int RA_[2], CA_[2];
#pragma unroll
    for (int i = 0; i < 2; ++i) { int R, C; stage_rc(tid * 16 + i * 8192, R, C); const int Rb = Epi::PERM ? ((R & ~31) + perm32(R & 31)) : R; RA_[i] = R; CA_[i] = C;
        voffB[i] = (unsigned)(Rb * g.ldb + C) * 2u;
#pragma unroll
        for (int h = 0; h < 2; ++h) { voffA[h][i] = (unsigned)((R + h * HALF) * g.lda + C) * 2u; voffN[h][i] = voffA[h][i]; } }
    const size_t kstep = (size_t)(BK * 2);
    const size_t hstepB = (size_t)HALF * g.ldb * 2;
    const unsigned ldsw = (unsigned)wid * 1024u;
    const int aoff = lds_byte(wr * 64 + fr, fq * 8), boff = lds_byte(wc * 32 + fr, fq * 8);
#define PG8_SA(b, h) (((b) * 2 + (h)) * HTB)
#define PG8_SB(b, h) ((4 + (b) * 2 + (h)) * HTB)
#define PG8_STAGE(bufoff, gbase, voff) do { _Pragma("unroll") for (int _i = 0; _i < 2; ++_i) \
        __builtin_amdgcn_global_load_lds((const unsigned*)((const char*)(gbase) + (voff)[_i]), (PG8_LAS unsigned*)(lds + (bufoff) + ldsw + _i * 8192), 16, 0, 0); } while (0)
#define PG8_LDA(dst, b, h) do { _Pragma("unroll") for (int m = 0; m < 4; ++m) _Pragma("unroll") for (int k = 0; k < 2; ++k) dst[m][k] = *(const PG8_LAS bf16x8*)(lds + PG8_SA(b, h) + aoff + m * 2048 + k * 1024); } while (0)
#define PG8_LDB(dst, b, h) do { _Pragma("unroll") for (int n = 0; n < 2; ++n) _Pragma("unroll") for (int k = 0; k < 2; ++k) dst[n][k] = *(const PG8_LAS bf16x8*)(lds + PG8_SB(b, h) + boff + n * 2048 + k * 1024); } while (0)
#ifdef PROBE_NOMMA
#define PG8_MMA_GUARD if (!g.nomma)
#else
#define PG8_MMA_GUARD
#endif
#define PG8_MMA(ai, bj, At, Bt) PG8_MMA_GUARD do { __builtin_amdgcn_s_setprio(1); _Pragma("unroll") for (int m = 0; m < 4; ++m) _Pragma("unroll") for (int n = 0; n < 2; ++n) _Pragma("unroll") for (int k = 0; k < 2; ++k) { \
        if constexpr (I8) acc[ai][bj][m][n] = __builtin_bit_cast(f32x4, __builtin_amdgcn_mfma_i32_16x16x64_i8(__builtin_bit_cast(i32x4, Bt[n][k]), __builtin_bit_cast(i32x4, At[m][k]), __builtin_bit_cast(i32x4, acc[ai][bj][m][n]), 0, 0, 0)); \
        else acc[ai][bj][m][n] = __builtin_amdgcn_mfma_f32_16x16x32_bf16(Bt[n][k], At[m][k], acc[ai][bj][m][n], 0, 0, 0); } __builtin_amdgcn_s_setprio(0); } while (0)
#define PG8_WAIT_V(n) asm volatile("s_waitcnt vmcnt(" #n ")" ::: "memory")
#define PG8_WAIT_L(n) asm volatile("s_waitcnt lgkmcnt(" #n ")" ::: "memory")
#define PG8_WAIT_VE() PG8_WAIT_V(8)
#define PG8_BAR __builtin_amdgcn_s_barrier()
#define PG8_SCHED __builtin_amdgcn_sched_barrier(0)
#define PG8_GATHER(dst, u) do { if constexpr (Sched::GATHER) { _Pragma("unroll") for (int _h = 0; _h < 2; ++_h) _Pragma("unroll") for (int _i = 0; _i < 2; ++_i) \
        dst[_h][_i] = (unsigned)S.row(u, _h * HALF + RA_[_i]) * (unsigned)(g.lda * 2) + (unsigned)(CA_[_i] * 2); } } while (0)
    Unit cur, nxt, nn; int ui = 0, en = 0;
    if (!S.next(0, cur)) return;
    bool has_next = S.next(1, nxt);
    f32x4 acc[2][2][4][2];
#pragma unroll
    for (int a = 0; a < 2; ++a)
#pragma unroll
        for (int b = 0; b < 2; ++b)
#pragma unroll
            for (int m = 0; m < 4; ++m)
#pragma unroll
                for (int n = 0; n < 2; ++n) acc[a][b][m][n] = (f32x4){0.f, 0.f, 0.f, 0.f};
    bf16x8 At[4][2], B0[2][2], B1[2][2];
    const char* cA = S.baseA(g, cur); const char* cB = S.baseB(g, cur);
    PG8_GATHER(voffA, cur);
    if constexpr (Sched::GATHER) { if (has_next) { PG8_GATHER(voffN, nxt); } else {
#pragma unroll
        for (int h = 0; h < 2; ++h)
#pragma unroll
            for (int i = 0; i < 2; ++i) voffN[h][i] = voffA[h][i]; } }
    PG8_STAGE(PG8_SB(0, 0), cB, voffB); PG8_STAGE(PG8_SB(0, 1), cB + hstepB, voffB); PG8_STAGE(PG8_SA(0, 0), cA, voffA[0]); PG8_STAGE(PG8_SA(0, 1), cA, voffA[1]);
    if (wr == 1) PG8_BAR;
    PG8_WAIT_V(2); PG8_BAR;
    PG8_STAGE(PG8_SB(1, 0), cB + kstep, voffB); PG8_STAGE(PG8_SA(1, 0), cA + kstep, voffA[0]); PG8_STAGE(PG8_SB(1, 1), cB + hstepB + kstep, voffB);
    PG8_WAIT_V(6); PG8_BAR;
    for (;;) {
        const char* nA = has_next ? S.baseA(g, nxt) : cA; const char* nB = has_next ? S.baseB(g, nxt) : cB;
        const char* cB2 = cB; if constexpr (Sched::SPLITB) cB2 = S.baseB2(g, cur);
        for (int t = 0; t < nt; t += 2) {
            const bool last = (t == nt - 2);
            const char* a1 = cA + (size_t)(t + 1) * kstep;
            const char* a2 = last ? nA : cA + (size_t)(t + 2) * kstep;
            const char* b2 = last ? nB : (Sched::SPLITB ? cB2 + (size_t)t * kstep : cB + (size_t)(t + 2) * kstep);
            const char* a3 = a2 + kstep; const char* b3 = b2 + kstep;
            unsigned v2[2][2];
#pragma unroll
            for (int h = 0; h < 2; ++h)
#pragma unroll
                for (int i = 0; i < 2; ++i) v2[h][i] = (Sched::GATHER && last) ? voffN[h][i] : voffA[h][i];
            PG8_LDB(B0, 0, 0); PG8_LDB(B1, 0, 1); PG8_SCHED; PG8_LDA(At, 0, 0); PG8_STAGE(PG8_SA(1, 1), a1, voffA[1]);
            PG8_WAIT_VE(); PG8_WAIT_L(0); PG8_BAR; PG8_MMA(0, 0, At, B0); PG8_MMA(0, 1, At, B1); PG8_BAR; PG8_SCHED;
            PG8_LDA(At, 0, 1); PG8_STAGE(PG8_SB(0, 0), b2, voffB); PG8_STAGE(PG8_SB(0, 1), b2 + hstepB, voffB); PG8_STAGE(PG8_SA(0, 0), a2, v2[0]);
            PG8_WAIT_VE(); PG8_WAIT_L(0); PG8_BAR; PG8_MMA(1, 0, At, B0); PG8_MMA(1, 1, At, B1); PG8_BAR; PG8_SCHED;
            PG8_LDB(B0, 1, 0); PG8_LDB(B1, 1, 1); PG8_SCHED; PG8_LDA(At, 1, 0); PG8_STAGE(PG8_SA(0, 1), a2, v2[1]);
            PG8_WAIT_V(8); PG8_WAIT_L(0); PG8_BAR; PG8_MMA(0, 0, At, B0); PG8_MMA(0, 1, At, B1); PG8_BAR; PG8_SCHED;
            PG8_LDA(At, 1, 1); PG8_STAGE(PG8_SB(1, 0), b3, voffB); PG8_STAGE(PG8_SB(1, 1), b3 + hstepB, voffB); PG8_STAGE(PG8_SA(1, 0), a3, v2[0]);
            PG8_WAIT_V(8); PG8_WAIT_L(0); PG8_BAR; PG8_MMA(1, 0, At, B0); PG8_MMA(1, 1, At, B1); PG8_BAR; PG8_SCHED;
        }
        const bool has_nn = has_next && S.next(ui + 2, nn);
        int trow[2][2];
        if constexpr (Sched::GATHER) { if (has_nn) {
#pragma unroll
            for (int h = 0; h < 2; ++h)
#pragma unroll
                for (int i = 0; i < 2; ++i) trow[h][i] = S.row(nn, h * HALF + RA_[i]); } }
        if (wr == 0) PG8_BAR;
        en = __builtin_amdgcn_readfirstlane(E(acc, cur, wr, wc, fr, fq));
        if (!has_next) break;
        if (!(Epi::CARRY && cur.sel == 0)) {
#pragma unroll
        for (int a = 0; a < 2; ++a)
#pragma unroll
            for (int b = 0; b < 2; ++b)
#pragma unroll
                for (int m = 0; m < 4; ++m)
#pragma unroll
                    for (int n = 0; n < 2; ++n) acc[a][b][m][n] = (f32x4){0.f, 0.f, 0.f, 0.f};
        }
        cur = nxt; cA = nA; cB = nB; ++ui; nxt = nn; has_next = has_nn;
        if constexpr (Sched::GATHER) {
#pragma unroll
            for (int h = 0; h < 2; ++h)
#pragma unroll
                for (int i = 0; i < 2; ++i) { voffA[h][i] = voffN[h][i]; if (has_nn) voffN[h][i] = (unsigned)trow[h][i] * (unsigned)(g.lda * 2) + (unsigned)(CA_[i] * 2); } }
        if (wr == 1) PG8_BAR;
    }
    PG8_WAIT_V(0);
    PG8_BAR;
#undef PG8_SA
#undef PG8_SB
#undef PG8_STAGE
#undef PG8_LDA
#undef PG8_LDB
#undef PG8_MMA
#undef PG8_WAIT_V
#undef PG8_WAIT_L
#undef PG8_WAIT_VE
#undef PG8_BAR
#undef PG8_SCHED
#undef PG8_GATHER
}
}
constexpr int NWAVES = 8;
constexpr int BATCH = 16, SEQ = 4096, D = 1024, M = BATCH * SEQ;
constexpr int CH = 64, NCH = SEQ / CH, NCHUNK = M / CH;
constexpr int NP = 5632;
constexpr float EPS = 1e-6f;
constexpr float LOG2E = 1.4426950408889634f;
constexpr int L_QA = 0, L_KA = 256, L_VA = 512, L_RA = 1024, L_ALR = 1536, L_QB = 1552, L_KB = 2064, L_VB = 2576, L_QI = 3088, L_KI = 3344, L_WI = 3376, L_GA = 3384, L_GB = 4408, D_IN = 5432;
constexpr int NEXP = 32, DEXP = 128, NCLASS = 112;

constexpr size_t MiB = 1u << 20;
constexpr size_t WS_CTL = 0, CTL_ZERO_BYTES = 1 * MiB;
constexpr size_t WS_WIN = 2 * MiB;
constexpr size_t WS_WA = 13 * MiB;
constexpr size_t WS_WB = 14 * MiB;
constexpr size_t WS_WO = 15 * MiB;
constexpr size_t WS_WGU = 17 * MiB;
constexpr size_t WS_WD = 33 * MiB;
constexpr size_t WS_META = 41 * MiB;
constexpr size_t WS_WR = 43 * MiB;
constexpr size_t WS_MRS = 44 * MiB;
constexpr size_t WS_TOK = 42 * MiB;
constexpr size_t WS_R0 = 48 * MiB;
constexpr size_t WS_HN = WS_R0, WS_KDT = WS_R0, WS_MASK = WS_R0 + 32 * MiB, WS_MIXED = WS_R0;
constexpr size_t WS_QA = 176 * MiB, WS_KA = 208 * MiB, WS_VA = 240 * MiB, WS_RA = 304 * MiB, WS_QB = 368 * MiB, WS_KB = 432 * MiB, WS_VB = 496 * MiB, WS_QI = 560 * MiB;
constexpr size_t WS_KI = 592 * MiB, WS_WI = 596 * MiB, WS_ALR = 598 * MiB, WS_DEC = 602 * MiB;
constexpr size_t WS_GA = 608 * MiB, WS_GB = 736 * MiB, WS_OCAT = 864 * MiB, WS_END = 992 * MiB;
constexpr size_t WS_HN8 = 672 * MiB;
constexpr size_t WS_WIN8 = 800 * MiB;
constexpr size_t WS_RS8 = 808 * MiB, WS_CS8 = 809 * MiB;
constexpr size_t WS_WGU8 = 812 * MiB, WS_CSU = 820 * MiB;
constexpr size_t WS_XB8 = WS_R0, WS_XS8 = WS_R0 + 64 * MiB;
constexpr size_t WS_WO8 = 821 * MiB, WS_CSO = 822 * MiB;
constexpr size_t WS_MIX8 = 368 * MiB, WS_MS8 = 432 * MiB;
constexpr size_t WS_SLOT1 = 824 * MiB, WS_SLOT2 = 826 * MiB;
constexpr size_t WS_H2 = 176 * MiB;
constexpr size_t WS_HID = 304 * MiB;
constexpr int CW_TMO = 0, CW_CODE = 1;
constexpr int CW_BAR = 4096;
constexpr int CW_XRANK = 9216;
constexpr int CW_ATTQ = 8448;
constexpr int CW_CMAX = 16384;
constexpr int CW_ROWMAX2 = 131072;
constexpr int CW_PCNT = 196608;
constexpr int CW_ROWMAX = 65536;
constexpr int CW_CLS = 8192;

constexpr int RING_OFF = 0, RING_BYTES = 131072;
constexpr int LDSCTL_OFF = RING_BYTES, MISC_OFF = LDSCTL_OFF + 320;
constexpr int XTRA_OFF = RING_BYTES + 1024;
constexpr int LDS_BYTES = 147456;

#define GAS __attribute__((address_space(1)))
#define LAS __attribute__((address_space(3)))
typedef unsigned short bf16;
typedef unsigned v4u __attribute__((ext_vector_type(4)));
typedef unsigned v2u __attribute__((ext_vector_type(2)));
typedef float f32x4 __attribute__((ext_vector_type(4)));
typedef float f32x16 __attribute__((ext_vector_type(16)));
typedef short bf16x8 __attribute__((ext_vector_type(8)));
typedef GAS unsigned gu32;
#define RLX_AGENT __ATOMIC_RELAXED, __HIP_MEMORY_SCOPE_AGENT
#define LDS_WAIT() asm volatile("s_waitcnt lgkmcnt(0)" ::: "memory")
#define VM_WAIT() asm volatile("s_waitcnt vmcnt(0)" ::: "memory")
__device__ __forceinline__ unsigned f2bf(float f) { unsigned u = __builtin_bit_cast(unsigned, f); return (u + 0x7fffu + ((u >> 16) & 1u)) >> 16; }
__device__ __forceinline__ unsigned pk2(float lo, float hi) { return f2bf(lo) | (f2bf(hi) << 16); }
__device__ __forceinline__ float bf2f(unsigned short b) { return __builtin_bit_cast(float, ((unsigned)b) << 16); }
__device__ __forceinline__ float bflo(unsigned w) { return __builtin_bit_cast(float, w << 16); }
__device__ __forceinline__ float bfhi(unsigned w) { return __builtin_bit_cast(float, w & 0xffff0000u); }
__device__ __forceinline__ float fast_exp2(float x) { return __builtin_amdgcn_exp2f(x); }
__device__ __forceinline__ float sigmoidf_(float x) { return __builtin_amdgcn_rcpf(1.0f + __builtin_amdgcn_exp2f(-x * LOG2E)); }
__device__ __forceinline__ float siluf_(float x) { return x * sigmoidf_(x); }

#define XB_TMO      128
#define XB_XCNT(j)  (256  + 64 * (j))
#define XB_XSUB(j)  (1280 + 64 * (j))
#define XB_XGEN(j)  (2304 + 64 * (j))
#define XB_TOP      3328
#define XB_TOPGEN   3392
#define XCD_BAR_WORDS 3456
#define XB_SPIN_CAP (1u << 18)
__device__ __forceinline__ unsigned xb_ld(unsigned* p)              { return __hip_atomic_load(p, __ATOMIC_RELAXED, __HIP_MEMORY_SCOPE_AGENT); }
__device__ __forceinline__ unsigned xb_add(unsigned* p, unsigned v) { return __hip_atomic_fetch_add(p, v, __ATOMIC_RELAXED, __HIP_MEMORY_SCOPE_AGENT); }
__device__ __forceinline__ unsigned xb_xcc_id() { return (unsigned)__builtin_amdgcn_s_getreg((3 << 11) | 20) & 0xFu; }
#define XB_SPIN(cond, bar) do { unsigned _sp = 0; while (cond) { __builtin_amdgcn_s_sleep(1); \
    if ((++_sp & 255u) == 0u) { if (xb_ld(&(bar)[XB_TMO])) break; if (_sp > XB_SPIN_CAP) { atomicAdd(&(bar)[XB_TMO], 1u); break; } } } } while (0)
struct XcdBarrier { unsigned* bar; unsigned x; volatile LAS unsigned* st; };
__device__ __forceinline__ XcdBarrier xcd_barrier_post(unsigned* bar, volatile LAS unsigned* st) {
    XcdBarrier b; b.bar = bar; b.x = xb_xcc_id(); b.st = st;
    if (threadIdx.x == 0) (void)xb_add(&bar[XB_XCNT(b.x)], 1u);
    return b;
}
__device__ __forceinline__ void xcd_barrier_complete(unsigned* bar, unsigned x, unsigned& nloc, unsigned& nx) {
    const unsigned G = gridDim.x * gridDim.y * gridDim.z;
    unsigned sum, cnt, mine, sp = 0u;
    for (;;) {
        sum = 0u; cnt = 0u; mine = 0u;
#pragma unroll
        for (unsigned j = 0; j < 16; ++j) { const unsigned c = xb_ld(&bar[XB_XCNT(j)]); sum += c; cnt += (c > 0u) ? 1u : 0u; mine = (j == x) ? c : mine; }
        if (sum == G) break;
        __builtin_amdgcn_s_sleep(1);
        if ((++sp & 255u) == 0u) { if (xb_ld(&bar[XB_TMO])) break; if (sp > XB_SPIN_CAP) { atomicAdd(&bar[XB_TMO], 1u); break; } }
    }
    nloc = mine > 0u ? mine : 1u; nx = cnt > 0u ? cnt : 1u;
}
__device__ __forceinline__ void xcd_barrier(const XcdBarrier& b) {
    asm volatile("s_waitcnt vmcnt(0)" ::: "memory");
    __syncthreads();
    if (threadIdx.x == 0) {
        unsigned* bar = b.bar;
        __builtin_amdgcn_s_waitcnt(0);
        unsigned nloc = b.st[0], nx = b.st[1];
        if (nloc == 0u) { xcd_barrier_complete(bar, b.x, nloc, nx); b.st[0] = nloc; b.st[1] = nx; }
        const unsigned old = xb_add(&bar[XB_XSUB(b.x)], 1u);
        const unsigned gen = old / nloc;
        if (old + 1u == (gen + 1u) * nloc) {
            __builtin_amdgcn_fence(__ATOMIC_RELEASE, "agent");
            asm volatile("s_waitcnt vmcnt(0)" ::: "memory");
            const unsigned og = xb_add(&bar[XB_TOP], 1u);
            const unsigned tg = og / nx;
            if (og + 1u == (tg + 1u) * nx) xb_add(&bar[XB_TOPGEN], 1u);
            else XB_SPIN(xb_ld(&bar[XB_TOPGEN]) == tg, bar);
            __builtin_amdgcn_fence(__ATOMIC_ACQUIRE, "agent");
            xb_add(&bar[XB_XGEN(b.x)], 1u);
            asm volatile("s_waitcnt vmcnt(0)" ::: "memory");
        } else {
            XB_SPIN(xb_ld(&bar[XB_XGEN(b.x)]) == gen, bar);
            __builtin_amdgcn_fence(__ATOMIC_ACQUIRE, "agent");
            asm volatile("s_waitcnt vmcnt(0)" ::: "memory");
        }
    }
    __syncthreads();
}

struct Args { const float* in[20]; float* out; unsigned char* ws; int ph_lo, ph_hi, flag, pad; };
struct Frame {
    LAS unsigned char* lds;
    volatile LAS unsigned* MISC;
    gu32* ctl;
    int tid, lane, wave;
    int vcu, G;
    float* out; unsigned char* ws;
};
#define IN_X 0
#define IN_GMIX 1
#define IN_WIN 2
#define IN_WA2 3
#define IN_BA 4
#define IN_GGLA 5
#define IN_WBRG 6
#define IN_GQ 7
#define IN_GK 8
#define IN_RELB 9
#define IN_WBRA 10
#define IN_WOUT 11
#define IN_GFFN 12
#define IN_WRG 13
#define IN_BRG 14
#define IN_WRE 15
#define IN_BRE 16
#define IN_WGATE 17
#define IN_WUP 18
#define IN_WDOWN 19
#define WSP(T, off) ((T*)(F.ws + (off)))

__device__ __forceinline__ float wave_sum(float v) {
#pragma unroll
    for (int o = 1; o < 64; o <<= 1) v += __shfl_xor(v, o);
    return v;
}
__device__ __forceinline__ float wave_max(float v) {
#pragma unroll
    for (int o = 1; o < 64; o <<= 1) v = fmaxf(v, __shfl_xor(v, o));
    return v;
}
__device__ __forceinline__ void win_map(int p, int& c, float& s) {
    const int tile = p >> 8, j = p & 255; s = 1.f;
    if (tile == 0) { c = L_QA + j; s = 0.125f; }
    else if (tile == 1) c = L_KA + j;
    else if (tile < 4) c = L_VA + (p - 512);
    else if (tile < 6) c = L_RA + (p - 1024);
    else if (tile < 10) {
        const int pl = (p - 1536) & 511, t2 = pl >> 8, jj = pl & 255, bj = jj >> 7, wc = (jj >> 5) & 3, x = jj & 31;
        c = (tile < 8 ? L_QB : L_KB) + t2 * 256 + 64 * wc + 32 * bj + x;
    }
    else if (tile < 12) c = L_VB + (p - 2560);
    else if (tile == 12) c = L_QI + j;
    else if (tile == 13) { if (j < 32) c = L_KI + j; else if (j < 40) { c = L_WI + (j - 32); s = 0.0625f; } else if (j < 56) c = L_ALR + (j - 40); else c = -1; }
    else {
        const int pl = (p - 3584) & 1023, t4 = pl >> 8, jj = pl & 255, bj = jj >> 7, wc = (jj >> 5) & 3, fq = (jj >> 3) & 3, j2 = jj & 7;
        c = (tile < 18 ? L_GA : L_GB) + t4 * 256 + 64 * wc + 16 * fq + 8 * bj + j2;
    }
}
#ifndef G1_NBF
#define G1_NBF 0
#endif
__host__ __device__ __forceinline__ int g1_tile(int set, int j) {
#if G1_NBF == 8
    return set ? (j < 4 ? j + 2 : (j < 6 ? j + 6 : j + 8)) : (j < 2 ? j : (j < 6 ? j + 4 : j + 6));
#elif G1_NBF == 2
    return set ? (j < 12 ? j : j + 2) : 12 + j;
#else
    return j;
#endif
}
__device__ __forceinline__ bool win_is8(int tile) {
#if G1_NBF == 8
    return (tile >= 2 && tile < 6) || tile == 10 || tile == 11 || tile >= 14;
#elif G1_NBF == 2
    return tile != 12 && tile != 13;
#else
    return true;
#endif
}
template <int MAP>
__device__ __forceinline__ void p0_transpose_item(const float* W, int K, int N, bf16* WT, int row_off, int nrows, LAS float* scr, int item, int lane, const float* ksc = nullptr, gu32* cmax = nullptr) {
    const int nblk = nrows / 32, kb = item / nblk, nb = item % nblk, k0 = 64 * kb, n0 = 32 * nb;
    const int c4 = lane & 7, kk8 = lane >> 3;
    int c = n0 + 4 * c4; float s = 1.f;
    if (MAP == 1) win_map(n0 + 4 * c4, c, s);
#pragma unroll
    for (int i = 0; i < 8; ++i) { const int kk = 8 * i + kk8; f32x4 v = {0.f, 0.f, 0.f, 0.f};
        if (c >= 0) v = *(const GAS f32x4*)(W + (size_t)(k0 + kk) * N + c) * (ksc ? s * ksc[k0 + kk] : s);
        LAS float* d = scr + kk * 33 + 4 * c4; d[0] = v.x; d[1] = v.y; d[2] = v.z; d[3] = v.w; }
    LDS_WAIT(); asm volatile("" ::: "memory");
    if (cmax) { if (MAP == 0 || win_is8(n0 >> 8)) {
        float mx = 0.f;
#pragma unroll 8
        for (int i = 0; i < 32; ++i) mx = fmaxf(mx, fabsf(scr[(2 * i + (lane >> 5)) * 33 + (lane & 31)]));
        mx = fmaxf(mx, __shfl_xor(mx, 32));
        if (lane < 32) __hip_atomic_fetch_max(cmax + row_off + n0 + lane, f2bf(mx) << 16, RLX_AGENT); } }
    const int ch = lane & 7;
#pragma unroll
    for (int j = 0; j < 4; ++j) { const int n = (lane >> 3) + 8 * j; const LAS float* sp = scr + (8 * ch) * 33 + n;
        v4u o; o.x = pk2(sp[0 * 33], sp[1 * 33]); o.y = pk2(sp[2 * 33], sp[3 * 33]); o.z = pk2(sp[4 * 33], sp[5 * 33]); o.w = pk2(sp[6 * 33], sp[7 * 33]);
        *(GAS v4u*)(WT + (size_t)(row_off + n0 + n) * K + k0 + 8 * ch) = o; }
    LDS_WAIT(); asm volatile("" ::: "memory");
}
__device__ __forceinline__ void rms_row_to_bf16(const float* xrow, const float* g, bf16* orow, int lane) {
    const GAS f32x4* xr = (const GAS f32x4*)xrow + lane; const GAS f32x4* gr = (const GAS f32x4*)g + lane;
    f32x4 v[4]; float s = 0.f;
#pragma unroll
    for (int j = 0; j < 4; ++j) { v[j] = xr[64 * j]; s += (v[j].x * v[j].x + v[j].y * v[j].y) + (v[j].z * v[j].z + v[j].w * v[j].w); }
    const float rs = 1.0f / sqrtf(wave_sum(s) * (1.f / D) + EPS);
    GAS unsigned long long* o8 = (GAS unsigned long long*)orow + lane;
#pragma unroll
    for (int j = 0; j < 4; ++j) { const f32x4 gg = gr[64 * j]; o8[64 * j] = (unsigned long long)pk2(v[j].x * rs * gg.x, v[j].y * rs * gg.y) | ((unsigned long long)pk2(v[j].z * rs * gg.z, v[j].w * rs * gg.w) << 32); }
}
__device__ __forceinline__ void p0_prologue(Frame& F, const Args& A) {
    LAS float* scr = (LAS float*)(F.lds + RING_OFF + F.wave * 16384);
    const int gw = F.vcu * NWAVES + F.wave, NGW = F.G * NWAVES;
    constexpr int I_IN = (D / 64) * (NP / 32);
    constexpr int I_AB = (512 / 64) * (D / 32);
    constexpr int I_O = (D / 64) * (D / 32);
    constexpr int I_GU = (D / 64) * (DEXP / 32);
    constexpr int I_DN = (DEXP / 64) * (D / 32);
    constexpr int NITEMS = I_IN + 2 * I_AB + I_O + NEXP * (2 * I_GU + I_DN);
    for (int it = gw; it < NITEMS; it += NGW) {
        int r = it;
        if (r < I_IN) { p0_transpose_item<1>(A.in[IN_WIN], D, D_IN, WSP(bf16, WS_WIN), 0, NP, scr, r, F.lane, nullptr, F.ctl + CW_CMAX); continue; } r -= I_IN;
        if (r < I_AB) { p0_transpose_item<0>(A.in[IN_WBRG], 512, D, WSP(bf16, WS_WA), 0, D, scr, r, F.lane); continue; } r -= I_AB;
        if (r < I_AB) { p0_transpose_item<0>(A.in[IN_WBRA], 512, D, WSP(bf16, WS_WB), 0, D, scr, r, F.lane); continue; } r -= I_AB;
        if (r < I_O) { p0_transpose_item<0>(A.in[IN_WOUT], D, D, WSP(bf16, WS_WO), 0, D, scr, r, F.lane, nullptr, F.ctl + CW_CMAX + NP + NEXP * 256); continue; } r -= I_O;
        const int e = r / (2 * I_GU + I_DN); r -= e * (2 * I_GU + I_DN);
        if (r < I_GU) { p0_transpose_item<0>(A.in[IN_WGATE] + (size_t)e * D * DEXP, D, DEXP, WSP(bf16, WS_WGU) + (size_t)e * 256 * D, 0, DEXP, scr, r, F.lane, A.in[IN_GFFN], F.ctl + CW_CMAX + NP + e * 256); continue; } r -= I_GU;
        if (r < I_GU) { p0_transpose_item<0>(A.in[IN_WUP] + (size_t)e * D * DEXP, D, DEXP, WSP(bf16, WS_WGU) + (size_t)e * 256 * D, 128, DEXP, scr, r, F.lane, A.in[IN_GFFN], F.ctl + CW_CMAX + NP + e * 256); continue; } r -= I_GU;
        p0_transpose_item<0>(A.in[IN_WDOWN] + (size_t)e * DEXP * D, DEXP, D, WSP(bf16, WS_WD) + (size_t)e * D * DEXP, 0, D, scr, r, F.lane);
    }
    { bf16* WRH = WSP(bf16, WS_WR); bf16* WRL = WRH + 64 * D;
      for (int i = F.vcu * 512 + F.tid; i < 64 * D; i += F.G * 512) { const int c = i >> 10, k = i & 1023;
          float v = 0.f; if (c < 4) v = A.in[IN_WRG][k * 4 + c]; else if (c < 36) v = A.in[IN_WRE][k * 32 + (c - 4)];
          v *= A.in[IN_GFFN][k]; const unsigned hb = f2bf(v); const float lo = v - __builtin_bit_cast(float, hb << 16);
          WRH[i] = (bf16)hb; WRL[i] = (bf16)f2bf(lo); } }
    for (int m = gw * 8; m < M; m += NGW * 8) {
        const GAS f32x4* gr = (const GAS f32x4*)A.in[IN_GMIX] + F.lane;
        f32x4 v[8][4]; float ss[8], am[8];
#pragma unroll
        for (int r = 0; r < 8; ++r) { const GAS f32x4* xr = (const GAS f32x4*)(A.in[IN_X] + (size_t)(m + r) * D) + F.lane; ss[r] = 0.f; am[r] = 0.f;
#pragma unroll
            for (int j = 0; j < 4; ++j) { v[r][j] = __builtin_nontemporal_load(xr + 64 * j); } }
#pragma unroll
        for (int r = 0; r < 8; ++r) {
#pragma unroll
            for (int j = 0; j < 4; ++j) ss[r] += (v[r][j].x * v[r][j].x + v[r][j].y * v[r][j].y) + (v[r][j].z * v[r][j].z + v[r][j].w * v[r][j].w);
            ss[r] = 1.0f / sqrtf(wave_sum(ss[r]) * (1.f / D) + EPS); }
#pragma unroll
        for (int j = 0; j < 4; ++j) { const f32x4 gg = gr[64 * j];
#pragma unroll
            for (int r = 0; r < 8; ++r) { GAS unsigned long long* o8 = (GAS unsigned long long*)(WSP(bf16, WS_HN) + (size_t)(m + r) * D) + F.lane; const float rs = ss[r];
                const f32x4 y = {v[r][j].x * rs * gg.x, v[r][j].y * rs * gg.y, v[r][j].z * rs * gg.z, v[r][j].w * rs * gg.w}; v[r][j] = y;
                am[r] = fmaxf(fmaxf(am[r], fmaxf(fabsf(y.x), fabsf(y.y))), fmaxf(fabsf(y.z), fabsf(y.w)));
                if (G1_NBF > 0) o8[64 * j] = (unsigned long long)pk2(y.x, y.y) | ((unsigned long long)pk2(y.z, y.w) << 32); } }
#pragma unroll
        for (int r = 0; r < 8; ++r) { const float a = wave_max(am[r]); const float inv = a > 0.f ? 127.0f / a : 0.f;
            if (F.lane == 0) WSP(float, WS_RS8)[m + r] = a * (1.0f / 127.0f);
            v4u q;
#pragma unroll
            for (int j = 0; j < 4; ++j) { unsigned b = 0u;
                b = __builtin_amdgcn_cvt_pk_u8_f32(__builtin_rintf(__builtin_fmaf(v[r][j].x, inv, 128.0f)), 0, b); b = __builtin_amdgcn_cvt_pk_u8_f32(__builtin_rintf(__builtin_fmaf(v[r][j].y, inv, 128.0f)), 1, b);
                b = __builtin_amdgcn_cvt_pk_u8_f32(__builtin_rintf(__builtin_fmaf(v[r][j].z, inv, 128.0f)), 2, b); b = __builtin_amdgcn_cvt_pk_u8_f32(__builtin_rintf(__builtin_fmaf(v[r][j].w, inv, 128.0f)), 3, b);
                q[j] = b ^ 0x80808080u; }
            *(GAS v4u*)(F.ws + WS_HN8 + (size_t)(m + r) * D + 16 * F.lane) = q; }
    }
}
__device__ __forceinline__ void p0_quant(Frame& F, const Args& A) {
    const int gw = F.vcu * NWAVES + F.wave, NGW = F.G * NWAVES;
    for (int idx = gw; idx < (22 - G1_NBF) * 256; idx += NGW) {
        const int tile = g1_tile(1, idx >> 8), p = tile * 256 + (idx & 255);
        const float a = __builtin_bit_cast(float, __hip_atomic_load(F.ctl + CW_CMAX + p, RLX_AGENT)); const float inv = a > 0.f ? 127.0f / a : 0.f;
        if (F.lane == 0) WSP(float, WS_CS8)[p] = a * (1.0f / 127.0f);
        const GAS v2u* row = (const GAS v2u*)(WSP(bf16, WS_WIN) + (size_t)p * D) + F.lane;
        v4u q;
#pragma unroll
        for (int j = 0; j < 4; ++j) { const v2u w = row[64 * j]; unsigned b = 0u;
            b = __builtin_amdgcn_cvt_pk_u8_f32(__builtin_rintf(__builtin_fmaf(bflo(w[0]), inv, 128.0f)), 0, b); b = __builtin_amdgcn_cvt_pk_u8_f32(__builtin_rintf(__builtin_fmaf(bfhi(w[0]), inv, 128.0f)), 1, b);
            b = __builtin_amdgcn_cvt_pk_u8_f32(__builtin_rintf(__builtin_fmaf(bflo(w[1]), inv, 128.0f)), 2, b); b = __builtin_amdgcn_cvt_pk_u8_f32(__builtin_rintf(__builtin_fmaf(bfhi(w[1]), inv, 128.0f)), 3, b);
            q[j] = b ^ 0x80808080u; }
        *(GAS v4u*)(F.ws + WS_WIN8 + (size_t)p * D + 16 * F.lane) = q;
    }
    for (int r = gw; r < NEXP * 256; r += NGW) {
        const float a = __builtin_bit_cast(float, __hip_atomic_load(F.ctl + CW_CMAX + NP + r, RLX_AGENT)); const float inv = a > 0.f ? 127.0f / a : 0.f;
        if (F.lane == 0) WSP(float, WS_CSU)[r] = a * (1.0f / 127.0f);
        const GAS v4u* row = (const GAS v4u*)(WSP(bf16, WS_WGU) + (size_t)r * D + 32 * (F.lane >> 1) + 8 * (F.lane & 1));
        v4u q;
#pragma unroll
        for (int c = 0; c < 2; ++c) { const v4u w = row[2 * c];
#pragma unroll
            for (int j = 0; j < 2; ++j) { unsigned b = 0u;
                b = __builtin_amdgcn_cvt_pk_u8_f32(__builtin_rintf(__builtin_fmaf(bflo(w[2 * j]), inv, 128.0f)), 0, b); b = __builtin_amdgcn_cvt_pk_u8_f32(__builtin_rintf(__builtin_fmaf(bfhi(w[2 * j]), inv, 128.0f)), 1, b);
                b = __builtin_amdgcn_cvt_pk_u8_f32(__builtin_rintf(__builtin_fmaf(bflo(w[2 * j + 1]), inv, 128.0f)), 2, b); b = __builtin_amdgcn_cvt_pk_u8_f32(__builtin_rintf(__builtin_fmaf(bfhi(w[2 * j + 1]), inv, 128.0f)), 3, b);
                q[2 * c + j] = b ^ 0x80808080u; } }
        *(GAS v4u*)(F.ws + WS_WGU8 + (size_t)r * D + 16 * F.lane) = q;
    }
    for (int r = gw; r < D; r += NGW) {
        const float a = __builtin_bit_cast(float, __hip_atomic_load(F.ctl + CW_CMAX + NP + NEXP * 256 + r, RLX_AGENT)); const float inv = a > 0.f ? 127.0f / a : 0.f;
        if (F.lane == 0) WSP(float, WS_CSO)[r] = a * (1.0f / 127.0f);
        const GAS v4u* row = (const GAS v4u*)(WSP(bf16, WS_WO) + (size_t)r * D + 256 * (F.lane >> 4) + 32 * ((F.lane >> 2) & 3) + 8 * (F.lane & 3));
        v4u q;
#pragma unroll
        for (int c = 0; c < 2; ++c) { const v4u w = row[16 * c];
#pragma unroll
            for (int j = 0; j < 2; ++j) { unsigned b = 0u;
                b = __builtin_amdgcn_cvt_pk_u8_f32(__builtin_rintf(__builtin_fmaf(bflo(w[2 * j]), inv, 128.0f)), 0, b); b = __builtin_amdgcn_cvt_pk_u8_f32(__builtin_rintf(__builtin_fmaf(bfhi(w[2 * j]), inv, 128.0f)), 1, b);
                b = __builtin_amdgcn_cvt_pk_u8_f32(__builtin_rintf(__builtin_fmaf(bflo(w[2 * j + 1]), inv, 128.0f)), 2, b); b = __builtin_amdgcn_cvt_pk_u8_f32(__builtin_rintf(__builtin_fmaf(bfhi(w[2 * j + 1]), inv, 128.0f)), 3, b);
                q[2 * c + j] = b ^ 0x80808080u; } }
        *(GAS v4u*)(F.ws + WS_WO8 + (size_t)r * D + 16 * F.lane) = q;
    }
}
namespace pg8 {
template <bool I8>
struct EpiG1 {
    static constexpr bool PERM = true, CARRY = false;
    unsigned char* ws; const float *gq, *gk; const float *RS, *CS;
    __device__ __forceinline__ int operator()(const f32x4 (&acc)[2][2][4][2], const Unit& u, int wr, int wc, int fr, int fq) const {
        { int l; asm volatile("v_mbcnt_lo_u32_b32 %0, -1, 0\n\tv_mbcnt_hi_u32_b32 %0, -1, %0" : "=v"(l)); fr = l & 15; fq = l >> 4; }
        const int pn = u.pn; const size_t row0 = (size_t)u.pm * BM + wr * 64 + fr;
        float rsc[2][4]; f32x4 csc[2][2];
        if constexpr (I8) {
#pragma unroll
            for (int ai = 0; ai < 2; ++ai)
#pragma unroll
                for (int m = 0; m < 4; ++m) rsc[ai][m] = RS[row0 + ai * HALF + m * 16];
#pragma unroll
            for (int bj = 0; bj < 2; ++bj)
#pragma unroll
                for (int n = 0; n < 2; ++n) csc[bj][n] = *(const f32x4*)(CS + pn * BM + bj * HALF + wc * 32 + 8 * fq + 4 * n);
        }
        auto DQ = [&](int ai, int bj, int m, int n) -> f32x4 {
            if constexpr (I8) return __builtin_convertvector(__builtin_bit_cast(i32x4, acc[ai][bj][m][n]), f32x4) * csc[bj][n] * rsc[ai][m];
            else return acc[ai][bj][m][n]; };
        if (pn >= 6 && pn < 10) {
            const bool isq = pn < 8; const int t2 = pn - (isq ? 6 : 8); bf16_t* out = (bf16_t*)(ws + (isq ? WS_QB : WS_KB)); const float* g = isq ? gq : gk; const float sc = isq ? 0.125f * 1.4426950408889634f : 1.0f;
            f32x4 gl[2][2];
#pragma unroll
            for (int bj = 0; bj < 2; ++bj)
#pragma unroll
                for (int n = 0; n < 2; ++n) gl[bj][n] = *(const f32x4*)(g + 32 * bj + 8 * fq + 4 * n) * sc;
#pragma unroll
            for (int ai = 0; ai < 2; ++ai)
#pragma unroll
                for (int m = 0; m < 4; ++m) {
                    float ss = 0.f; f32x4 xv[2][2];
#pragma unroll
                    for (int bj = 0; bj < 2; ++bj)
#pragma unroll
                        for (int n = 0; n < 2; ++n) { const f32x4 x = DQ(ai, bj, m, n); xv[bj][n] = x; ss += (x[0] * x[0] + x[1] * x[1]) + (x[2] * x[2] + x[3] * x[3]); }
                    ss += __shfl_xor(ss, 16); ss += __shfl_xor(ss, 32);
                    const float rs = 1.0f / sqrtf(ss * (1.0f / 64.0f) + 1e-6f);
                    bf16_t* rowp = out + (row0 + ai * HALF + m * 16) * 512 + t2 * 256 + 64 * wc + 8 * fq;
#pragma unroll
                    for (int bj = 0; bj < 2; ++bj) { const f32x4 v0 = xv[bj][0] * rs * gl[bj][0], v1 = xv[bj][1] * rs * gl[bj][1];
                        u32x4 w; w.x = cvt_pk_bf16(v0[0], v0[1]); w.y = cvt_pk_bf16(v0[2], v0[3]); w.z = cvt_pk_bf16(v1[0], v1[1]); w.w = cvt_pk_bf16(v1[2], v1[3]);
                        __builtin_nontemporal_store(w, (u32x4*)(rowp + 32 * bj)); }
                }
            return 16;
        }
        if (pn == 13) {
            if (wc == 0) {
#pragma unroll
                for (int ai = 0; ai < 2; ++ai)
#pragma unroll
                    for (int m = 0; m < 4; ++m) { const f32x4 v0 = DQ(ai, 0, m, 0), v1 = DQ(ai, 0, m, 1);
                        u32x4 w; w.x = cvt_pk_bf16(v0[0], v0[1]); w.y = cvt_pk_bf16(v0[2], v0[3]); w.z = cvt_pk_bf16(v1[0], v1[1]); w.w = cvt_pk_bf16(v1[2], v1[3]);
                        *(u32x4*)((bf16_t*)(ws + WS_KI) + (row0 + ai * HALF + m * 16) * 32 + 8 * fq) = w; }
            } else if (wc == 1 && fq < 3) {
#pragma unroll
                for (int ai = 0; ai < 2; ++ai)
#pragma unroll
                    for (int m = 0; m < 4; ++m) { const size_t r = row0 + ai * HALF + m * 16;
                        float* dst = (fq == 0) ? ((float*)(ws + WS_WI) + r * 8) : ((float*)(ws + WS_ALR) + r * 16 + 8 * (fq - 1));
                        *(f32x4*)dst = DQ(ai, 0, m, 0); *(f32x4*)(dst + 4) = DQ(ai, 0, m, 1); }
            }
            return wc == 0 ? 8 : (wc == 1 ? 16 : 0);
        }
        if (pn >= 14) {
            unsigned char* gb = ws + (pn < 18 ? WS_GA : WS_GB) + ((pn - 14) & 3) * 256 + 64 * wc + 16 * fq;
#pragma unroll
            for (int ai = 0; ai < 2; ++ai)
#pragma unroll
                for (int m = 0; m < 4; ++m) { u32x4 w;
#pragma unroll
                    for (int bj = 0; bj < 2; ++bj) { const f32x4 v0 = DQ(ai, bj, m, 0), v1 = DQ(ai, bj, m, 1); unsigned b0 = 0u, b1 = 0u;
#pragma unroll
                        for (int j = 0; j < 4; ++j) { b0 = __builtin_amdgcn_cvt_pk_u8_f32(sigmoidf_(v0[j]) * 255.0f, j, b0); b1 = __builtin_amdgcn_cvt_pk_u8_f32(sigmoidf_(v1[j]) * 255.0f, j, b1); }
                        if (bj == 0) { w.x = b0; w.y = b1; } else { w.z = b0; w.w = b1; } }
                    __builtin_nontemporal_store(w, (u32x4*)(gb + (row0 + ai * HALF + m * 16) * (size_t)1024)); }
            return 8;
        }
        const bool act = (pn == 4 || pn == 5);
        const size_t ob = pn == 0 ? WS_QA : (pn == 1 ? WS_KA : (pn < 4 ? WS_VA : (pn < 6 ? WS_RA : (pn < 12 ? WS_VB : WS_QI))));
        const int ld = (pn < 2 || pn == 12) ? 256 : 512, cb = (pn < 2 || pn == 12) ? 0 : ((pn < 4 ? pn - 2 : (pn < 6 ? pn - 4 : pn - 10)) * 256);
        bf16_t* base = (bf16_t*)(ws + ob);
        const int col0 = cb + wc * 32 + 8 * fq;
#pragma unroll
        for (int ai = 0; ai < 2; ++ai)
#pragma unroll
            for (int m = 0; m < 4; ++m) { bf16_t* rowp = base + (row0 + ai * HALF + m * 16) * ld + col0;
#pragma unroll
                for (int bj = 0; bj < 2; ++bj) { f32x4 v0 = DQ(ai, bj, m, 0), v1 = DQ(ai, bj, m, 1);
                    if (act) {
#pragma unroll
                        for (int j = 0; j < 4; ++j) { v0[j] = siluf_(v0[j]); v1[j] = siluf_(v1[j]); } }
                    u32x4 w; w.x = cvt_pk_bf16(v0[0], v0[1]); w.y = cvt_pk_bf16(v0[2], v0[3]); w.z = cvt_pk_bf16(v1[0], v1[1]); w.w = cvt_pk_bf16(v1[2], v1[3]);
                    __builtin_nontemporal_store(w, (u32x4*)(rowp + bj * HALF)); } }
        return 16;
    }
};
struct G1Order {
    static constexpr bool GATHER = false, SPLITB = false;
    int G, c, ns, set, cnt;
    __device__ bool next(int i, Unit& u) const {
        u.sel = 0;
        if (c < ns) return false;
        const long L = (long)i * (G - ns) + (c - ns); if (L >= 256L * cnt) return false;
        int j; tile_of((int)L, 256, cnt, u.pm, j);
        u.pn = g1_tile(set, j); return true;
    }
    __device__ __forceinline__ const char* baseA(const Gemm& g, const Unit& u) const { return (const char*)g.A + (size_t)u.pm * BM * g.lda * 2; }
    __device__ __forceinline__ const char* baseB(const Gemm& g, const Unit& u) const { return (const char*)g.Bt + (size_t)u.pn * BM * g.ldb * 2; }
};
struct PairOrder {
    static constexpr bool GATHER = false, SPLITB = false;
    int nM, nN, nwg, G, c; const bf16_t* Wa; const bf16_t* Wb;
    __device__ bool next(int i, Unit& u) const {
        const long L = (long)(i >> 1) * G + c; if (L >= nwg) return false;
        tile_of((int)L, nM, nN, u.pm, u.pn); u.sel = i & 1; return true;
    }
    __device__ __forceinline__ const char* baseA(const Gemm& g, const Unit& u) const { return (const char*)g.A + ((size_t)u.pm * BM * g.lda + (u.sel ? 512 : 0)) * 2; }
    __device__ __forceinline__ const char* baseB(const Gemm& g, const Unit& u) const { return (const char*)(u.sel ? Wb : Wa) + (size_t)u.pn * BM * g.ldb * 2; }
};
struct PanelX { PG8_LAS float* xl; unsigned* slots; gu32* cnt; float* scale; };
__device__ __forceinline__ void panel_rowmax(const PanelX& P, int pm, int pn, int wr, int wc, int fr, int fq, float (&mx)[8]) {
    const int tid = threadIdx.x;
#pragma unroll
    for (int it = 0; it < 8; ++it) { mx[it] = fmaxf(mx[it], __shfl_xor(mx[it], 16)); mx[it] = fmaxf(mx[it], __shfl_xor(mx[it], 32)); }
    if (fq == 0) {
#pragma unroll
        for (int it = 0; it < 8; ++it) P.xl[wc * 256 + (it >> 2) * HALF + wr * 64 + (it & 3) * 16 + fr] = mx[it]; }
    __syncthreads();
    if (tid < 256) { const float v = fmaxf(fmaxf(P.xl[tid], P.xl[256 + tid]), fmaxf(P.xl[512 + tid], P.xl[768 + tid]));
        __hip_atomic_store(P.slots + (pm * 4 + pn) * 256 + tid, __builtin_bit_cast(unsigned, v), RLX_AGENT); }
    asm volatile("s_waitcnt vmcnt(0)" ::: "memory");
    __syncthreads();
    if (tid == 0) { __hip_atomic_fetch_add(P.cnt + pm, 1u, __ATOMIC_RELEASE, __HIP_MEMORY_SCOPE_AGENT);
        while (__hip_atomic_load(P.cnt + pm, __ATOMIC_ACQUIRE, __HIP_MEMORY_SCOPE_AGENT) < 4u) __builtin_amdgcn_s_sleep(2); }
    __syncthreads();
    if (tid < 256) { unsigned s[4];
#pragma unroll
        for (int j = 0; j < 4; ++j) s[j] = __hip_atomic_load(P.slots + (pm * 4 + j) * 256 + tid, RLX_AGENT);
        const float v = fmaxf(fmaxf(__builtin_bit_cast(float, s[0]), __builtin_bit_cast(float, s[1])), fmaxf(__builtin_bit_cast(float, s[2]), __builtin_bit_cast(float, s[3])));
        P.xl[1024 + tid] = v; if (pn == 0) P.scale[(size_t)pm * 256 + tid] = v * (1.0f / 127.0f); }
    __syncthreads();
#pragma unroll
    for (int it = 0; it < 8; ++it) mx[it] = P.xl[1024 + (it >> 2) * HALF + wr * 64 + (it & 3) * 16 + fr];
}
struct EpiMix {
    static constexpr bool PERM = true, CARRY = true;
    const bf16_t *GA, *GB; unsigned char* M8; PanelX PX;
    static constexpr float GB_TINY = 255.0f / 1099511627776.0f;
    __device__ __forceinline__ int operator()(f32x4 (&acc)[2][2][4][2], const Unit& u, int wr, int wc, int fr, int fq) const {
        { int l; asm volatile("v_mbcnt_lo_u32_b32 %0, -1, 0\n\tv_mbcnt_hi_u32_b32 %0, -1, %0" : "=v"(l)); fr = l & 15; fq = l >> 4; }
        const size_t row0 = (size_t)u.pm * BM + wr * 64 + fr; const int col0 = u.pn * BM + wc * 32 + 8 * fq;
        const unsigned char* ga = (const unsigned char*)GA; const unsigned char* gb = (const unsigned char*)GB;
        float mx[8]; v2u wbb[2][2], wab[2][2];
#pragma unroll
        for (int bj = 0; bj < 2; ++bj) { const size_t off = row0 * 1024 + col0 + bj * HALF; wbb[0][bj] = *(const v2u*)(gb + off); wab[0][bj] = (v2u){0u, 0u}; if (!u.sel) wab[0][bj] = *(const v2u*)(ga + off); }
#pragma unroll
        for (int it = 0; it < 8; ++it) { const int ai = it >> 2, m = it & 3, sl = it & 1;
            if (it + 1 < 8) { const size_t offn = (row0 + ((it + 1) >> 2) * HALF + ((it + 1) & 3) * 16) * 1024 + col0;
#pragma unroll
                for (int bj = 0; bj < 2; ++bj) { wbb[sl ^ 1][bj] = *(const v2u*)(gb + offn + bj * HALF); wab[sl ^ 1][bj] = (v2u){0u, 0u}; if (!u.sel) wab[sl ^ 1][bj] = *(const v2u*)(ga + offn + bj * HALF); } }
            asm volatile("" ::: "memory");
            mx[it] = 0.f;
#pragma unroll
            for (int bj = 0; bj < 2; ++bj) { const v2u wb = wbb[sl][bj]; f32x4 v0 = acc[ai][bj][m][0], v1 = acc[ai][bj][m][1];
                float b[8];
#pragma unroll
                for (int j = 0; j < 4; ++j) { b[j] = fmaxf((float)((wb[0] >> (8 * j)) & 255u), GB_TINY); b[4 + j] = fmaxf((float)((wb[1] >> (8 * j)) & 255u), GB_TINY); }
                if (!u.sel) { const v2u wa = wab[sl][bj];
#pragma unroll
                    for (int j = 0; j < 4; ++j) { v0[j] *= (float)((wa[0] >> (8 * j)) & 255u) * __builtin_amdgcn_rcpf(b[j]); v1[j] *= (float)((wa[1] >> (8 * j)) & 255u) * __builtin_amdgcn_rcpf(b[4 + j]); } }
                else {
#pragma unroll
                    for (int j = 0; j < 4; ++j) { v0[j] *= b[j] * (1.0f / 255.0f); v1[j] *= b[4 + j] * (1.0f / 255.0f); }
                    mx[it] = fmaxf(fmaxf(mx[it], fmaxf(fmaxf(fabsf(v0[0]), fabsf(v0[1])), fmaxf(fabsf(v0[2]), fabsf(v0[3])))), fmaxf(fmaxf(fabsf(v1[0]), fabsf(v1[1])), fmaxf(fabsf(v1[2]), fabsf(v1[3])))); }
                acc[ai][bj][m][0] = v0; acc[ai][bj][m][1] = v1; } }
        if (!u.sel) return 0;
        panel_rowmax(PX, u.pm, u.pn, wr, wc, fr, fq, mx);
        unsigned char* o8 = M8 + row0 * 1024 + u.pn * BM + 64 * wc + 16 * fq;
#pragma unroll
        for (int it = 0; it < 8; ++it) { const int ai = it >> 2, m = it & 3; const float a = mx[it]; const float inv = a > 0.f ? 127.0f / a : 0.f;
            u32x4 w;
#pragma unroll
            for (int bj = 0; bj < 2; ++bj) { const f32x4 v0 = acc[ai][bj][m][0], v1 = acc[ai][bj][m][1]; unsigned b0 = 0u, b1 = 0u;
#pragma unroll
                for (int j = 0; j < 4; ++j) { b0 = __builtin_amdgcn_cvt_pk_u8_f32(__builtin_rintf(__builtin_fmaf(v0[j], inv, 128.0f)), j, b0); b1 = __builtin_amdgcn_cvt_pk_u8_f32(__builtin_rintf(__builtin_fmaf(v1[j], inv, 128.0f)), j, b1); }
                if (bj == 0) { w.x = b0 ^ 0x80808080u; w.y = b1 ^ 0x80808080u; } else { w.z = b0 ^ 0x80808080u; w.w = b1 ^ 0x80808080u; } }
            *(u32x4*)(o8 + (size_t)(ai * HALF + m * 16) * 1024) = w; }
        return 8;
    }
};
struct EpiRes {
    static constexpr bool PERM = true, CARRY = false;
    const float* X; bf16_t* XB; const float *MS, *CSO; PG8_LAS float* xl; unsigned* slots;
    __device__ __forceinline__ int operator()(const f32x4 (&acc)[2][2][4][2], const Unit& u, int wr, int wc, int fr, int fq) const {
        { int l; asm volatile("v_mbcnt_lo_u32_b32 %0, -1, 0\n\tv_mbcnt_hi_u32_b32 %0, -1, %0" : "=v"(l)); fr = l & 15; fq = l >> 4; }
        const size_t row0 = (size_t)u.pm * BM + wr * 64 + fr; const int col0 = u.pn * BM + wc * 32 + 8 * fq;
        f32x4 csc[2][2];
#pragma unroll
        for (int bj = 0; bj < 2; ++bj)
#pragma unroll
            for (int n = 0; n < 2; ++n) csc[bj][n] = *(const f32x4*)(CSO + col0 + bj * HALF + 4 * n);
        f32x4 xb[2][2][2];
#pragma unroll
        for (int bj = 0; bj < 2; ++bj) { const size_t off = row0 * 1024 + col0 + bj * HALF; xb[0][bj][0] = *(const f32x4*)(X + off); xb[0][bj][1] = *(const f32x4*)(X + off + 4); }
#pragma unroll
        for (int it = 0; it < 8; ++it) { const int ai = it >> 2, m = it & 3, sl = it & 1; const size_t off = (row0 + ai * HALF + m * 16) * 1024 + col0;
            if (it + 1 < 8) { const size_t offn = (row0 + ((it + 1) >> 2) * HALF + ((it + 1) & 3) * 16) * 1024 + col0;
#pragma unroll
                for (int bj = 0; bj < 2; ++bj) { xb[sl ^ 1][bj][0] = *(const f32x4*)(X + offn + bj * HALF); xb[sl ^ 1][bj][1] = *(const f32x4*)(X + offn + bj * HALF + 4); } }
            asm volatile("" ::: "memory");
            const float rsc = MS[row0 + ai * HALF + m * 16]; float mx = 0.f;
#pragma unroll
            for (int bj = 0; bj < 2; ++bj) { const f32x4 y0 = xb[sl][bj][0] + __builtin_convertvector(__builtin_bit_cast(i32x4, acc[ai][bj][m][0]), f32x4) * csc[bj][0] * rsc, y1 = xb[sl][bj][1] + __builtin_convertvector(__builtin_bit_cast(i32x4, acc[ai][bj][m][1]), f32x4) * csc[bj][1] * rsc;
                mx = fmaxf(fmaxf(mx, fmaxf(fmaxf(fabsf(y0[0]), fabsf(y0[1])), fmaxf(fabsf(y0[2]), fabsf(y0[3])))), fmaxf(fmaxf(fabsf(y1[0]), fabsf(y1[1])), fmaxf(fabsf(y1[2]), fabsf(y1[3]))));
                u32x4 w; w.x = cvt_pk_bf16(y0[0], y0[1]); w.y = cvt_pk_bf16(y0[2], y0[3]); w.z = cvt_pk_bf16(y1[0], y1[1]); w.w = cvt_pk_bf16(y1[2], y1[3]);
                *(u32x4*)(XB + off + bj * HALF) = w; }
            mx = fmaxf(mx, __shfl_xor(mx, 16)); mx = fmaxf(mx, __shfl_xor(mx, 32));
            if (fq == 0) xl[wc * 256 + ai * HALF + wr * 64 + m * 16 + fr] = __builtin_bit_cast(float, f2bf(mx) << 16);
            asm volatile("" ::: "memory"); }
        __syncthreads();
        { const int tid = threadIdx.x;
          if (tid < 256) { const float v = fmaxf(fmaxf(xl[tid], xl[256 + tid]), fmaxf(xl[512 + tid], xl[768 + tid])); slots[(u.pm * 4 + u.pn) * 256 + tid] = __builtin_bit_cast(unsigned, v); } }
        __syncthreads();
        return 16;
    }
};
}
__device__ __forceinline__ void gla_prep(Frame& F, const Args& A) {
    const int half = F.tid >> 8, dcol = F.tid & 255;
    LAS float* alr_s = (LAS float*)(F.lds) + half * 1024;
    const float* W2 = A.in[IN_WA2]; const float* ALR = WSP(float, WS_ALR); const bf16* KA = WSP(bf16, WS_KA);
    bf16* KDT = WSP(bf16, WS_KDT); float* DEC = WSP(float, WS_DEC);
    float w2[16];
#pragma unroll
    for (int r = 0; r < 16; ++r) w2[r] = W2[r * 256 + dcol];
    const float bb = A.in[IN_BA][dcol];
    for (int it = F.vcu; it < NCHUNK / 2; it += F.G) {
        const int chunk = it * 2 + half; const size_t row0 = (size_t)chunk * CH;
        __syncthreads();
        *(LAS f32x4*)(alr_s + dcol * 4) = *(const f32x4*)(ALR + row0 * 16 + dcol * 4);
        __syncthreads();
        float cum[64]; float run = 0.f;
#pragma unroll
        for (int t = 0; t < 64; ++t) {
            float z = bb;
#pragma unroll
            for (int r4 = 0; r4 < 4; ++r4) { const f32x4 a = *(const LAS f32x4*)(alr_s + t * 16 + r4 * 4); z += a[0] * w2[r4 * 4] + a[1] * w2[r4 * 4 + 1] + a[2] * w2[r4 * 4 + 2] + a[3] * w2[r4 * 4 + 3]; }
            const float ls = fminf(z, 0.f) - 0.6931471805599453f * __builtin_amdgcn_logf(1.0f + __builtin_amdgcn_exp2f(-fabsf(z) * LOG2E));
            run += ls * (1.0f / 16.0f); cum[t] = run;
        }
        const float total = run;
        DEC[(size_t)chunk * 256 + dcol] = __builtin_amdgcn_exp2f(total * LOG2E);
        const int h = dcol >> 6, d = dcol & 63;
        bf16* dst = KDT + (((size_t)chunk * 4 + h) * 64 + d) * 64;
        const bf16* ksrc = KA + row0 * 256 + dcol;
#pragma unroll
        for (int t8 = 0; t8 < 8; ++t8) {
            float kv[8];
#pragma unroll
            for (int j = 0; j < 8; ++j) { const int t = t8 * 8 + j; kv[j] = bf2f(ksrc[(size_t)t * 256]) * __builtin_amdgcn_exp2f((total - cum[t]) * LOG2E); }
            v4u o; o.x = pk2(kv[0], kv[1]); o.y = pk2(kv[2], kv[3]); o.z = pk2(kv[4], kv[5]); o.w = pk2(kv[6], kv[7]);
            *(GAS v4u*)(dst + t8 * 8) = o;
        }
    }
    __syncthreads();
}
namespace gla {
using s16x4 = __attribute__((ext_vector_type(4))) short;
typedef short v4i16_t __attribute__((ext_vector_type(4)));
typedef __attribute__((address_space(3))) const char* lds_cptr;
__device__ __forceinline__ s16x4 vtr(lds_cptr p) { return __builtin_bit_cast(s16x4, __builtin_amdgcn_ds_read_tr16_b64_v4i16((__attribute__((address_space(3))) v4i16_t*)p)); }
__device__ __forceinline__ void glds16(const void* gsrc, unsigned lds_dst) { unsigned keep;
    asm volatile("s_mov_b32 %0, m0\n\ts_mov_b32 m0, %2\n\ts_nop 0\n\tglobal_load_lds_dwordx4 %1, off\n\ts_mov_b32 m0, %0" : "=&s"(keep) : "v"(gsrc), "s"(lds_dst) : "memory"); }
__device__ __forceinline__ unsigned cvtpk(float lo, float hi) { return pg8::cvt_pk_bf16(lo, hi); }
constexpr int L_Q = 0, L_KD = 16384, L_V = 32768, L_R = 65536, L_DEC = 98304, L_OST = 98816, L_RED = 115200, L_END = L_RED + 2048;
struct Ctx { const bf16* KDT; const float* DEC; const bf16* QA; const bf16* VA; const bf16* RA; bf16* OC; };
#define GLA_BAR() asm volatile("s_waitcnt lgkmcnt(0)\n\ts_barrier" ::: "memory")

__device__ __forceinline__ void load_chunk(const Ctx& X, unsigned lds0, int chunk, int h, int ld, int lane, int slot) {
    const size_t row0 = (size_t)chunk * 64;
#pragma unroll
    for (int i = 0; i < 2; ++i) { const int p = 128 * ld + 64 * i + lane, r = p >> 3, cg = (p & 7) ^ (r & 7);
        glds16(X.QA + (row0 + r) * 256 + h * 64 + cg * 8, (unsigned)__builtin_amdgcn_readfirstlane(lds0 + L_Q + slot * 8192 + (128 * ld + 64 * i) * 16));
        glds16(X.KDT + (((size_t)chunk * 4 + h) * 64 + r) * 64 + cg * 8, (unsigned)__builtin_amdgcn_readfirstlane(lds0 + L_KD + slot * 8192 + (128 * ld + 64 * i) * 16)); }
    const size_t voff = (row0 + (lane >> 2)) * 512 + h * 128 + ld * 32 + (lane & 3) * 8;
#pragma unroll
    for (int p = 0; p < 4; ++p) { glds16(X.VA + voff + (size_t)p * 16 * 512, (unsigned)__builtin_amdgcn_readfirstlane(lds0 + L_V + slot * 16384 + ld * 4096 + p * 1024));
                                  glds16(X.RA + voff + (size_t)p * 16 * 512, (unsigned)__builtin_amdgcn_readfirstlane(lds0 + L_R + slot * 16384 + ld * 4096 + p * 1024)); }
}
__device__ __forceinline__ void store_chunk(const Ctx& X, LAS unsigned char* lds, int chunk, int h, int ld, int lane) {
    const size_t row0 = (size_t)chunk * 64; v4u v[4];
#pragma unroll
    for (int p = 0; p < 4; ++p) v[p] = *(const LAS v4u*)(lds + L_OST + ld * 4096 + p * 1024 + lane * 16);
    asm volatile("s_waitcnt lgkmcnt(0)" ::: "memory");
#pragma unroll
    for (int p = 0; p < 4; ++p) *(v4u*)(X.OC + (row0 + 16 * p + (lane >> 2)) * 1024 + h * 128 + ld * 32 + (lane & 3) * 8) = v[p];
}
__device__ __forceinline__ void step_a(LAS unsigned char* lds, int slot, int sl, int lane, f32x16 (&S)[2], f32x16 (&oT)[2]) {
    const int n32 = lane & 31, hi = lane >> 5;
    const LAS float* dsc = (const LAS float*)(lds + L_DEC + slot * 256);
#pragma unroll
    for (int dt = 0; dt < 2; ++dt)
#pragma unroll
        for (int g = 0; g < 4; ++g) { const f32x4 dv = *(const LAS f32x4*)(dsc + 32 * dt + 8 * g + 4 * hi);
#pragma unroll
            for (int j = 0; j < 4; ++j) S[dt][4 * g + j] *= dv[j]; }
    const lds_cptr kdp = (lds_cptr)lds + L_KD + slot * 8192, qp = (lds_cptr)lds + L_Q + slot * 8192;
    const lds_cptr vp = (lds_cptr)lds + L_V + slot * 16384 + sl * 4096 + ((lane >> 4) & 1) * 32 + (lane & 3) * 8 + (8 * hi + ((lane & 15) >> 2)) * 64;
#pragma unroll
    for (int s = 0; s < 4; ++s) { const s16x4 a0 = vtr(vp + s * 1024), a1 = vtr(vp + s * 1024 + 256);
        const bf16x8 vf = (bf16x8){a0[0], a0[1], a0[2], a0[3], a1[0], a1[1], a1[2], a1[3]};
#pragma unroll
        for (int dt = 0; dt < 2; ++dt) { const int d = 32 * dt + n32; const bf16x8 kf = *(const __attribute__((address_space(3))) bf16x8*)(kdp + d * 128 + (((2 * s + hi) ^ (d & 7)) << 4));
            S[dt] = __builtin_amdgcn_mfma_f32_32x32x16_bf16(kf, vf, S[dt], 0, 0, 0); } }
    v4u sa[2][2];
#pragma unroll
    for (int dt = 0; dt < 2; ++dt)
#pragma unroll
        for (int s = 0; s < 2; ++s)
#pragma unroll
            for (int i = 0; i < 4; ++i) sa[dt][s][i] = cvtpk(S[dt][8 * s + 2 * i], S[dt][8 * s + 2 * i + 1]);
#pragma unroll
    for (int tn = 0; tn < 2; ++tn) { const int t = 32 * tn + n32;
#pragma unroll
        for (int r = 0; r < 16; ++r) oT[tn][r] = 0.f;
#pragma unroll
        for (int dt = 0; dt < 2; ++dt)
#pragma unroll
            for (int s = 0; s < 2; ++s) { const int c0 = 4 * dt + 2 * s;
                const v2u q0 = *(const __attribute__((address_space(3))) v2u*)(qp + t * 128 + ((c0 ^ (t & 7)) << 4) + 8 * hi), q1 = *(const __attribute__((address_space(3))) v2u*)(qp + t * 128 + (((c0 + 1) ^ (t & 7)) << 4) + 8 * hi);
                const v4u qq = (v4u){q0[0], q0[1], q1[0], q1[1]};
                oT[tn] = __builtin_amdgcn_mfma_f32_32x32x16_bf16(__builtin_bit_cast(bf16x8, sa[dt][s]), __builtin_bit_cast(bf16x8, qq), oT[tn], 0, 0, 0); } }
    LAS float* red = (LAS float*)(lds + L_RED) + slot * 256;
#pragma unroll
    for (int tn = 0; tn < 2; ++tn) { float ss = 0.f;
#pragma unroll
        for (int r = 0; r < 16; ++r) ss += oT[tn][r] * oT[tn][r];
        { auto rr = __builtin_amdgcn_permlane32_swap(__float_as_uint(ss), __float_as_uint(ss), false, false); ss = __uint_as_float(rr[0]) + __uint_as_float(rr[1]); }
        if (hi == 0) red[sl * 64 + 32 * tn + n32] = ss; }
}
__device__ __forceinline__ void step_b(LAS unsigned char* lds, int slot, int sl, int lane, const f32x16 (&oT)[2], const float (&gg)[16]) {
    const int n32 = lane & 31, hi = lane >> 5;
    const LAS float* red = (const LAS float*)(lds + L_RED) + slot * 256;
#pragma unroll
    for (int tn = 0; tn < 2; ++tn) { const int t = 32 * tn + n32;
        const float tot = (red[t] + red[64 + t]) + (red[128 + t] + red[192 + t]);
        const float rs = 1.0f / sqrtf(tot * (1.0f / 128.0f) + EPS);
        const int toff = sl * 4096 + (t >> 4) * 1024 + (t & 15) * 64 + 8 * hi;
#pragma unroll
        for (int g = 0; g < 4; ++g) { const v2u rw = *(const LAS v2u*)(lds + L_R + slot * 16384 + toff + 16 * g);
            const float y0 = oT[tn][4 * g] * rs * gg[4 * g] * bflo(rw[0]), y1 = oT[tn][4 * g + 1] * rs * gg[4 * g + 1] * bfhi(rw[0]);
            const float y2 = oT[tn][4 * g + 2] * rs * gg[4 * g + 2] * bflo(rw[1]), y3 = oT[tn][4 * g + 3] * rs * gg[4 * g + 3] * bfhi(rw[1]);
            v2u w; w[0] = cvtpk(y0, y1); w[1] = cvtpk(y2, y3); *(LAS v2u*)(lds + L_OST + toff + 16 * g) = w; } }
}
}

__device__ __forceinline__ void gla_scan_mfma(Frame& F, const Args& A) {
    if (F.vcu >= 64) return;
    const gla::Ctx X{WSP(bf16, WS_KDT), WSP(float, WS_DEC), WSP(bf16, WS_QA), WSP(bf16, WS_VA), WSP(bf16, WS_RA), WSP(bf16, WS_OCAT)};
    const int wid = F.wave, lane = F.lane, hi = lane >> 5;
    const int bh = F.vcu, b = bh >> 2, h = bh & 3, c0 = b * NCH;
    const unsigned lds0 = (unsigned)(uintptr_t)F.lds;
    __syncthreads();
    if (wid >= 4) {
        const int ld = wid - 4;
        gla::load_chunk(X, lds0, c0, h, ld, lane, 0);
        float dv = X.DEC[(size_t)c0 * 256 + h * 64 + lane];
        asm volatile("s_waitcnt vmcnt(0)" ::: "memory");
        if (ld == 0) ((LAS float*)(F.lds + gla::L_DEC))[lane] = dv;
        for (int c = 0; c < NCH; ++c) {
            GLA_BAR();
            if (c + 1 < NCH) { gla::load_chunk(X, lds0, c0 + c + 1, h, ld, lane, (c + 1) & 1); dv = X.DEC[(size_t)(c0 + c + 1) * 256 + h * 64 + lane]; }
            if (c > 0) gla::store_chunk(X, F.lds, c0 + c - 1, h, ld, lane);
            GLA_BAR();
            asm volatile("s_waitcnt vmcnt(0)" ::: "memory");
            if (ld == 0 && c + 1 < NCH) ((LAS float*)(F.lds + gla::L_DEC + ((c + 1) & 1) * 256))[lane] = dv;
        }
        GLA_BAR();
        gla::store_chunk(X, F.lds, c0 + NCH - 1, h, ld, lane);
    } else {
        const int sl = wid;
        float gg[16];
#pragma unroll
        for (int r = 0; r < 16; ++r) gg[r] = A.in[IN_GGLA][sl * 32 + (r & 3) + 8 * (r >> 2) + 4 * hi];
        f32x16 S[2], oT[2];
#pragma unroll
        for (int r = 0; r < 16; ++r) { S[0][r] = 0.f; S[1][r] = 0.f; }
        for (int c = 0; c < NCH; ++c) {
            GLA_BAR();
            gla::step_a(F.lds, c & 1, sl, lane, S, oT);
            GLA_BAR();
            gla::step_b(F.lds, c & 1, sl, lane, oT, gg);
        }
        GLA_BAR();
    }
    __syncthreads();
}
__device__ __forceinline__ unsigned f2key(float f) { const unsigned u = __builtin_bit_cast(unsigned, f + 0.0f);     return u ^ ((u >> 31) ? 0xffffffffu : 0x80000000u); }
template <int NREG>
__device__ __forceinline__ unsigned long long radix_select(const unsigned (&key)[NREG], int lane) {
    unsigned prefix = 0u; bool exact = false;
    for (int bit = 31; bit >= 0; --bit) {
        const unsigned cand = prefix | (1u << bit); int cnt = 0;
#pragma unroll
        for (int j = 0; j < NREG; ++j) cnt += __popcll(__ballot(key[j] >= cand));
        if (cnt >= 256) { prefix = cand; if (cnt == 256) { exact = true; break; } }
    }
    int mlo = 0, mhi = 0;
    int cgt = 0;
#pragma unroll
    for (int j = 0; j < NREG; ++j) cgt += __popcll(__ballot(key[j] > prefix));
    int rem = exact ? 0 : 256 - cgt;
#pragma unroll
    for (int j = 0; j < NREG; ++j) {
        const unsigned long long gt = __ballot(exact ? key[j] >= prefix : key[j] > prefix), eq = exact ? 0ull : __ballot(key[j] == prefix);
        unsigned long long w = gt;
        if (eq != 0ull && rem > 0) {
            const int c = __popcll(eq);
            if (c <= rem) { w |= eq; rem -= c; }
            else { const int rank = __popcll(eq & ((1ull << lane) - 1ull)); w |= __ballot(((eq >> lane) & 1ull) && rank < rem); rem = 0; }
        }
        asm volatile("s_nop 4\n\tv_writelane_b32 %0, %2, %4\n\tv_writelane_b32 %1, %3, %4" : "+v"(mlo), "+v"(mhi) : "s"((unsigned)w), "s"((unsigned)(w >> 32)), "i"(j));
    }
    return ((unsigned long long)(unsigned)mhi << 32) | (unsigned)mlo;
}
#define DPP_STEP_U(x, ctrl, rmask) __builtin_amdgcn_update_dpp(0, (int)(x), ctrl, rmask, 0xf, false)
__device__ __forceinline__ unsigned dpp_scan_add(unsigned x) {
    x += (unsigned)DPP_STEP_U(x, 0x111, 0xf); x += (unsigned)DPP_STEP_U(x, 0x112, 0xf); x += (unsigned)DPP_STEP_U(x, 0x114, 0xf); x += (unsigned)DPP_STEP_U(x, 0x118, 0xf);
    x += (unsigned)DPP_STEP_U(x, 0x142, 0xa); x += (unsigned)DPP_STEP_U(x, 0x143, 0xc); return x; }
#define DPP_STEP_F(x, ctrl, rmask) __builtin_bit_cast(float, __builtin_amdgcn_update_dpp((int)0xff800000, __builtin_bit_cast(int, (x)), ctrl, rmask, 0xf, false))
__device__ __forceinline__ float dpp_wave_max(float x) {
    x = fmaxf(x, DPP_STEP_F(x, 0x111, 0xf)); x = fmaxf(x, DPP_STEP_F(x, 0x112, 0xf)); x = fmaxf(x, DPP_STEP_F(x, 0x114, 0xf)); x = fmaxf(x, DPP_STEP_F(x, 0x118, 0xf));
    x = fmaxf(x, DPP_STEP_F(x, 0x142, 0xa)); x = fmaxf(x, DPP_STEP_F(x, 0x143, 0xc));
    return __builtin_bit_cast(float, __builtin_amdgcn_readlane(__builtin_bit_cast(int, x), 63)); }
__device__ __forceinline__ float rl_f(float v, int l) { return __builtin_bit_cast(float, __builtin_amdgcn_readlane(__builtin_bit_cast(int, v), l)); }
__device__ __forceinline__ int rl_i(int v, int l) { return __builtin_amdgcn_readlane(v, l); }
template <int NREG>
__device__ __forceinline__ unsigned long long select_hist(LAS float* sc, int nr_, int lane) {
    const int nr = __builtin_amdgcn_readfirstlane(nr_);
    float s[NREG]; float lo = INFINITY, hi = -INFINITY;
#pragma unroll
    for (int j = 0; j < NREG; ++j) { if (j < NREG - 7 || j < nr) { s[j] = sc[j * 64 + lane]; lo = fminf(lo, s[j]); hi = fmaxf(hi, s[j]); } else s[j] = -INFINITY; }
    hi = dpp_wave_max(hi); lo = -dpp_wave_max(-lo);
    float c1 = 4095.0f / fmaxf(hi - lo, 1e-30f), c0 = -lo * c1;
    LAS unsigned* hist = (LAS unsigned*)sc;
    asm volatile("s_waitcnt lgkmcnt(0)" ::: "memory");
#pragma unroll
    for (int k = 0; k < 16; ++k) *(LAS v4u*)(hist + k * 256 + lane * 4) = (v4u){0u, 0u, 0u, 0u};
    asm volatile("s_waitcnt lgkmcnt(0)" ::: "memory");
#define SEL_BIN(v) ((int)__builtin_amdgcn_fmed3f(__builtin_fmaf((v), c1, c0), 0.0f, 4095.0f))
#pragma unroll
    for (int j = 0; j < NREG; ++j) { if (j < NREG - 7 || j < nr) (void)__hip_atomic_fetch_add(hist + SEL_BIN(s[j]), 1u, __ATOMIC_RELAXED, __HIP_MEMORY_SCOPE_WORKGROUP); }
    asm volatile("s_waitcnt lgkmcnt(0)" ::: "memory");
    unsigned tot = 0u;
#pragma unroll
    for (int k = 0; k < 16; ++k) { const v4u h4 = *(const LAS v4u*)(hist + lane * 64 + k * 4); tot += (h4[0] + h4[1]) + (h4[2] + h4[3]); }
    const unsigned pre = dpp_scan_add(tot); const unsigned all = (unsigned)rl_i((int)pre, 63);
    const unsigned suf = all - pre + tot;
    const unsigned above = suf - tot;
    const unsigned long long m1 = __ballot(above < 256u && suf >= 256u);
    const int Ls = __ffsll((long long)m1) - 1;
    const unsigned aboveL = (unsigned)rl_i((int)above, Ls);
    const unsigned hb = hist[Ls * 64 + lane];
    const unsigned pre2 = dpp_scan_add(hb); const unsigned suf2 = (unsigned)rl_i((int)pre2, 63) - pre2 + hb;
    const unsigned ab2 = aboveL + (suf2 - hb);
    const unsigned long long m2 = __ballot(ab2 < 256u && ab2 + hb >= 256u);
    const int ks = __ffsll((long long)m2) - 1;
    const int bstar = Ls * 64 + ks; const int cab = rl_i((int)ab2, ks); const int nc = rl_i((int)hb, ks); const int need = 256 - cab;
    if (nc > 64) {
        unsigned key[NREG];
#pragma unroll
        for (int j = 0; j < NREG; ++j) key[j] = (s[j] == -INFINITY) ? 0u : f2key(s[j]);
        return radix_select<NREG>(key, lane);
    }
    LAS float* cv = (LAS float*)(hist) ; LAS int* ci = (LAS int*)(hist + 64);
    asm volatile("s_waitcnt lgkmcnt(0)" ::: "memory");
    int base = 0;
    asm volatile("" : "+v"(c0), "+v"(c1));
#pragma unroll
    for (int j = 0; j < NREG; ++j) { if (j < NREG - 7 || j < nr) { const bool inb = SEL_BIN(s[j]) == bstar; const unsigned long long mk = __ballot(inb);
        if (mk) { if (inb) { const int p = base + __popcll(mk & ((1ull << lane) - 1ull)); cv[p] = s[j]; ci[p] = j * 64 + lane; } base += __popcll(mk); } } }
#undef SEL_BIN
    asm volatile("s_waitcnt lgkmcnt(0)" ::: "memory");
    const float myv = lane < nc ? cv[lane] : -INFINITY; const int myi = lane < nc ? ci[lane] : 0x7fffffff;
    int rank = 0;
    for (int k = 0; k < nc; ++k) { const float vk = rl_f(myv, k); const int ik = rl_i(myi, k); rank += (vk > myv || (vk == myv && ik < myi)) ? 1 : 0; }
    const unsigned long long m3 = __ballot(lane < nc && rank == need - 1);
    const int ts = __ffsll((long long)m3) - 1;
    const float vstar = rl_f(myv, ts); const int istar = rl_i(myi, ts);
    const int ties = __popcll(__ballot(lane < nc && myv == vstar));
    int mlo = 0, mhi = 0;
    if (ties == 1) {
#pragma unroll
        for (int j = 0; j < NREG; ++j) { const unsigned long long w = __ballot(s[j] >= vstar);
            asm volatile("s_nop 4\n\tv_writelane_b32 %0, %2, %4\n\tv_writelane_b32 %1, %3, %4" : "+v"(mlo), "+v"(mhi) : "s"((unsigned)w), "s"((unsigned)(w >> 32)), "i"(j)); }
    } else {
#pragma unroll
        for (int j = 0; j < NREG; ++j) { const int idx = j * 64 + lane; const unsigned long long w = __ballot(s[j] > vstar || (s[j] == vstar && idx <= istar));
            asm volatile("s_nop 4\n\tv_writelane_b32 %0, %2, %4\n\tv_writelane_b32 %1, %3, %4" : "+v"(mlo), "+v"(mhi) : "s"((unsigned)w), "s"((unsigned)(w >> 32)), "i"(j)); }
    }
    return ((unsigned long long)(unsigned)mhi << 32) | (unsigned)mlo;
}
__device__ __forceinline__ float dsa_relu(float x) { const int b = __builtin_bit_cast(int, x); return __builtin_bit_cast(float, b > 0 ? b : 0); }
__device__ __forceinline__ void dsa_select_mfma(Frame& F, const Args& A) {
    LAS float* sc = (LAS float*)F.lds;
    const bf16* QI = WSP(bf16, WS_QI); const bf16* KI = WSP(bf16, WS_KI); const float* WI = WSP(float, WS_WI);
    unsigned long long* MASK = WSP(unsigned long long, WS_MASK);
    const int lane = F.lane, n32 = lane & 31, hi = lane >> 5;
    const int qi_m = 2 * ((n32 >> 2) & 1) + (n32 >> 4), hd_m = (n32 & 3) + 4 * ((n32 >> 3) & 1);
    for (int u = F.vcu; u < 8192; u += F.G) {
        const int g = u & 7, rest = u >> 3, b = rest & 15;
        int i = rest >> 4;
        if (F.G == 256) i ^= (u >> 8) & 1;

        const int N = (i + 1) * 64; const size_t seq0 = (size_t)b * SEQ; const size_t q0 = seq0 + (size_t)i * 64 + g * 8;
        if (i < 4) {
            const size_t r = q0 + F.wave; const int nw = N >> 6;
            MASK[r * 64 + lane] = (lane < nw) ? ~0ull : 0ull;
            continue;
        }
        bf16x8 aq[2][2]; f32x4 wv[2][4];
#pragma unroll
        for (int mt = 0; mt < 2; ++mt) {
#pragma unroll
            for (int s = 0; s < 2; ++s) aq[mt][s] = *(const bf16x8*)(QI + (q0 + 4 * mt + qi_m) * 256 + hd_m * 32 + 16 * s + 8 * hi);
#pragma unroll
            for (int c = 0; c < 4; ++c) wv[mt][c] = *(const f32x4*)(WI + (q0 + 4 * mt + 2 * hi) * 8 + 4 * c);
        }
        __syncthreads();
        const int nj = N / 32;
        bf16x8 nb0, nb1;
        { const int key = 32 * F.wave + n32; nb0 = *(const bf16x8*)(KI + (seq0 + key) * 32 + 8 * hi); nb1 = *(const bf16x8*)(KI + (seq0 + key) * 32 + 16 + 8 * hi); }
        for (int j = F.wave; j < nj; j += 8) {
            const int key = 32 * j + n32;
            const bf16x8 bk0 = nb0, bk1 = nb1;
            { const int jn = (j + 8 < nj) ? j + 8 : j; const int kn = 32 * jn + n32; nb0 = *(const bf16x8*)(KI + (seq0 + kn) * 32 + 8 * hi); nb1 = *(const bf16x8*)(KI + (seq0 + kn) * 32 + 16 + 8 * hi); }
            f32x16 a0, a1;
#pragma unroll
            for (int r = 0; r < 16; ++r) { a0[r] = 0.f; a1[r] = 0.f; }
            a0 = __builtin_amdgcn_mfma_f32_32x32x16_bf16(aq[0][0], bk0, a0, 0, 0, 0); a0 = __builtin_amdgcn_mfma_f32_32x32x16_bf16(aq[0][1], bk1, a0, 0, 0, 0);
            a1 = __builtin_amdgcn_mfma_f32_32x32x16_bf16(aq[1][0], bk0, a1, 0, 0, 0); a1 = __builtin_amdgcn_mfma_f32_32x32x16_bf16(aq[1][1], bk1, a1, 0, 0, 0);
            float s00 = 0.f, s01 = 0.f, s10 = 0.f, s11 = 0.f;
#pragma unroll
            for (int r = 0; r < 8; ++r) { s00 += wv[0][r >> 2][r & 3] * dsa_relu(a0[r]); s01 += wv[0][2 + (r >> 2)][r & 3] * dsa_relu(a0[8 + r]);
                                          s10 += wv[1][r >> 2][r & 3] * dsa_relu(a1[r]); s11 += wv[1][2 + (r >> 2)][r & 3] * dsa_relu(a1[8 + r]); }
            sc[(2 * hi) * 4096 + key] = s00 + 0.0f; sc[(2 * hi + 1) * 4096 + key] = s01 + 0.0f; sc[(4 + 2 * hi) * 4096 + key] = s10 + 0.0f; sc[(5 + 2 * hi) * 4096 + key] = s11 + 0.0f;
        }
        __syncthreads();
        unsigned long long w;
        LAS float* my = sc + F.wave * 4096;
        switch ((i + 8) >> 3) {
            case 1: w = select_hist<8>(my, i + 1, lane); break;
            case 2: w = select_hist<16>(my, i + 1, lane); break;
            case 3: w = select_hist<24>(my, i + 1, lane); break;
            case 4: w = select_hist<32>(my, i + 1, lane); break;
            case 5: w = select_hist<40>(my, i + 1, lane); break;
            case 6: w = select_hist<48>(my, i + 1, lane); break;
            case 7: w = select_hist<56>(my, i + 1, lane); break;
            default: w = select_hist<64>(my, i + 1, lane); break;
        }
        MASK[(q0 + F.wave) * 64 + lane] = w;
    }
    __syncthreads();
}

__device__ __forceinline__ int t5_bucket(int rel) {
    const int n = rel < 0 ? -rel : rel;
    const int v = n < 8 ? n : 8 + (n >= 12) + (n >= 16) + (n >= 23) + (n >= 32) + (n >= 46) + (n >= 64) + (n >= 91);
    return (rel > 0 ? 16 : 0) + v;
}
namespace att {
using s16x4 = __attribute__((ext_vector_type(4))) short;
typedef short v4i16_t __attribute__((ext_vector_type(4)));
constexpr int SLOTB = 8192, LDS_K = 0  , LDS_V = 4 * SLOTB  , LDS_TBL = 6 * SLOTB  , LDS_WS = LDS_TBL + 8 * 2048, LDS_OST = LDS_WS + 8 * 64 * 4, LDS_Q = LDS_OST + 8 * 4096  , LDS_END = LDS_Q + 16;
__device__ __forceinline__ int crow(int r, int hi) { return (r & 3) + 8 * (r >> 2) + 4 * hi; }
__device__ __forceinline__ void glds16(const void* gsrc, unsigned lds_dst) { unsigned keep;
    asm volatile("s_mov_b32 %0, m0\n\ts_mov_b32 m0, %2\n\ts_nop 0\n\tglobal_load_lds_dwordx4 %1, off\n\ts_mov_b32 m0, %0" : "=&s"(keep) : "v"(gsrc), "s"(lds_dst) : "memory"); }
__device__ __forceinline__ void gload8(unsigned long long& dst, const void* gsrc) { asm volatile("global_load_dwordx2 %0, %1, off" : "=v"(dst) : "v"(gsrc) : "memory"); }
typedef __attribute__((address_space(3))) const char* lds_cptr;
__device__ __forceinline__ s16x4 vtr(lds_cptr p) { return __builtin_bit_cast(s16x4, __builtin_amdgcn_ds_read_tr16_b64_v4i16((__attribute__((address_space(3))) v4i16_t*)p)); }
__device__ __forceinline__ unsigned cvtpk(float lo, float hi) { return pg8::cvt_pk_bf16(lo, hi); }

__device__ __forceinline__ void tile_qk(f32x16& p0, f32x16& p1, const bf16x8 (&qr)[4], lds_cptr kb, float cinit) {
#pragma unroll
    for (int r = 0; r < 16; ++r) { p0[r] = cinit; p1[r] = cinit; }
#pragma unroll
    for (int d0 = 0; d0 < 4; ++d0) {
        const bf16x8 b0 = *(const __attribute__((address_space(3))) bf16x8*)(kb + d0 * 2048);
        const bf16x8 b1 = *(const __attribute__((address_space(3))) bf16x8*)(kb + d0 * 2048 + 512);
        p0 = __builtin_amdgcn_mfma_f32_32x32x16_bf16(b0, qr[d0], p0, 0, 0, 0);
        p1 = __builtin_amdgcn_mfma_f32_32x32x16_bf16(b1, qr[d0], p1, 0, 0, 0);
    }
}
template <bool NEAR>
__device__ __forceinline__ void tile_sm_pv(f32x16& o0, f32x16& o1, float& l, f32x16& p0, f32x16& p1, lds_cptr vp, unsigned long long wcur, int hi, const LAS float* tb) {
    const unsigned wl = (unsigned)wcur >> (4 * hi), wh = (unsigned)(wcur >> 32) >> (4 * hi);
    float ls = 0.f;
#define ATT_SM_ELEM(r) do { constexpr int bp = ((r) & 3) + 8 * ((r) >> 2); float a = p0[r], b = p1[r]; \
        if (NEAR) { a += tb[bp]; b += tb[32 + bp]; } \
        a = __builtin_amdgcn_exp2f(a); b = __builtin_amdgcn_exp2f(b); \
        int m0, m1; asm("v_bfe_i32 %0, %1, %2, 1" : "=v"(m0) : "v"(wl), "n"(bp)); asm("v_bfe_i32 %0, %1, %2, 1" : "=v"(m1) : "v"(wh), "n"(bp)); \
        a = __builtin_bit_cast(float, __builtin_bit_cast(unsigned, a) & (unsigned)m0); b = __builtin_bit_cast(float, __builtin_bit_cast(unsigned, b) & (unsigned)m1); \
        p0[r] = a; p1[r] = b; ls += a + b; } while (0)
    ATT_SM_ELEM(0); ATT_SM_ELEM(1); ATT_SM_ELEM(2); ATT_SM_ELEM(3); ATT_SM_ELEM(4); ATT_SM_ELEM(5); ATT_SM_ELEM(6); ATT_SM_ELEM(7);
    ATT_SM_ELEM(8); ATT_SM_ELEM(9); ATT_SM_ELEM(10); ATT_SM_ELEM(11); ATT_SM_ELEM(12); ATT_SM_ELEM(13); ATT_SM_ELEM(14); ATT_SM_ELEM(15);
#undef ATT_SM_ELEM
    l += ls;
    v4u pw[4];
#pragma unroll
    for (int i = 0; i < 4; ++i) { pw[0][i] = cvtpk(p0[2 * i], p0[2 * i + 1]); pw[1][i] = cvtpk(p0[8 + 2 * i], p0[9 + 2 * i]); pw[2][i] = cvtpk(p1[2 * i], p1[2 * i + 1]); pw[3][i] = cvtpk(p1[8 + 2 * i], p1[9 + 2 * i]); }
#pragma unroll
    for (int ks = 0; ks < 4; ++ks) {
        const s16x4 a0 = vtr(vp + ks * 1024), a1 = vtr(vp + ks * 1024 + 512), c0 = vtr(vp + 4096 + ks * 1024), c1 = vtr(vp + 4096 + ks * 1024 + 512);
        const bf16x8 v0 = (bf16x8){a0[0], a0[1], a0[2], a0[3], a1[0], a1[1], a1[2], a1[3]}, v1 = (bf16x8){c0[0], c0[1], c0[2], c0[3], c1[0], c1[1], c1[2], c1[3]};
        const bf16x8 pa = __builtin_bit_cast(bf16x8, pw[ks]);
        o0 = __builtin_amdgcn_mfma_f32_32x32x16_bf16(pa, v0, o0, 0, 0, 0);
        o1 = __builtin_amdgcn_mfma_f32_32x32x16_bf16(pa, v1, o1, 0, 0, 0);
    }
}

__device__ __forceinline__ void attn_unit(LAS unsigned char* lds, int b, int h, int qb, float cfar, float cnear, const bf16* QB, const bf16* KB, const bf16* VB, const unsigned long long* MASK, bf16* OC) {
    const int tid = threadIdx.x, lane = tid & 63, r32 = lane & 31, hi = lane >> 5; const int wid = __builtin_amdgcn_readfirstlane(tid >> 6);
    const size_t rowbase = (size_t)b * SEQ; const int q0 = qb * 256; const int myq = q0 + wid * 32 + r32;
    const bf16* Qw = QB + (rowbase + myq) * 512 + h * 64;
    const bf16* ksrc = KB + (rowbase + lane) * 512 + h * 64 + wid * 8;
    const bf16* vsrc = VB + (rowbase + 16 * (wid & 3) + (lane >> 2)) * 512 + h * 64 + (wid >> 2) * 32 + (lane & 3) * 8;
    const unsigned long long* msrc = MASK + (rowbase + myq) * 64;
    const unsigned lds0 = (unsigned)(uintptr_t)lds;
    const unsigned kdst = lds0 + LDS_K + wid * 1024, vdst = lds0 + LDS_V + wid * 1024;
    const lds_cptr l3 = (lds_cptr)lds;
    const lds_cptr kb0 = l3 + LDS_K + hi * 1024 + r32 * 16;
    const lds_cptr vp0 = l3 + LDS_V + ((lane >> 4) & 1) * 32 + (lane & 3) * 8 + (4 * hi + ((lane & 15) >> 2)) * 64;
    const LAS float* tbl = (const LAS float*)(lds + LDS_TBL) + h * 512;
    LAS float* wsf = (LAS float*)(lds + LDS_WS) + wid * 64;
    const int NT = 4 * (qb + 1);
    const int nfar_ = (q0 + 32 * wid - 154 >= 0) ? ((q0 + 32 * wid - 154) >> 6) + 1 : 0; const int nfar = nfar_ < NT ? nfar_ : NT;
    bf16x8 qr[4];
#pragma unroll
    for (int d0 = 0; d0 < 4; ++d0) qr[d0] = *(const bf16x8*)(Qw + d0 * 16 + hi * 8);
    f32x16 o0, o1;
#pragma unroll
    for (int r = 0; r < 16; ++r) { o0[r] = 0.f; o1[r] = 0.f; }
    float l = 0.f;
    unsigned long long wA, wB;
    const unsigned kd0 = (unsigned)__builtin_amdgcn_readfirstlane(kdst), vd0 = (unsigned)__builtin_amdgcn_readfirstlane(vdst);
#define ATT_WAITBAR(w) asm volatile("s_waitcnt vmcnt(0) lgkmcnt(0)\n\ts_barrier" : "+v"(w) :: "memory")
#define ATT_DMA_K(tt) glds16(ksrc + (size_t)(tt) * 64 * 512, kd0 + ((tt) & 3) * SLOTB)
#define ATT_DMA_V(tt) glds16(vsrc + (size_t)(tt) * 64 * 512, vd0 + ((tt) & 1) * SLOTB)
#define ATT_CINIT(tt) (((tt) < nfar) ? cfar : cnear)
#define ATT_SMPV(tt, P0, P1, w) do { if ((tt) < nfar) tile_sm_pv<false>(o0, o1, l, P0, P1, vp0 + ((tt) & 1) * SLOTB, w, hi, tbl); \
        else tile_sm_pv<true>(o0, o1, l, P0, P1, vp0 + ((tt) & 1) * SLOTB, w, hi, tbl + ((tt) * 64 + 4 * hi - myq + 447)); } while (0)
    f32x16 sA0, sA1, sB0, sB1;
    ATT_DMA_K(0); ATT_DMA_V(0); gload8(wA, msrc); ATT_DMA_K(1);
    ATT_WAITBAR(wA);
    tile_qk(sA0, sA1, qr, kb0, ATT_CINIT(0));
    for (int t = 0; t < NT; t += 2) {
        if (t > 0) ATT_WAITBAR(wA);
        if (t + 2 < NT) ATT_DMA_K(t + 2);
        ATT_DMA_V(t + 1); gload8(wB, msrc + (t + 1));
        tile_qk(sB0, sB1, qr, kb0 + ((t + 1) & 3) * SLOTB, ATT_CINIT(t + 1));
        ATT_SMPV(t, sA0, sA1, wA);
        ATT_WAITBAR(wB);
        if (t + 3 < NT) ATT_DMA_K(t + 3);
        if (t + 2 < NT) { ATT_DMA_V(t + 2); gload8(wA, msrc + (t + 2)); tile_qk(sA0, sA1, qr, kb0 + ((t + 2) & 3) * SLOTB, ATT_CINIT(t + 2)); }
        ATT_SMPV(t + 1, sB0, sB1, wB);
    }
#undef ATT_WAITBAR
#undef ATT_DMA_K
#undef ATT_DMA_V
#undef ATT_CINIT
#undef ATT_SMPV
    { auto rr = __builtin_amdgcn_permlane32_swap(__float_as_uint(l), __float_as_uint(l), false, false); l = __uint_as_float(rr[0]) + __uint_as_float(rr[1]); }
    if (hi == 0) wsf[32 + r32] = l; asm volatile("s_waitcnt lgkmcnt(0)" ::: "memory");
    float rli[16];
#pragma unroll
    for (int r = 0; r < 16; ++r) rli[r] = __builtin_amdgcn_rcpf(wsf[32 + crow(r, hi)]);
    bf16* Ow = OC + (rowbase + q0 + wid * 32) * 1024 + 512 + h * 64;
    { LAS bf16* stg = (LAS bf16*)(lds + LDS_OST) + wid * 2048;
#pragma unroll
      for (int r = 0; r < 16; ++r) { const int orow = crow(r, hi); stg[orow * 64 + r32] = (bf16)f2bf(o0[r] * rli[r]); stg[orow * 64 + 32 + r32] = (bf16)f2bf(o1[r] * rli[r]); }
      asm volatile("s_waitcnt lgkmcnt(0)" ::: "memory");
#pragma unroll
      for (int i = 0; i < 4; ++i) { const int row = i * 8 + (lane >> 3), ch = lane & 7; const v4u v = *(const LAS v4u*)(stg + row * 64 + ch * 8); *(v4u*)(Ow + (size_t)row * 1024 + ch * 8) = v; } }
    asm volatile("s_waitcnt lgkmcnt(0)\n\ts_barrier" ::: "memory");
}
}

__device__ __forceinline__ void dsa_attn_mfma(Frame& F, const Args& A) {
    LAS float* tbl = (LAS float*)(F.lds + att::LDS_TBL);
    volatile LAS int* qw = (volatile LAS int*)(F.lds + att::LDS_Q);
    const bf16* QB = WSP(bf16, WS_QB); const bf16* KB = WSP(bf16, WS_KB); const bf16* VB = WSP(bf16, WS_VB);
    const unsigned long long* MASK = WSP(unsigned long long, WS_MASK); bf16* OC = WSP(bf16, WS_OCAT);
    const float* relb = A.in[IN_RELB];
    float mq = 0.f, mk = 0.f, mb = 0.f;
    { mq = fabsf(A.in[IN_GQ][F.lane]); mk = fabsf(A.in[IN_GK][F.lane]); mb = fmaxf(fmaxf(fabsf(relb[F.lane]), fabsf(relb[64 + F.lane])), fmaxf(fabsf(relb[128 + F.lane]), fabsf(relb[192 + F.lane])));
      mq = wave_max(mq); mk = wave_max(mk); mb = wave_max(mb); }
    const float ref = 8.0f * LOG2E * mq * mk + LOG2E * mb;
    __syncthreads();
    for (int i = F.tid; i < 8 * 512; i += 512) { const int hh = i >> 9, j = i & 511; tbl[i] = (j < 511) ? relb[t5_bucket(j - 447) * 8 + hh] * LOG2E : 0.f; }
    __syncthreads();
    gu32* qctr = F.ctl + CW_ATTQ;
    for (;;) {
        if (F.tid == 0) qw[0] = (int)__hip_atomic_fetch_add(qctr, 1u, RLX_AGENT);
        __syncthreads();
        const int u = qw[0];
        __syncthreads();
        if (u >= 2048) break;
        const int qb = 15 - (u >> 7), bh = u & 127, b = bh >> 3, h = bh & 7;
        const float cnear = -ref, cfar = -ref + relb[15 * 8 + h] * LOG2E;
        att::attn_unit(F.lds, b, h, qb, cfar, cnear, QB, KB, VB, MASK, OC);
    }
    __syncthreads();
}
__device__ __forceinline__ void moe_route_mfma(Frame& F, const Args& A) {
    const bf16* XB = WSP(bf16, WS_H2); const bf16* WRH = WSP(bf16, WS_WR); const bf16* WRL = WRH + 64 * D;
    unsigned* ME = WSP(unsigned, WS_META); float* MC = (float*)(F.ws + WS_META + 512 * 1024); float* MRS = WSP(float, WS_MRS);
    const int lane = F.lane, n32 = lane & 31, hi = lane >> 5;
    LAS float* lg = (LAS float*)F.lds + F.wave * 2048;
    LAS int* lcnt = (LAS int*)(F.lds + XTRA_OFF); LAS int* lbase = lcnt + 128; int* POSC = (int*)(F.ws + WS_META + 256 * 1024);
    if (F.tid < 128) lcnt[F.tid] = 0;
    LAS unsigned char* wl = F.lds + RING_OFF; constexpr int WPITCH = 2048;
    for (int tile = F.vcu * NWAVES + F.wave; tile < M / 32; tile += F.G * NWAVES) {
        __syncthreads();
#pragma unroll 4
        for (int i = 0; i < 16; ++i) { const int p = F.tid + 512 * i, row = p >> 7, c16 = p & 127;
            const v4u v = *(const GAS v4u*)((row < 32 ? WRH + (size_t)row * D : WRL + (size_t)(row - 32) * D) + 8 * c16);
            *(LAS v4u*)(wl + row * WPITCH + 16 * (c16 ^ (row & 7))) = v; }
        __syncthreads();
        const size_t t0 = (size_t)tile * 32;
        const bf16* xp = XB + (t0 + n32) * D + 8 * hi;
        const bf16* bh = WRH + (size_t)n32 * D + 8 * hi; const bf16* bl = WRL + (size_t)n32 * D + 8 * hi;
        f32x16 acc0, acc1;
#pragma unroll
        for (int r = 0; r < 16; ++r) { acc0[r] = 0.f; acc1[r] = 0.f; }
        float ss = 0.f;
        float ra; { const unsigned* sl = WSP(const unsigned, WS_SLOT2) + ((t0 + n32) >> 8) * 1024 + ((t0 + n32) & 255);
            ra = fmaxf(fmaxf(__builtin_bit_cast(float, sl[0]), __builtin_bit_cast(float, sl[256])), fmaxf(__builtin_bit_cast(float, sl[512]), __builtin_bit_cast(float, sl[768]))); }
        const float qinv = ra > 0.f ? 127.0f / ra : 0.f;
        if (hi == 0) WSP(float, WS_XS8)[t0 + n32] = ra * (1.0f / 127.0f);
        unsigned char* x8 = F.ws + WS_XB8 + (t0 + n32) * D + 16 * hi; v4u q8;
        v4u xs[4]; bf16x8 wq[4][4];
#define RT_LOAD(sl, s) do { xs[sl] = *(const v4u*)(xp + 16 * (s)); \
                            wq[sl][1] = (bf16x8){0, 0, 0, 0, 0, 0, 0, 0}; wq[sl][3] = (bf16x8){0, 0, 0, 0, 0, 0, 0, 0}; \
                            if (n32 < 4) { wq[sl][1] = *(const bf16x8*)(bh + 32 * D + 16 * (s)); wq[sl][3] = *(const bf16x8*)(bl + 32 * D + 16 * (s)); } } while (0)
        RT_LOAD(0, 0); RT_LOAD(1, 1); RT_LOAD(2, 2);
        for (int s4 = 0; s4 < 64; s4 += 4) {
#pragma unroll
            for (int u4 = 0; u4 < 4; ++u4) { const int s = s4 + u4;
                if (s + 3 < 64) RT_LOAD((u4 + 3) & 3, s + 3);
                asm volatile("" ::: "memory");
                const v4u xw = xs[u4];
                {
                    unsigned b0 = 0u, b1 = 0u;
                    b0 = __builtin_amdgcn_cvt_pk_u8_f32(__builtin_rintf(__builtin_fmaf(bflo(xw[0]), qinv, 128.0f)), 0, b0); b0 = __builtin_amdgcn_cvt_pk_u8_f32(__builtin_rintf(__builtin_fmaf(bfhi(xw[0]), qinv, 128.0f)), 1, b0);
                    b0 = __builtin_amdgcn_cvt_pk_u8_f32(__builtin_rintf(__builtin_fmaf(bflo(xw[1]), qinv, 128.0f)), 2, b0); b0 = __builtin_amdgcn_cvt_pk_u8_f32(__builtin_rintf(__builtin_fmaf(bfhi(xw[1]), qinv, 128.0f)), 3, b0);
                    b1 = __builtin_amdgcn_cvt_pk_u8_f32(__builtin_rintf(__builtin_fmaf(bflo(xw[2]), qinv, 128.0f)), 0, b1); b1 = __builtin_amdgcn_cvt_pk_u8_f32(__builtin_rintf(__builtin_fmaf(bfhi(xw[2]), qinv, 128.0f)), 1, b1);
                    b1 = __builtin_amdgcn_cvt_pk_u8_f32(__builtin_rintf(__builtin_fmaf(bflo(xw[3]), qinv, 128.0f)), 2, b1); b1 = __builtin_amdgcn_cvt_pk_u8_f32(__builtin_rintf(__builtin_fmaf(bfhi(xw[3]), qinv, 128.0f)), 3, b1);
                    if ((u4 & 1) == 0) { q8.x = b0 ^ 0x80808080u; q8.y = b1 ^ 0x80808080u; } else { q8.z = b0 ^ 0x80808080u; q8.w = b1 ^ 0x80808080u; *(v4u*)(x8 + 32 * (s >> 1)) = q8; } }
#pragma unroll
                for (int j = 0; j < 4; ++j) { const float a = bflo(xw[j]), b = bfhi(xw[j]); ss += a * a + b * b; }
                const bf16x8 Ah = __builtin_bit_cast(bf16x8, xw);
                const bf16x8 w0h = *(const LAS bf16x8*)(wl + n32 * WPITCH + 16 * ((2 * s + hi) ^ (n32 & 7))), w0l = *(const LAS bf16x8*)(wl + (32 + n32) * WPITCH + 16 * ((2 * s + hi) ^ (n32 & 7)));
                acc0 = __builtin_amdgcn_mfma_f32_32x32x16_bf16(Ah, w0h, acc0, 0, 0, 0); acc1 = __builtin_amdgcn_mfma_f32_32x32x16_bf16(Ah, wq[u4][1], acc1, 0, 0, 0);
                acc0 = __builtin_amdgcn_mfma_f32_32x32x16_bf16(Ah, w0l, acc0, 0, 0, 0); acc1 = __builtin_amdgcn_mfma_f32_32x32x16_bf16(Ah, wq[u4][3], acc1, 0, 0, 0);
            }
        }
#undef RT_LOAD
        ss += __shfl_xor(ss, 32);
        const float rs = 1.0f / sqrtf(ss * (1.f / D) + EPS);
        __syncthreads();
#pragma unroll
        for (int r = 0; r < 16; ++r) { const int tk = (r & 3) + 8 * (r >> 2) + 4 * hi; lg[tk * 64 + n32] = acc0[r]; lg[tk * 64 + 32 + n32] = acc1[r]; }
        LDS_WAIT(); asm volatile("" ::: "memory");
        if (hi == 0) {
            const size_t r = t0 + n32; const LAS float* my = lg + n32 * 64;
            float gl[4];
#pragma unroll
            for (int c = 0; c < 4; ++c) gl[c] = my[c] * rs + A.in[IN_BRG][c];
            int gs = 0; float gm = gl[0];
#pragma unroll
            for (int c = 1; c < 4; ++c) if (gl[c] > gm) { gm = gl[c]; gs = c; }
            float den = 0.f;
#pragma unroll
            for (int c = 0; c < 4; ++c) den += __expf(gl[c] - gm);
            const float gw = 1.0f / den;
            float el[8];
#pragma unroll
            for (int c = 0; c < 8; ++c) el[c] = my[4 + gs * 8 + c] * rs + A.in[IN_BRE][gs * 8 + c];
            int i0 = 0; float v0 = el[0];
#pragma unroll
            for (int c = 1; c < 8; ++c) if (el[c] > v0) { v0 = el[c]; i0 = c; }
            int i1 = -1; float v1 = -INFINITY;
#pragma unroll
            for (int c = 0; c < 8; ++c) if (c != i0 && el[c] > v1) { v1 = el[c]; i1 = c; }
            const float p1 = 1.0f / (1.0f + __expf(v0 - v1)), p0 = 1.0f - p1;
            const float c0 = p0 * gw, c1 = p1 * gw;
            const int a = i0 < i1 ? i0 : i1, bq = i0 < i1 ? i1 : i0; const float ca = i0 < i1 ? c0 : c1, cb = i0 < i1 ? c1 : c0;
            const int cls = gs * 28 + (a * (15 - a)) / 2 + (bq - a - 1);
            ME[r] = (unsigned)(gs * 8 + a) | ((unsigned)(gs * 8 + bq) << 8) | ((unsigned)cls << 16); MC[r * 2] = ca; MC[r * 2 + 1] = cb; MRS[r] = rs;
            POSC[r] = __hip_atomic_fetch_add(lcnt + cls, 1, __ATOMIC_RELAXED, __HIP_MEMORY_SCOPE_WORKGROUP);
        }
        LDS_WAIT(); asm volatile("" ::: "memory");
    }
    __syncthreads();
    if (F.tid < NCLASS) { const int n = lcnt[F.tid]; lbase[F.tid] = n ? (int)__hip_atomic_fetch_add(F.ctl + CW_CLS + F.tid, (unsigned)n, RLX_AGENT) : 0; }
    __syncthreads();
    for (int tile = F.vcu * NWAVES + F.wave; tile < M / 32; tile += F.G * NWAVES) {
        if (hi == 0) { const size_t r = (size_t)tile * 32 + n32; POSC[r] += lbase[ME[r] >> 16]; } }
    __syncthreads();
}
constexpr size_t WS_TILEE = WS_TOK + 512 * 1024, WS_NT = WS_TOK + 768 * 1024;
__device__ __forceinline__ void moe_assign(Frame& F, const Args& A) {
    LAS int* off_s = (LAS int*)F.lds; LAS int* cnt_s = off_s + 128;
    gu32* cnt = F.ctl + CW_CLS;
    int* TOK = WSP(int, WS_TOK); unsigned* TILEE = WSP(unsigned, WS_TILEE); int* NT = WSP(int, WS_NT); const unsigned* ME = WSP(unsigned, WS_META);
    __syncthreads();
    if (F.tid < NCLASS) cnt_s[F.tid] = (int)__hip_atomic_load(cnt + F.tid, RLX_AGENT);
    __syncthreads();
    if (F.tid == 0) { int o = 0; for (int c = 0; c < NCLASS; ++c) { off_s[c] = o; o += (cnt_s[c] + 255) & ~255; } off_s[NCLASS] = o; }
    __syncthreads();
    for (int r = F.vcu * 512 + F.tid; r < M; r += F.G * 512) { const int cls = (int)(ME[r] >> 16); const int pos = off_s[cls] + WSP(const int, WS_META + 256 * 1024)[r]; TOK[pos] = r; }
    for (int c = F.vcu; c < NCLASS; c += F.G) {
        const int lo = off_s[c] + cnt_s[c], hi = off_s[c + 1];
        for (int p = lo + F.tid; p < hi; p += 512) TOK[p] = -1;
        const int g = c / 28; int pi = c % 28, a = 0; while (pi >= 7 - a) { pi -= 7 - a; ++a; } const int b = a + 1 + pi;
        const unsigned ee = (unsigned)(g * 8 + a) | ((unsigned)(g * 8 + b) << 8);
        for (int t = off_s[c] / 256 + F.tid; t < off_s[c + 1] / 256; t += 512) TILEE[t] = ee;
    }
    if (F.vcu == 0 && F.tid == 0) NT[0] = off_s[NCLASS] / 256;
    __syncthreads();
}
namespace pg8 {
struct MoeUpOrder {
    static constexpr bool GATHER = true, SPLITB = false;
    int nT, G, c; const int* TOK; const unsigned* TILEE; const bf16_t* WGU;
    __device__ bool next(int i, Unit& u) const { const long L = (long)i * G + c; if (L >= 2L * nT) return false; tile_of((int)L, nT, 2, u.pm, u.pn); u.sel = (int)TILEE[u.pm]; return true; }
    __device__ __forceinline__ const char* baseA(const Gemm& g, const Unit&) const { return (const char*)g.A; }
    __device__ __forceinline__ const char* baseB(const Gemm& g, const Unit& u) const { const int e = (u.pn ? (u.sel >> 8) : u.sel) & 255; return (const char*)WGU + (size_t)e * 256 * g.ldb * 2; }
    __device__ __forceinline__ int row(const Unit& u, int r) const { const int t = TOK[u.pm * BM + r]; return t < 0 ? 0 : t; }
};
struct EpiMoeUp {
    static constexpr bool PERM = true, CARRY = false;
    const int* TOK; const float* MC; const float* MRS; bf16_t* HID; const float* XS; const float* CSU;
    __device__ __forceinline__ int operator()(const f32x4 (&acc)[2][2][4][2], const Unit& u, int wr, int wc, int fr, int fq) const {
        { int l; asm volatile("v_mbcnt_lo_u32_b32 %0, -1, 0\n\tv_mbcnt_hi_u32_b32 %0, -1, %0" : "=v"(l)); fr = l & 15; fq = l >> 4; }
        const int pos0 = u.pm * BM + wr * 64 + fr; const int e = (u.pn ? (u.sel >> 8) : u.sel) & 255;
        f32x4 csc[2][2];
#pragma unroll
        for (int bj = 0; bj < 2; ++bj)
#pragma unroll
            for (int n = 0; n < 2; ++n) csc[bj][n] = *(const f32x4*)(CSU + e * 256 + bj * HALF + wc * 32 + 8 * fq + 4 * n);
#pragma unroll
        for (int ai = 0; ai < 2; ++ai)
#pragma unroll
            for (int m = 0; m < 4; ++m) { const int pos = pos0 + ai * HALF + m * 16; const int tok = TOK[pos]; const float cw = tok >= 0 ? MC[(size_t)tok * 2 + u.pn] : 0.f; const float rs = tok >= 0 ? MRS[tok] * XS[tok] : 0.f;
                const f32x4 g0 = __builtin_convertvector(__builtin_bit_cast(i32x4, acc[ai][0][m][0]), f32x4) * csc[0][0], g1 = __builtin_convertvector(__builtin_bit_cast(i32x4, acc[ai][0][m][1]), f32x4) * csc[0][1];
                const f32x4 u0 = __builtin_convertvector(__builtin_bit_cast(i32x4, acc[ai][1][m][0]), f32x4) * csc[1][0], u1 = __builtin_convertvector(__builtin_bit_cast(i32x4, acc[ai][1][m][1]), f32x4) * csc[1][1]; float h[8];
#pragma unroll
                for (int j = 0; j < 4; ++j) { h[j] = cw * siluf_(rs * g0[j]) * (rs * u0[j]); h[4 + j] = cw * siluf_(rs * g1[j]) * (rs * u1[j]); }
                u32x4 w; w.x = cvt_pk_bf16(h[0], h[1]); w.y = cvt_pk_bf16(h[2], h[3]); w.z = cvt_pk_bf16(h[4], h[5]); w.w = cvt_pk_bf16(h[6], h[7]);
                *(u32x4*)(HID + (size_t)pos * 256 + u.pn * 128 + wc * 32 + 8 * fq) = w; }
        return 8;
    }
};
struct MoeDownOrder {
    static constexpr bool GATHER = false, SPLITB = true;
    int nT, G, c; const unsigned* TILEE; const bf16_t* WD;
    __device__ bool next(int i, Unit& u) const { const long L = (long)i * G + c; if (L >= 4L * nT) return false; tile_of((int)L, nT, 4, u.pm, u.pn); u.sel = (int)TILEE[u.pm]; return true; }
    __device__ __forceinline__ const char* baseA(const Gemm& g, const Unit& u) const { return (const char*)g.A + (size_t)u.pm * BM * g.lda * 2; }
    __device__ __forceinline__ const char* baseB(const Gemm&, const Unit& u) const { return (const char*)WD + ((size_t)(u.sel & 255) * 1024 + (size_t)u.pn * BM) * 128 * 2; }
    __device__ __forceinline__ const char* baseB2(const Gemm&, const Unit& u) const { return (const char*)WD + ((size_t)((u.sel >> 8) & 255) * 1024 + (size_t)u.pn * BM) * 128 * 2; }
};
struct EpiMoeDown {
    static constexpr bool PERM = true, CARRY = false;
    const int* TOK; const bf16_t* XB; float* O; float* DUMP;
    __device__ __forceinline__ int operator()(const f32x4 (&acc)[2][2][4][2], const Unit& u, int wr, int wc, int fr, int fq) const {
        { int l; asm volatile("v_mbcnt_lo_u32_b32 %0, -1, 0\n\tv_mbcnt_hi_u32_b32 %0, -1, %0" : "=v"(l)); fr = l & 15; fq = l >> 4; }
        const int* tp = TOK + u.pm * BM + wr * 64 + fr; const int col0 = u.pn * BM + wc * 32 + 8 * fq;
        int tk[8];
#pragma unroll
        for (int it = 0; it < 8; ++it) tk[it] = tp[(it >> 2) * HALF + (it & 3) * 16];
        u32x4 xw[2][2];
#pragma unroll
        for (int bj = 0; bj < 2; ++bj) xw[0][bj] = *(const u32x4*)(XB + (size_t)(tk[0] >= 0 ? tk[0] : 0) * 1024 + col0 + bj * HALF);
#pragma unroll
        for (int it = 0; it < 8; ++it) { const int ai = it >> 2, m = it & 3, sl = it & 1; const int tok = tk[it];
            if (it + 1 < 8) {
#pragma unroll
                for (int bj = 0; bj < 2; ++bj) xw[sl ^ 1][bj] = *(const u32x4*)(XB + (size_t)(tk[it + 1] >= 0 ? tk[it + 1] : 0) * 1024 + col0 + bj * HALF); }
            asm volatile("" ::: "memory");
            float* rowp = (tok >= 0 ? O + (size_t)tok * 1024 : DUMP) + col0;
#pragma unroll
            for (int bj = 0; bj < 2; ++bj) { const u32x4 x = xw[sl][bj]; f32x4 y0 = acc[ai][bj][m][0], y1 = acc[ai][bj][m][1];
                y0[0] += bflo(x.x); y0[1] += bfhi(x.x); y0[2] += bflo(x.y); y0[3] += bfhi(x.y);
                y1[0] += bflo(x.z); y1[1] += bfhi(x.z); y1[2] += bflo(x.w); y1[3] += bfhi(x.w);
                *(f32x4*)(rowp + bj * HALF) = y0; *(f32x4*)(rowp + bj * HALF + 4) = y1; }
            asm volatile("" ::: "memory"); }
        return 32;
    }
};
}
#ifndef MK_SPLIT
#define MK_SPLIT 0
#endif
constexpr int NPHASE = 12;
__global__ void __launch_bounds__(NWAVES * 64, 2) fwd(Args args) {
    extern __shared__ __attribute__((aligned(16))) unsigned char lds[];
    Frame F;
    F.lds = (LAS unsigned char*)lds;
    F.MISC = (volatile LAS unsigned*)(F.lds + MISC_OFF);
    F.tid = threadIdx.x; F.lane = F.tid & 63; F.wave = __builtin_amdgcn_readfirstlane(F.tid >> 6);
    F.G = gridDim.x; { const int bx = blockIdx.x; F.vcu = (F.G % 8 == 0) ? (bx % 8) * (F.G / 8) + bx / 8 : bx; }
    F.ws = args.ws; F.out = args.out; F.ctl = (gu32*)(args.ws + WS_CTL);
    for (int u = F.tid; u < 256; u += NWAVES * 64) ((LAS unsigned*)(F.lds + LDSCTL_OFF))[u] = 0u;
    __syncthreads();
    const int lo = args.ph_lo, hi = args.ph_hi;
    XcdBarrier bar; bar.bar = (unsigned*)(F.ctl + CW_BAR); bar.x = 0; bar.st = nullptr;
    if (hi - lo > 1) { bar = xcd_barrier_post((unsigned*)(F.ctl + CW_BAR), F.MISC + 8);
        if (F.tid == 0) { const unsigned x = xb_xcc_id(); F.MISC[16] = x; F.MISC[17] = __hip_atomic_fetch_add(F.ctl + CW_XRANK + 64 * x, 1u, RLX_AGENT); } }
    int vid = (int)blockIdx.x;
#ifndef ONLY
#define ONLY -1
#endif
#define IN(k) ((ONLY < 0 || ONLY == (k)) && lo <= (k) && (k) < hi)
#define BOTH(k) (IN(k) && IN((k) + 1))
#ifndef PROBE_FLAG
#define PROBE_FLAG 1
#endif
#ifndef REP_PHASE
#define REP_PHASE -1
#endif
#define NREP(k) 1
#define GRID_BAR() xcd_barrier(bar)

    if (IN(0)) _Pragma("unroll") for (int rep_ = 0; rep_ < NREP(0); ++rep_) { p0_prologue(F, args); if (BOTH(0)) GRID_BAR(); }
    if (IN(1)) { p0_quant(F, args); if (BOTH(1)) GRID_BAR(); }
    if (hi - lo > 1 && lo == 0) {
        bool ok = (F.G % 8) == 0;
#pragma unroll
        for (int j = 0; j < 8; ++j) ok = ok && (__hip_atomic_load(F.ctl + CW_XRANK + 64 * j, RLX_AGENT) == (unsigned)(F.G / 8));
        __syncthreads();
        if (ok) vid = (int)__builtin_amdgcn_readfirstlane((int)(F.MISC[17] * 8u + F.MISC[16]));
    }
    if (IN(2)) _Pragma("unroll") for (int rep_ = 0; rep_ < NREP(2); ++rep_) {
        if (G1_NBF > 0) { pg8::Gemm g{WSP(bf16, WS_HN), WSP(bf16, WS_WIN), D, D, D}; pg8::G1Order S{F.G, vid, 0, 0, G1_NBF};
          pg8::EpiG1<false> E{F.ws, args.in[IN_GQ], args.in[IN_GK], nullptr, nullptr};
          pg8::gemm_phase<pg8::EpiG1<false>, pg8::G1Order>(F.lds + RING_OFF, g, S, E); }
        { pg8::Gemm g{WSP(bf16, WS_HN8), WSP(bf16, WS_WIN8), D / 2, D / 2, D / 2}; pg8::G1Order S{F.G, vid, 0, 1, 22 - G1_NBF};
          pg8::EpiG1<true> E{F.ws, args.in[IN_GQ], args.in[IN_GK], WSP(const float, WS_RS8), WSP(const float, WS_CS8)};
          pg8::gemm_phase<pg8::EpiG1<true>, pg8::G1Order, true>(F.lds + RING_OFF, g, S, E); }
        if (BOTH(2)) GRID_BAR();
    }
    if (IN(3)) _Pragma("unroll") for (int rep_ = 0; rep_ < NREP(3); ++rep_) { gla_prep(F, args); }
    if (IN(4)) _Pragma("unroll") for (int rep_ = 0; rep_ < NREP(4); ++rep_) { dsa_select_mfma(F, args); if (BOTH(4)) GRID_BAR(); }
    if (IN(5)) _Pragma("unroll") for (int rep_ = 0; rep_ < NREP(5); ++rep_) { gla_scan_mfma(F, args); dsa_attn_mfma(F, args); if (BOTH(5)) GRID_BAR(); }
    if (IN(6)) _Pragma("unroll") for (int rep_ = 0; rep_ < NREP(6); ++rep_) {
        pg8::Gemm g{WSP(bf16, WS_OCAT), nullptr, 1024, 512, 512};
        pg8::PairOrder S; S.nM = M / 256; S.nN = D / 256; S.nwg = S.nM * S.nN; S.G = F.G; S.c = vid; S.Wa = WSP(bf16, WS_WA); S.Wb = WSP(bf16, WS_WB);
        pg8::EpiMix E{WSP(bf16, WS_GA), WSP(bf16, WS_GB), F.ws + WS_MIX8, pg8::PanelX{(LAS float*)(F.lds + XTRA_OFF), WSP(unsigned, WS_SLOT1), F.ctl + CW_PCNT, WSP(float, WS_MS8)}};
        pg8::gemm_phase<pg8::EpiMix, pg8::PairOrder>(F.lds + RING_OFF, g, S, E);
        if (BOTH(6)) GRID_BAR();
    }
    if (IN(7)) _Pragma("unroll") for (int rep_ = 0; rep_ < NREP(7); ++rep_) {
        pg8::Gemm g{WSP(bf16, WS_MIX8), WSP(bf16, WS_WO8), D / 2, D / 2, D / 2}; pg8::StaticOrder S; S.init(M, D, F.G, vid);
        pg8::EpiRes E{args.in[IN_X], WSP(bf16, WS_H2), WSP(const float, WS_MS8), WSP(const float, WS_CSO), (LAS float*)(F.lds + XTRA_OFF), WSP(unsigned, WS_SLOT2)};
        pg8::gemm_phase<pg8::EpiRes, pg8::StaticOrder, true>(F.lds + RING_OFF, g, S, E);
        if (BOTH(7)) GRID_BAR();
    }
    if (IN(8)) _Pragma("unroll") for (int rep_ = 0; rep_ < NREP(8); ++rep_) { moe_route_mfma(F, args); if (BOTH(8)) GRID_BAR(); }
    if (IN(9)) _Pragma("unroll") for (int rep_ = 0; rep_ < NREP(9); ++rep_) { moe_assign(F, args); if (BOTH(9)) GRID_BAR(); }
    if (IN(10)) _Pragma("unroll") for (int rep_ = 0; rep_ < NREP(10); ++rep_) {
        const int nT = __builtin_amdgcn_readfirstlane(*WSP(const int, WS_NT));
        pg8::Gemm g{WSP(bf16, WS_XB8), nullptr, D / 2, D / 2, D / 2};
        pg8::MoeUpOrder S{nT, F.G, vid, WSP(const int, WS_TOK), WSP(const unsigned, WS_TILEE), WSP(bf16, WS_WGU8)};
        pg8::EpiMoeUp E{WSP(const int, WS_TOK), (const float*)(F.ws + WS_META + 512 * 1024), WSP(const float, WS_MRS), WSP(bf16, WS_HID), WSP(const float, WS_XS8), WSP(const float, WS_CSU)};
        pg8::gemm_phase<pg8::EpiMoeUp, pg8::MoeUpOrder, true>(F.lds + RING_OFF, g, S, E);
        if (BOTH(10)) GRID_BAR();
    }
    if (IN(11)) _Pragma("unroll") for (int rep_ = 0; rep_ < NREP(11); ++rep_) {
        const int nT = __builtin_amdgcn_readfirstlane(*WSP(const int, WS_NT));
        pg8::Gemm g{WSP(bf16, WS_HID), nullptr, 256, 128, 256};
        pg8::MoeDownOrder S{nT, F.G, vid, WSP(const unsigned, WS_TILEE), WSP(bf16, WS_WD)};
        pg8::EpiMoeDown E{WSP(const int, WS_TOK), WSP(bf16, WS_H2), F.out, WSP(float, WS_NT + 4096)};
        pg8::gemm_phase<pg8::EpiMoeDown, pg8::MoeDownOrder>(F.lds + RING_OFF, g, S, E);
    }
#undef IN
#undef BOTH
#undef GRID_BAR
}

extern "C" void kernel_launch(void* const* d_in, const int* in_sizes, int n_in, void* d_out, int out_size, void* d_ws, size_t ws_size, hipStream_t stream) {
    static int grid = 0;
    if (grid == 0) {
        if (n_in != 20 || in_sizes[0] != M * D || out_size != M * D || ws_size < WS_END) { fprintf(stderr, "kernel_launch: unexpected shapes (n_in %d, in0 %d, out %d, ws %zu); nothing launched\n", n_in, n_in > 0 ? in_sizes[0] : -1, out_size, ws_size); grid = -1; return; }
        int dev = 0, cus = 0, per_cu = 0;
        if (hipGetDevice(&dev) != hipSuccess || hipDeviceGetAttribute(&cus, hipDeviceAttributeMultiprocessorCount, dev) != hipSuccess) { grid = -1; return; }
        if (hipFuncSetAttribute((const void*)fwd, hipFuncAttributeMaxDynamicSharedMemorySize, LDS_BYTES) != hipSuccess) { fprintf(stderr, "kernel_launch: hipFuncSetAttribute failed\n"); grid = -1; return; }
        if (hipOccupancyMaxActiveBlocksPerMultiprocessor(&per_cu, (const void*)fwd, NWAVES * 64, LDS_BYTES) != hipSuccess || per_cu < 1) fprintf(stderr, "kernel_launch: occupancy query says %d\n", per_cu);
        (void)hipGetLastError();
        grid = cus;
        if (grid > 256) grid = 256;
        if (grid != 256 || per_cu < 1) { fprintf(stderr, "kernel_launch: needs 256 resident workgroups (the merge epilogue's panel exchange); nothing launched\n"); grid = -1; return; }
    }
    if (grid < 0) return;
    if (hipMemsetAsync((char*)d_ws + WS_CTL, 0, CTL_ZERO_BYTES, stream) != hipSuccess) return;
    Args a{};
    for (int i = 0; i < 20; ++i) a.in[i] = (const float*)d_in[i];
    a.out = (float*)d_out; a.ws = (unsigned char*)d_ws;
#if MK_SPLIT
    for (int p = 0; p < NPHASE; ++p) for (int rep = 0; rep < ((p == REP_PHASE) ? 2 : 1); ++rep) { a.ph_lo = p; a.ph_hi = p + 1; a.flag = rep ? PROBE_FLAG : 0; hipLaunchKernelGGL(fwd, dim3(grid), dim3(NWAVES * 64), LDS_BYTES, stream, a); }
#else
    a.ph_lo = 0; a.ph_hi = NPHASE; hipLaunchKernelGGL(fwd, dim3(grid), dim3(NWAVES * 64), LDS_BYTES, stream, a);
#endif
}
```

```cpp
#include <hip/hip_runtime.h>
#include <cstdio>
#include <cstdint>
#include <cmath>
#define MK_SPLIT 0
namespace pg8 {
#define PG8_LAS __attribute__((address_space(3)))
typedef unsigned short bf16_t;
typedef short bf16x8 __attribute__((ext_vector_type(8)));
typedef float f32x4 __attribute__((ext_vector_type(4)));
typedef unsigned u32x4 __attribute__((ext_vector_type(4)));
typedef int i32x4 __attribute__((ext_vector_type(4)));
constexpr int BM = 256, BK = 64, HALF = 128, HTB = HALF * BK * 2  , STAGE_BYTES = 8 * HTB, NXCD = 8, WGM = 8;

__host__ __device__ __forceinline__ int lds_byte(int r, int c) { const int st = (r >> 4) * 2 + (c >> 5), rr = r & 15, cc = c & 31, ob = rr * 64 + cc * 2; return st * 1024 + (ob ^ (((ob >> 9) & 1) << 5)); }
__host__ __device__ __forceinline__ void stage_rc(int b, int& R, int& C) { const int st = b / 1024, sb = b % 1024, swz = sb ^ (((sb >> 9) & 1) << 5); R = (st >> 1) * 16 + swz / 64; C = (st & 1) * 32 + (swz % 64) / 2; }
__host__ __device__ __forceinline__ int perm32(int rho) { const int n = rho >> 4, i = rho & 15; return 8 * (i >> 2) + 4 * n + (i & 3); }

struct Unit { int pm, pn, sel; };
struct Gemm { const bf16_t* A; const bf16_t* Bt; int lda, ldb, K; int nomma = 0; };

__host__ __device__ __forceinline__ void tile_of(int wgid, int nM, int nN, int& pm, int& pn) {
    const int nwg = nM * nN;
    { const int q = nwg / NXCD, r = nwg % NXCD, xcd = wgid % NXCD, off = wgid / NXCD; wgid = (xcd < r ? xcd * (q + 1) : r * (q + 1) + (xcd - r) * q) + off; }
    const int nig = WGM * nN, gid = wgid / nig, fm = gid * WGM, gsz = (nM - fm) < WGM ? (nM - fm) : WGM;
    pm = fm + ((wgid % nig) % gsz); pn = (wgid % nig) / gsz;
}
struct StaticOrder {
    static constexpr bool GATHER = false, SPLITB = false;
    int nM, nN, nwg, G, c;
    __host__ __device__ void init(int M, int N, int G_, int c_) { nM = M / BM; nN = N / BM; nwg = nM * nN; G = G_; c = c_; }
    __host__ __device__ bool next(int i, Unit& u) const {
        const long L = (long)i * G + c; if (L >= nwg) return false;
        tile_of((int)L, nM, nN, u.pm, u.pn); u.sel = 0; return true;
    }
    __device__ __forceinline__ const char* baseA(const Gemm& g, const Unit& u) const { return (const char*)g.A + (size_t)u.pm * BM * g.lda * 2; }
    __device__ __forceinline__ const char* baseB(const Gemm& g, const Unit& u) const { return (const char*)g.Bt + (size_t)u.pn * BM * g.ldb * 2; }
};

typedef float f32x2_t __attribute__((ext_vector_type(2))); typedef __bf16 bf16x2_t __attribute__((ext_vector_type(2)));
__device__ __forceinline__ unsigned cvt_pk_bf16(float lo, float hi) { const f32x2_t v = {lo, hi}; const bf16x2_t b = __builtin_convertvector(v, bf16x2_t); return __builtin_bit_cast(unsigned, b); }

template <class Epi, class Sched, bool I8 = false>
__device__ __forceinline__ void gemm_phase(PG8_LAS unsigned char* lds, const Gemm g, const Sched& S, const Epi& E) {
    const int tid = threadIdx.x, wid = __builtin_amdgcn_readfirstlane(tid >> 6), lane = tid & 63, wr = wid >> 2, wc = wid & 3, fr = lane & 15, fq = lane >> 4;
    const int K = g.K, nt = K / BK;
    unsigned voffA[2][2], voffN[2][2], voffB[2]; int RA_[2], CA_[2];
#pragma unroll
    for (int i = 0; i < 2; ++i) { int R, C; stage_rc(tid * 16 + i * 8192, R, C); const int Rb = Epi::PERM ? ((R & ~31) + perm32(R & 31)) : R; RA_[i] = R; CA_[i] = C;
        voffB[i] = (unsigned)(Rb * g.ldb + C) * 2u;
#pragma unroll
        for (int h = 0; h < 2; ++h) { voffA[h][i] = (unsigned)((R + h * HALF) * g.lda + C) * 2u; voffN[h][i] = voffA[h][i]; } }
    const size_t kstep = (size_t)(BK * 2);
    const size_t hstepB = (size_t)HALF * g.ldb * 2;
    const unsigned ldsw = (unsigned)wid * 1024u;
    const int aoff = lds_byte(wr * 64 + fr, fq * 8), boff = lds_byte(wc * 32 + fr, fq * 8);
#define PG8_SA(b, h) (((b) * 2 + (h)) * HTB)
#define PG8_SB(b, h) ((4 + (b) * 2 + (h)) * HTB)
#define PG8_STAGE(bufoff, gbase, voff) do { _Pragma("unroll") for (int _i = 0; _i < 2; ++_i) \
        __builtin_amdgcn_global_load_lds((const unsigned*)((const char*)(gbase) + (voff)[_i]), (PG8_LAS unsigned*)(lds + (bufoff) + ldsw + _i * 8192), 16, 0, 0); } while (0)
#define PG8_LDA(dst, b, h) do { _Pragma("unroll") for (int m = 0; m < 4; ++m) _Pragma("unroll") for (int k = 0; k < 2; ++k) dst[m][k] = *(const PG8_LAS bf16x8*)(lds + PG8_SA(b, h) + aoff + m * 2048 + k * 1024); } while (0)
#define PG8_LDB(dst, b, h) do { _Pragma("unroll") for (int n = 0; n < 2; ++n) _Pragma("unroll") for (int k = 0; k < 2; ++k) dst[n][k] = *(const PG8_LAS bf16x8*)(lds + PG8_SB(b, h) + boff + n * 2048 + k * 1024); } while (0)
#ifdef PROBE_NOMMA
#define PG8_MMA_GUARD if (!g.nomma)
#else
#define PG8_MMA_GUARD
#endif
#define PG8_MMA(ai, bj, At, Bt) PG8_MMA_GUARD do { __builtin_amdgcn_s_setprio(1); _Pragma("unroll") for (int m = 0; m < 4; ++m) _Pragma("unroll") for (int n = 0; n < 2; ++n) _Pragma("unroll") for (int k = 0; k < 2; ++k) { \
        if constexpr (I8) acc[ai][bj][m][n] = __builtin_bit_cast(f32x4, __builtin_amdgcn_mfma_i32_16x16x64_i8(__builtin_bit_cast(i32x4, Bt[n][k]), __builtin_bit_cast(i32x4, At[m][k]), __builtin_bit_cast(i32x4, acc[ai][bj][m][n]), 0, 0, 0)); \
        else acc[ai][bj][m][n] = __builtin_amdgcn_mfma_f32_16x16x32_bf16(Bt[n][k], At[m][k], acc[ai][bj][m][n], 0, 0, 0); } __builtin_amdgcn_s_setprio(0); } while (0)
#define PG8_WAIT_V(n) asm volatile("s_waitcnt vmcnt(" #n ")" ::: "memory")
#define PG8_WAIT_L(n) asm volatile("s_waitcnt lgkmcnt(" #n ")" ::: "memory")
#define PG8_WAIT_VE() PG8_WAIT_V(8)
#define PG8_BAR __builtin_amdgcn_s_barrier()
#define PG8_SCHED __builtin_amdgcn_sched_barrier(0)
#define PG8_GATHER(dst, u) do { if constexpr (Sched::GATHER) { _Pragma("unroll") for (int _h = 0; _h < 2; ++_h) _Pragma("unroll") for (int _i = 0; _i < 2; ++_i) \
        dst[_h][_i] = (unsigned)S.row(u, _h * HALF + RA_[_i]) * (unsigned)(g.lda * 2) + (unsigned)(CA_[_i] * 2); } } while (0)
    Unit cur, nxt, nn; int ui = 0, en = 0;
    if (!S.next(0, cur)) return;
    bool has_next = S.next(1, nxt);
    f32x4 acc[2][2][4][2];
#pragma unroll
    for (int a = 0; a < 2; ++a)
#pragma unroll
        for (int b = 0; b < 2; ++b)
#pragma unroll
            for (int m = 0; m < 4; ++m)
#pragma unroll
                for (int n = 0; n < 2; ++n) acc[a][b][m][n] = (f32x4){0.f, 0.f, 0.f, 0.f};
    bf16x8 At[4][2], B0[2][2], B1[2][2];
    const char* cA = S.baseA(g, cur); const char* cB = S.baseB(g, cur);
    PG8_GATHER(voffA, cur);
    if constexpr (Sched::GATHER) { if (has_next) { PG8_GATHER(voffN, nxt); } else {
#pragma unroll
        for (int h = 0; h < 2; ++h)
#pragma unroll
            for (int i = 0; i < 2; ++i) voffN[h][i] = voffA[h][i]; } }
    PG8_STAGE(PG8_SB(0, 0), cB, voffB); PG8_STAGE(PG8_SB(0, 1), cB + hstepB, voffB); PG8_STAGE(PG8_SA(0, 0), cA, voffA[0]); PG8_STAGE(PG8_SA(0, 1), cA, voffA[1]);
    if (wr == 1) PG8_BAR;
    PG8_WAIT_V(2); PG8_BAR;
    PG8_STAGE(PG8_SB(1, 0), cB + kstep, voffB); PG8_STAGE(PG8_SA(1, 0), cA + kstep, voffA[0]); PG8_STAGE(PG8_SB(1, 1), cB + hstepB + kstep, voffB);
    PG8_WAIT_V(6); PG8_BAR;
    for (;;) {
        const char* nA = has_next ? S.baseA(g, nxt) : cA; const char* nB = has_next ? S.baseB(g, nxt) : cB;
        const char* cB2 = cB; if constexpr (Sched::SPLITB) cB2 = S.baseB2(g, cur);
        for (int t = 0; t < nt; t += 2) {
            const bool last = (t == nt - 2);
            const char* a1 = cA + (size_t)(t + 1) * kstep;
            const char* a2 = last ? nA : cA + (size_t)(t + 2) * kstep;
            const char* b2 = last ? nB : (Sched::SPLITB ? cB2 + (size_t)t * kstep : cB + (size_t)(t + 2) * kstep);
            const char* a3 = a2 + kstep; const char* b3 = b2 + kstep;
            unsigned v2[2][2];
#pragma unroll
            for (int h = 0; h < 2; ++h)
#pragma unroll
                for (int i = 0; i < 2; ++i) v2[h][i] = (Sched::GATHER && last) ? voffN[h][i] : voffA[h][i];
            PG8_LDB(B0, 0, 0); PG8_LDB(B1, 0, 1); PG8_SCHED; PG8_LDA(At, 0, 0); PG8_STAGE(PG8_SA(1, 1), a1, voffA[1]);
            PG8_WAIT_VE(); PG8_WAIT_L(0); PG8_BAR; PG8_MMA(0, 0, At, B0); PG8_MMA(0, 1, At, B1); PG8_BAR; PG8_SCHED;
            PG8_LDA(At, 0, 1); PG8_STAGE(PG8_SB(0, 0), b2, voffB); PG8_STAGE(PG8_SB(0, 1), b2 + hstepB, voffB); PG8_STAGE(PG8_SA(0, 0), a2, v2[0]);
            PG8_WAIT_VE(); PG8_WAIT_L(0); PG8_BAR; PG8_MMA(1, 0, At, B0); PG8_MMA(1, 1, At, B1); PG8_BAR; PG8_SCHED;
            PG8_LDB(B0, 1, 0); PG8_LDB(B1, 1, 1); PG8_SCHED; PG8_LDA(At, 1, 0); PG8_STAGE(PG8_SA(0, 1), a2, v2[1]);
            PG8_WAIT_V(8); PG8_WAIT_L(0); PG8_BAR; PG8_MMA(0, 0, At, B0); PG8_MMA(0, 1, At, B1); PG8_BAR; PG8_SCHED;
            PG8_LDA(At, 1, 1); PG8_STAGE(PG8_SB(1, 0), b3, voffB); PG8_STAGE(PG8_SB(1, 1), b3 + hstepB, voffB); PG8_STAGE(PG8_SA(1, 0), a3, v2[0]);
            PG8_WAIT_V(8); PG8_WAIT_L(0); PG8_BAR; PG8_MMA(1, 0, At, B0); PG8_MMA(1, 1, At, B1); PG8_BAR; PG8_SCHED;
        }
        const bool has_nn = has_next && S.next(ui + 2, nn);
        int trow[2][2];
        if constexpr (Sched::GATHER) { if (has_nn) {
#pragma unroll
            for (int h = 0; h < 2; ++h)
#pragma unroll
                for (int i = 0; i < 2; ++i) trow[h][i] = S.row(nn, h * HALF + RA_[i]); } }
        if (wr == 0) PG8_BAR;
        en = __builtin_amdgcn_readfirstlane(E(acc, cur, wr, wc, fr, fq));
        if (!has_next) break;
        if (!(Epi::CARRY && cur.sel == 0)) {
#pragma unroll
        for (int a = 0; a < 2; ++a)
#pragma unroll
            for (int b = 0; b < 2; ++b)
#pragma unroll
                for (int m = 0; m < 4; ++m)
#pragma unroll
                    for (int n = 0; n < 2; ++n) acc[a][b][m][n] = (f32x4){0.f, 0.f, 0.f, 0.f};
        }
        cur = nxt; cA = nA; cB = nB; ++ui; nxt = nn; has_next = has_nn;
        if constexpr (Sched::GATHER) {
#pragma unroll
            for (int h = 0; h < 2; ++h)
#pragma unroll
                for (int i = 0; i < 2; ++i) { voffA[h][i] = voffN[h][i]; if (has_nn) voffN[h][i] = (unsigned)trow[h][i] * (unsigned)(g.lda * 2) + (unsigned)(CA_[i] * 2); } }
        if (wr == 1) PG8_BAR;
    }
    PG8_WAIT_V(0);
    PG8_BAR;
#undef PG8_SA
#undef PG8_SB
#undef PG8_STAGE
#undef PG8_LDA
#undef PG8_LDB
#undef PG8_MMA
#undef PG8_WAIT_V
#undef PG8_WAIT_L
#undef PG8_WAIT_VE
#undef PG8_BAR
#undef PG8_SCHED
#undef PG8_GATHER
}
}
constexpr int NWAVES = 8;
constexpr int BATCH = 16, SEQ = 4096, D = 1024, M = BATCH * SEQ;
constexpr int CH = 64, NCH = SEQ / CH, NCHUNK = M / CH;
constexpr int NP = 5632;
constexpr float EPS = 1e-6f;
constexpr float LOG2E = 1.4426950408889634f;
constexpr int L_QA = 0, L_KA = 256, L_VA = 512, L_RA = 1024, L_ALR = 1536, L_QB = 1552, L_KB = 2064, L_VB = 2576, L_QI = 3088, L_KI = 3344, L_WI = 3376, L_GA = 3384, L_GB = 4408, D_IN = 5432;
constexpr int NEXP = 32, DEXP = 128, NCLASS = 112;

constexpr size_t MiB = 1u << 20;
constexpr size_t WS_CTL = 0, CTL_ZERO_BYTES = 1 * MiB;
constexpr size_t WS_WIN = 2 * MiB;
constexpr size_t WS_WA = 13 * MiB;
constexpr size_t WS_WB = 14 * MiB;
constexpr size_t WS_WO = 15 * MiB;
constexpr size_t WS_WGU = 17 * MiB;
constexpr size_t WS_WD = 33 * MiB;
constexpr size_t WS_META = 41 * MiB;
constexpr size_t WS_WR = 43 * MiB;
constexpr size_t WS_MRS = 44 * MiB;
constexpr size_t WS_TOK = 42 * MiB;
constexpr size_t WS_R0 = 48 * MiB;
constexpr size_t WS_HN = WS_R0, WS_KDT = WS_R0, WS_MASK = WS_R0 + 32 * MiB, WS_MIXED = WS_R0;
constexpr size_t WS_QA = 176 * MiB, WS_KA = 208 * MiB, WS_VA = 240 * MiB, WS_RA = 304 * MiB, WS_QB = 368 * MiB, WS_KB = 432 * MiB, WS_VB = 496 * MiB, WS_QI = 560 * MiB;
constexpr size_t WS_KI = 592 * MiB, WS_WI = 596 * MiB, WS_ALR = 598 * MiB, WS_DEC = 602 * MiB;
constexpr size_t WS_GA = 608 * MiB, WS_GB = 736 * MiB, WS_OCAT = 864 * MiB, WS_END = 992 * MiB;
constexpr size_t WS_HN8 = 672 * MiB;
constexpr size_t WS_WIN8 = 800 * MiB;
constexpr size_t WS_RS8 = 808 * MiB, WS_CS8 = 809 * MiB;
constexpr size_t WS_WGU8 = 812 * MiB, WS_CSU = 820 * MiB;
constexpr size_t WS_XB8 = WS_R0, WS_XS8 = WS_R0 + 64 * MiB;
constexpr size_t WS_WO8 = 821 * MiB, WS_CSO = 822 * MiB;
constexpr size_t WS_MIX8 = 368 * MiB, WS_MS8 = 432 * MiB;
constexpr size_t WS_SLOT1 = 824 * MiB, WS_SLOT2 = 826 * MiB;
constexpr size_t WS_H2 = 176 * MiB;
constexpr size_t WS_HID = 304 * MiB;
constexpr int CW_TMO = 0, CW_CODE = 1;
constexpr int CW_BAR = 4096;
constexpr int CW_XRANK = 9216;
constexpr int CW_ATTQ = 8448;
constexpr int CW_CMAX = 16384;
constexpr int CW_ROWMAX2 = 131072;
constexpr int CW_PCNT = 196608;
constexpr int CW_ROWMAX = 65536;
constexpr int CW_CLS = 8192;

constexpr int RING_OFF = 0, RING_BYTES = 131072;
constexpr int LDSCTL_OFF = RING_BYTES, MISC_OFF = LDSCTL_OFF + 320;
constexpr int XTRA_OFF = RING_BYTES + 1024;
constexpr int LDS_BYTES = 147456;

#define GAS __attribute__((address_space(1)))
#define LAS __attribute__((address_space(3)))
typedef unsigned short bf16;
typedef unsigned v4u __attribute__((ext_vector_type(4)));
typedef unsigned v2u __attribute__((ext_vector_type(2)));
typedef float f32x4 __attribute__((ext_vector_type(4)));
typedef float f32x16 __attribute__((ext_vector_type(16)));
typedef short bf16x8 __attribute__((ext_vector_type(8)));
typedef GAS unsigned gu32;
#define RLX_AGENT __ATOMIC_RELAXED, __HIP_MEMORY_SCOPE_AGENT
#define LDS_WAIT() asm volatile("s_waitcnt lgkmcnt(0)" ::: "memory")
#define VM_WAIT() asm volatile("s_waitcnt vmcnt(0)" ::: "memory")
__device__ __forceinline__ unsigned f2bf(float f) { unsigned u = __builtin_bit_cast(unsigned, f); return (u + 0x7fffu + ((u >> 16) & 1u)) >> 16; }
__device__ __forceinline__ unsigned pk2(float lo, float hi) { return f2bf(lo) | (f2bf(hi) << 16); }
__device__ __forceinline__ float bf2f(unsigned short b) { return __builtin_bit_cast(float, ((unsigned)b) << 16); }
__device__ __forceinline__ float bflo(unsigned w) { return __builtin_bit_cast(float, w << 16); }
__device__ __forceinline__ float bfhi(unsigned w) { return __builtin_bit_cast(float, w & 0xffff0000u); }
__device__ __forceinline__ float fast_exp2(float x) { return __builtin_amdgcn_exp2f(x); }
__device__ __forceinline__ float sigmoidf_(float x) { return __builtin_amdgcn_rcpf(1.0f + __builtin_amdgcn_exp2f(-x * LOG2E)); }
__device__ __forceinline__ float siluf_(float x) { return x * sigmoidf_(x); }

#define XB_TMO      128
#define XB_XCNT(j)  (256  + 64 * (j))
#define XB_XSUB(j)  (1280 + 64 * (j))
#define XB_XGEN(j)  (2304 + 64 * (j))
#define XB_TOP      3328
#define XB_TOPGEN   3392
#define XCD_BAR_WORDS 3456
#define XB_SPIN_CAP (1u << 18)
__device__ __forceinline__ unsigned xb_ld(unsigned* p)              { return __hip_atomic_load(p, __ATOMIC_RELAXED, __HIP_MEMORY_SCOPE_AGENT); }
__device__ __forceinline__ unsigned xb_add(unsigned* p, unsigned v) { return __hip_atomic_fetch_add(p, v, __ATOMIC_RELAXED, __HIP_MEMORY_SCOPE_AGENT); }
__device__ __forceinline__ unsigned xb_xcc_id() { return (unsigned)__builtin_amdgcn_s_getreg((3 << 11) | 20) & 0xFu; }
#define XB_SPIN(cond, bar) do { unsigned _sp = 0; while (cond) { __builtin_amdgcn_s_sleep(1); \
    if ((++_sp & 255u) == 0u) { if (xb_ld(&(bar)[XB_TMO])) break; if (_sp > XB_SPIN_CAP) { atomicAdd(&(bar)[XB_TMO], 1u); break; } } } } while (0)
struct XcdBarrier { unsigned* bar; unsigned x; volatile LAS unsigned* st; };
__device__ __forceinline__ XcdBarrier xcd_barrier_post(unsigned* bar, volatile LAS unsigned* st) {
    XcdBarrier b; b.bar = bar; b.x = xb_xcc_id(); b.st = st;
    if (threadIdx.x == 0) (void)xb_add(&bar[XB_XCNT(b.x)], 1u);
    return b;
}
__device__ __forceinline__ void xcd_barrier_complete(unsigned* bar, unsigned x, unsigned& nloc, unsigned& nx) {
    const unsigned G = gridDim.x * gridDim.y * gridDim.z;
    unsigned sum, cnt, mine, sp = 0u;
    for (;;) {
        sum = 0u; cnt = 0u; mine = 0u;
#pragma unroll
        for (unsigned j = 0; j < 16; ++j) { const unsigned c = xb_ld(&bar[XB_XCNT(j)]); sum += c; cnt += (c > 0u) ? 1u : 0u; mine = (j == x) ? c : mine; }
        if (sum == G) break;
        __builtin_amdgcn_s_sleep(1);
        if ((++sp & 255u) == 0u) { if (xb_ld(&bar[XB_TMO])) break; if (sp > XB_SPIN_CAP) { atomicAdd(&bar[XB_TMO], 1u); break; } }
    }
    nloc = mine > 0u ? mine : 1u; nx = cnt > 0u ? cnt : 1u;
}
__device__ __forceinline__ void xcd_barrier(const XcdBarrier& b) {
    asm volatile("s_waitcnt vmcnt(0)" ::: "memory");
    __syncthreads();
    if (threadIdx.x == 0) {
        unsigned* bar = b.bar;
        __builtin_amdgcn_s_waitcnt(0);
        unsigned nloc = b.st[0], nx = b.st[1];
        if (nloc == 0u) { xcd_barrier_complete(bar, b.x, nloc, nx); b.st[0] = nloc; b.st[1] = nx; }
        const unsigned old = xb_add(&bar[XB_XSUB(b.x)], 1u);
        const unsigned gen = old / nloc;
        if (old + 1u == (gen + 1u) * nloc) {
            __builtin_amdgcn_fence(__ATOMIC_RELEASE, "agent");
            asm volatile("s_waitcnt vmcnt(0)" ::: "memory");
            const unsigned og = xb_add(&bar[XB_TOP], 1u);
            const unsigned tg = og / nx;
            if (og + 1u == (tg + 1u) * nx) xb_add(&bar[XB_TOPGEN], 1u);
            else XB_SPIN(xb_ld(&bar[XB_TOPGEN]) == tg, bar);
            __builtin_amdgcn_fence(__ATOMIC_ACQUIRE, "agent");
            xb_add(&bar[XB_XGEN(b.x)], 1u);
            asm volatile("s_waitcnt vmcnt(0)" ::: "memory");
        } else {
            XB_SPIN(xb_ld(&bar[XB_XGEN(b.x)]) == gen, bar);
            __builtin_amdgcn_fence(__ATOMIC_ACQUIRE, "agent");
            asm volatile("s_waitcnt vmcnt(0)" ::: "memory");
        }
    }
    __syncthreads();
}

struct Args { const float* in[20]; float* out; unsigned char* ws; int ph_lo, ph_hi, flag, pad; };
struct Frame {
    LAS unsigned char* lds;
    volatile LAS unsigned* MISC;
    gu32* ctl;
    int tid, lane, wave;
    int vcu, G;
    float* out; unsigned char* ws;
};
#define IN_X 0
#define IN_GMIX 1
#define IN_WIN 2
#define IN_WA2 3
#define IN_BA 4
#define IN_GGLA 5
#define IN_WBRG 6
#define IN_GQ 7
#define IN_GK 8
#define IN_RELB 9
#define IN_WBRA 10
#define IN_WOUT 11
#define IN_GFFN 12
#define IN_WRG 13
#define IN_BRG 14
#define IN_WRE 15
#define IN_BRE 16
#define IN_WGATE 17
#define IN_WUP 18
#define IN_WDOWN 19
#define WSP(T, off) ((T*)(F.ws + (off)))

__device__ __forceinline__ float wave_sum(float v) {
#pragma unroll
    for (int o = 1; o < 64; o <<= 1) v += __shfl_xor(v, o);
    return v;
}
__device__ __forceinline__ float wave_max(float v) {
#pragma unroll
    for (int o = 1; o < 64; o <<= 1) v = fmaxf(v, __shfl_xor(v, o));
    return v;
}
__device__ __forceinline__ void win_map(int p, int& c, float& s) {
    const int tile = p >> 8, j = p & 255; s = 1.f;
    if (tile == 0) { c = L_QA + j; s = 0.125f; }
    else if (tile == 1) c = L_KA + j;
    else if (tile < 4) c = L_VA + (p - 512);
    else if (tile < 6) c = L_RA + (p - 1024);
    else if (tile < 10) {
        const int pl = (p - 1536) & 511, t2 = pl >> 8, jj = pl & 255, bj = jj >> 7, wc = (jj >> 5) & 3, x = jj & 31;
        c = (tile < 8 ? L_QB : L_KB) + t2 * 256 + 64 * wc + 32 * bj + x;
    }
    else if (tile < 12) c = L_VB + (p - 2560);
    else if (tile == 12) c = L_QI + j;
    else if (tile == 13) { if (j < 32) c = L_KI + j; else if (j < 40) { c = L_WI + (j - 32); s = 0.0625f; } else if (j < 56) c = L_ALR + (j - 40); else c = -1; }
    else {
        const int pl = (p - 3584) & 1023, t4 = pl >> 8, jj = pl & 255, bj = jj >> 7, wc = (jj >> 5) & 3, fq = (jj >> 3) & 3, j2 = jj & 7;
        c = (tile < 18 ? L_GA : L_GB) + t4 * 256 + 64 * wc + 16 * fq + 8 * bj + j2;
    }
}
#ifndef G1_NBF
#define G1_NBF 0
#endif
__host__ __device__ __forceinline__ int g1_tile(int set, int j) {
#if G1_NBF == 8
    return set ? (j < 4 ? j + 2 : (j < 6 ? j + 6 : j + 8)) : (j < 2 ? j : (j < 6 ? j + 4 : j + 6));
#elif G1_NBF == 2
    return set ? (j < 12 ? j : j + 2) : 12 + j;
#else
    return j;
#endif
}
__device__ __forceinline__ bool win_is8(int tile) {
#if G1_NBF == 8
    return (tile >= 2 && tile < 6) || tile == 10 || tile == 11 || tile >= 14;
#elif G1_NBF == 2
    return tile != 12 && tile != 13;
#else
    return true;
#endif
}
template <int MAP>
__device__ __forceinline__ void p0_transpose_item(const float* W, int K, int N, bf16* WT, int row_off, int nrows, LAS float* scr, int item, int lane, const float* ksc = nullptr, gu32* cmax = nullptr) {
    const int nblk = nrows / 32, kb = item / nblk, nb = item % nblk, k0 = 64 * kb, n0 = 32 * nb;
    const int c4 = lane & 7, kk8 = lane >> 3;
    int c = n0 + 4 * c4; float s = 1.f;
    if (MAP == 1) win_map(n0 + 4 * c4, c, s);
#pragma unroll
    for (int i = 0; i < 8; ++i) { const int kk = 8 * i + kk8; f32x4 v = {0.f, 0.f, 0.f, 0.f};
        if (c >= 0) v = *(const GAS f32x4*)(W + (size_t)(k0 + kk) * N + c) * (ksc ? s * ksc[k0 + kk] : s);
        LAS float* d = scr + kk * 33 + 4 * c4; d[0] = v.x; d[1] = v.y; d[2] = v.z; d[3] = v.w; }
    LDS_WAIT(); asm volatile("" ::: "memory");
    if (cmax) { if (MAP == 0 || win_is8(n0 >> 8)) {
        float mx = 0.f;
#pragma unroll 8
        for (int i = 0; i < 32; ++i) mx = fmaxf(mx, fabsf(scr[(2 * i + (lane >> 5)) * 33 + (lane & 31)]));
        mx = fmaxf(mx, __shfl_xor(mx, 32));
        if (lane < 32) __hip_atomic_fetch_max(cmax + row_off + n0 + lane, f2bf(mx) << 16, RLX_AGENT); } }
    const int ch = lane & 7;
#pragma unroll
    for (int j = 0; j < 4; ++j) { const int n = (lane >> 3) + 8 * j; const LAS float* sp = scr + (8 * ch) * 33 + n;
        v4u o; o.x = pk2(sp[0 * 33], sp[1 * 33]); o.y = pk2(sp[2 * 33], sp[3 * 33]); o.z = pk2(sp[4 * 33], sp[5 * 33]); o.w = pk2(sp[6 * 33], sp[7 * 33]);
        *(GAS v4u*)(WT + (size_t)(row_off + n0 + n) * K + k0 + 8 * ch) = o; }
    LDS_WAIT(); asm volatile("" ::: "memory");
}
__device__ __forceinline__ void rms_row_to_bf16(const float* xrow, const float* g, bf16* orow, int lane) {
    const GAS f32x4* xr = (const GAS f32x4*)xrow + lane; const GAS f32x4* gr = (const GAS f32x4*)g + lane;
    f32x4 v[4]; float s = 0.f;
#pragma unroll
    for (int j = 0; j < 4; ++j) { v[j] = xr[64 * j]; s += (v[j].x * v[j].x + v[j].y * v[j].y) + (v[j].z * v[j].z + v[j].w * v[j].w); }
    const float rs = 1.0f / sqrtf(wave_sum(s) * (1.f / D) + EPS);
    GAS unsigned long long* o8 = (GAS unsigned long long*)orow + lane;
#pragma unroll
    for (int j = 0; j < 4; ++j) { const f32x4 gg = gr[64 * j]; o8[64 * j] = (unsigned long long)pk2(v[j].x * rs * gg.x, v[j].y * rs * gg.y) | ((unsigned long long)pk2(v[j].z * rs * gg.z, v[j].w * rs * gg.w) << 32); }
}
__device__ __forceinline__ void p0_prologue(Frame& F, const Args& A) {
    LAS float* scr = (LAS float*)(F.lds + RING_OFF + F.wave * 16384);
    const int gw = F.vcu * NWAVES + F.wave, NGW = F.G * NWAVES;
    constexpr int I_IN = (D / 64) * (NP / 32);
    constexpr int I_AB = (512 / 64) * (D / 32);
    constexpr int I_O = (D / 64) * (D / 32);
    constexpr int I_GU = (D / 64) * (DEXP / 32);
    constexpr int I_DN = (DEXP / 64) * (D / 32);
    constexpr int NITEMS = I_IN + 2 * I_AB + I_O + NEXP * (2 * I_GU + I_DN);
    for (int it = gw; it < NITEMS; it += NGW) {
        int r = it;
        if (r < I_IN) { p0_transpose_item<1>(A.in[IN_WIN], D, D_IN, WSP(bf16, WS_WIN), 0, NP, scr, r, F.lane, nullptr, F.ctl + CW_CMAX); continue; } r -= I_IN;
        if (r < I_AB) { p0_transpose_item<0>(A.in[IN_WBRG], 512, D, WSP(bf16, WS_WA), 0, D, scr, r, F.lane); continue; } r -= I_AB;
        if (r < I_AB) { p0_transpose_item<0>(A.in[IN_WBRA], 512, D, WSP(bf16, WS_WB), 0, D, scr, r, F.lane); continue; } r -= I_AB;
        if (r < I_O) { p0_transpose_item<0>(A.in[IN_WOUT], D, D, WSP(bf16, WS_WO), 0, D, scr, r, F.lane, nullptr, F.ctl + CW_CMAX + NP + NEXP * 256); continue; } r -= I_O;
        const int e = r / (2 * I_GU + I_DN); r -= e * (2 * I_GU + I_DN);
        if (r < I_GU) { p0_transpose_item<0>(A.in[IN_WGATE] + (size_t)e * D * DEXP, D, DEXP, WSP(bf16, WS_WGU) + (size_t)e * 256 * D, 0, DEXP, scr, r, F.lane, A.in[IN_GFFN], F.ctl + CW_CMAX + NP + e * 256); continue; } r -= I_GU;
        if (r < I_GU) { p0_transpose_item<0>(A.in[IN_WUP] + (size_t)e * D * DEXP, D, DEXP, WSP(bf16, WS_WGU) + (size_t)e * 256 * D, 128, DEXP, scr, r, F.lane, A.in[IN_GFFN], F.ctl + CW_CMAX + NP + e * 256); continue; } r -= I_GU;
        p0_transpose_item<0>(A.in[IN_WDOWN] + (size_t)e * DEXP * D, DEXP, D, WSP(bf16, WS_WD) + (size_t)e * D * DEXP, 0, D, scr, r, F.lane);
    }
    { bf16* WRH = WSP(bf16, WS_WR); bf16* WRL = WRH + 64 * D;
      for (int i = F.vcu * 512 + F.tid; i < 64 * D; i += F.G * 512) { const int c = i >> 10, k = i & 1023;
          float v = 0.f; if (c < 4) v = A.in[IN_WRG][k * 4 + c]; else if (c < 36) v = A.in[IN_WRE][k * 32 + (c - 4)];
          v *= A.in[IN_GFFN][k]; const unsigned hb = f2bf(v); const float lo = v - __builtin_bit_cast(float, hb << 16);
          WRH[i] = (bf16)hb; WRL[i] = (bf16)f2bf(lo); } }
    for (int m = gw * 8; m < M; m += NGW * 8) {
        const GAS f32x4* gr = (const GAS f32x4*)A.in[IN_GMIX] + F.lane;
        f32x4 v[8][4]; float ss[8], am[8];
#pragma unroll
        for (int r = 0; r < 8; ++r) { const GAS f32x4* xr = (const GAS f32x4*)(A.in[IN_X] + (size_t)(m + r) * D) + F.lane; ss[r] = 0.f; am[r] = 0.f;
#pragma unroll
            for (int j = 0; j < 4; ++j) { v[r][j] = __builtin_nontemporal_load(xr + 64 * j); } }
#pragma unroll
        for (int r = 0; r < 8; ++r) {
#pragma unroll
            for (int j = 0; j < 4; ++j) ss[r] += (v[r][j].x * v[r][j].x + v[r][j].y * v[r][j].y) + (v[r][j].z * v[r][j].z + v[r][j].w * v[r][j].w);
            ss[r] = 1.0f / sqrtf(wave_sum(ss[r]) * (1.f / D) + EPS); }
#pragma unroll
        for (int j = 0; j < 4; ++j) { const f32x4 gg = gr[64 * j];
#pragma unroll
            for (int r = 0; r < 8; ++r) { GAS unsigned long long* o8 = (GAS unsigned long long*)(WSP(bf16, WS_HN) + (size_t)(m + r) * D) + F.lane; const float rs = ss[r];
                const f32x4 y = {v[r][j].x * rs * gg.x, v[r][j].y * rs * gg.y, v[r][j].z * rs * gg.z, v[r][j].w * rs * gg.w}; v[r][j] = y;
                am[r] = fmaxf(fmaxf(am[r], fmaxf(fabsf(y.x), fabsf(y.y))), fmaxf(fabsf(y.z), fabsf(y.w)));
                if (G1_NBF > 0) o8[64 * j] = (unsigned long long)pk2(y.x, y.y) | ((unsigned long long)pk2(y.z, y.w) << 32); } }
#pragma unroll
        for (int r = 0; r < 8; ++r) { const float a = wave_max(am[r]); const float inv = a > 0.f ? 127.0f / a : 0.f;
            if (F.lane == 0) WSP(float, WS_RS8)[m + r] = a * (1.0f / 127.0f);
            v4u q;
#pragma unroll
            for (int j = 0; j < 4; ++j) { unsigned b = 0u;
                b = __builtin_amdgcn_cvt_pk_u8_f32(__builtin_rintf(__builtin_fmaf(v[r][j].x, inv, 128.0f)), 0, b); b = __builtin_amdgcn_cvt_pk_u8_f32(__builtin_rintf(__builtin_fmaf(v[r][j].y, inv, 128.0f)), 1, b);
                b = __builtin_amdgcn_cvt_pk_u8_f32(__builtin_rintf(__builtin_fmaf(v[r][j].z, inv, 128.0f)), 2, b); b = __builtin_amdgcn_cvt_pk_u8_f32(__builtin_rintf(__builtin_fmaf(v[r][j].w, inv, 128.0f)), 3, b);
                q[j] = b ^ 0x80808080u; }
            *(GAS v4u*)(F.ws + WS_HN8 + (size_t)(m + r) * D + 16 * F.lane) = q; }
    }
}
__device__ __forceinline__ void p0_quant(Frame& F, const Args& A) {
    const int gw = F.vcu * NWAVES + F.wave, NGW = F.G * NWAVES;
    for (int idx = gw; idx < (22 - G1_NBF) * 256; idx += NGW) {
        const int tile = g1_tile(1, idx >> 8), p = tile * 256 + (idx & 255);
        const float a = __builtin_bit_cast(float, __hip_atomic_load(F.ctl + CW_CMAX + p, RLX_AGENT)); const float inv = a > 0.f ? 127.0f / a : 0.f;
        if (F.lane == 0) WSP(float, WS_CS8)[p] = a * (1.0f / 127.0f);
        const GAS v2u* row = (const GAS v2u*)(WSP(bf16, WS_WIN) + (size_t)p * D) + F.lane;
        v4u q;
#pragma unroll
        for (int j = 0; j < 4; ++j) { const v2u w = row[64 * j]; unsigned b = 0u;
            b = __builtin_amdgcn_cvt_pk_u8_f32(__builtin_rintf(__builtin_fmaf(bflo(w[0]), inv, 128.0f)), 0, b); b = __builtin_amdgcn_cvt_pk_u8_f32(__builtin_rintf(__builtin_fmaf(bfhi(w[0]), inv, 128.0f)), 1, b);
            b = __builtin_amdgcn_cvt_pk_u8_f32(__builtin_rintf(__builtin_fmaf(bflo(w[1]), inv, 128.0f)), 2, b); b = __builtin_amdgcn_cvt_pk_u8_f32(__builtin_rintf(__builtin_fmaf(bfhi(w[1]), inv, 128.0f)), 3, b);
            q[j] = b ^ 0x80808080u; }
        *(GAS v4u*)(F.ws + WS_WIN8 + (size_t)p * D + 16 * F.lane) = q;
    }
    for (int r = gw; r < NEXP * 256; r += NGW) {
        const float a = __builtin_bit_cast(float, __hip_atomic_load(F.ctl + CW_CMAX + NP + r, RLX_AGENT)); const float inv = a > 0.f ? 127.0f / a : 0.f;
        if (F.lane == 0) WSP(float, WS_CSU)[r] = a * (1.0f / 127.0f);
        const GAS v4u* row = (const GAS v4u*)(WSP(bf16, WS_WGU) + (size_t)r * D + 32 * (F.lane >> 1) + 8 * (F.lane & 1));
        v4u q;
#pragma unroll
        for (int c = 0; c < 2; ++c) { const v4u w = row[2 * c];
#pragma unroll
            for (int j = 0; j < 2; ++j) { unsigned b = 0u;
                b = __builtin_amdgcn_cvt_pk_u8_f32(__builtin_rintf(__builtin_fmaf(bflo(w[2 * j]), inv, 128.0f)), 0, b); b = __builtin_amdgcn_cvt_pk_u8_f32(__builtin_rintf(__builtin_fmaf(bfhi(w[2 * j]), inv, 128.0f)), 1, b);
                b = __builtin_amdgcn_cvt_pk_u8_f32(__builtin_rintf(__builtin_fmaf(bflo(w[2 * j + 1]), inv, 128.0f)), 2, b); b = __builtin_amdgcn_cvt_pk_u8_f32(__builtin_rintf(__builtin_fmaf(bfhi(w[2 * j + 1]), inv, 128.0f)), 3, b);
                q[2 * c + j] = b ^ 0x80808080u; } }
        *(GAS v4u*)(F.ws + WS_WGU8 + (size_t)r * D + 16 * F.lane) = q;
    }
    for (int r = gw; r < D; r += NGW) {
        const float a = __builtin_bit_cast(float, __hip_atomic_load(F.ctl + CW_CMAX + NP + NEXP * 256 + r, RLX_AGENT)); const float inv = a > 0.f ? 127.0f / a : 0.f;
        if (F.lane == 0) WSP(float, WS_CSO)[r] = a * (1.0f / 127.0f);
        const GAS v4u* row = (const GAS v4u*)(WSP(bf16, WS_WO) + (size_t)r * D + 256 * (F.lane >> 4) + 32 * ((F.lane >> 2) & 3) + 8 * (F.lane & 3));
        v4u q;
#pragma unroll
        for (int c = 0; c < 2; ++c) { const v4u w = row[16 * c];
#pragma unroll
            for (int j = 0; j < 2; ++j) { unsigned b = 0u;
                b = __builtin_amdgcn_cvt_pk_u8_f32(__builtin_rintf(__builtin_fmaf(bflo(w[2 * j]), inv, 128.0f)), 0, b); b = __builtin_amdgcn_cvt_pk_u8_f32(__builtin_rintf(__builtin_fmaf(bfhi(w[2 * j]), inv, 128.0f)), 1, b);
                b = __builtin_amdgcn_cvt_pk_u8_f32(__builtin_rintf(__builtin_fmaf(bflo(w[2 * j + 1]), inv, 128.0f)), 2, b); b = __builtin_amdgcn_cvt_pk_u8_f32(__builtin_rintf(__builtin_fmaf(bfhi(w[2 * j + 1]), inv, 128.0f)), 3, b);
                q[2 * c + j] = b ^ 0x80808080u; } }
        *(GAS v4u*)(F.ws + WS_WO8 + (size_t)r * D + 16 * F.lane) = q;
    }
}
namespace pg8 {
template <bool I8>
struct EpiG1 {
    static constexpr bool PERM = true, CARRY = false;
    unsigned char* ws; const float *gq, *gk; const float *RS, *CS;
    __device__ __forceinline__ int operator()(const f32x4 (&acc)[2][2][4][2], const Unit& u, int wr, int wc, int fr, int fq) const {
        { int l; asm volatile("v_mbcnt_lo_u32_b32 %0, -1, 0\n\tv_mbcnt_hi_u32_b32 %0, -1, %0" : "=v"(l)); fr = l & 15; fq = l >> 4; }
        const int pn = u.pn; const size_t row0 = (size_t)u.pm * BM + wr * 64 + fr;
        float rsc[2][4]; f32x4 csc[2][2];
        if constexpr (I8) {
#pragma unroll
            for (int ai = 0; ai < 2; ++ai)
#pragma unroll
                for (int m = 0; m < 4; ++m) rsc[ai][m] = RS[row0 + ai * HALF + m * 16];
#pragma unroll
            for (int bj = 0; bj < 2; ++bj)
#pragma unroll
                for (int n = 0; n < 2; ++n) csc[bj][n] = *(const f32x4*)(CS + pn * BM + bj * HALF + wc * 32 + 8 * fq + 4 * n);
        }
        auto DQ = [&](int ai, int bj, int m, int n) -> f32x4 {
            if constexpr (I8) return __builtin_convertvector(__builtin_bit_cast(i32x4, acc[ai][bj][m][n]), f32x4) * csc[bj][n] * rsc[ai][m];
            else return acc[ai][bj][m][n]; };
        if (pn >= 6 && pn < 10) {
            const bool isq = pn < 8; const int t2 = pn - (isq ? 6 : 8); bf16_t* out = (bf16_t*)(ws + (isq ? WS_QB : WS_KB)); const float* g = isq ? gq : gk; const float sc = isq ? 0.125f * 1.4426950408889634f : 1.0f;
            f32x4 gl[2][2];
#pragma unroll
            for (int bj = 0; bj < 2; ++bj)
#pragma unroll
                for (int n = 0; n < 2; ++n) gl[bj][n] = *(const f32x4*)(g + 32 * bj + 8 * fq + 4 * n) * sc;
#pragma unroll
            for (int ai = 0; ai < 2; ++ai)
#pragma unroll
                for (int m = 0; m < 4; ++m) {
                    float ss = 0.f; f32x4 xv[2][2];
#pragma unroll
                    for (int bj = 0; bj < 2; ++bj)
#pragma unroll
                        for (int n = 0; n < 2; ++n) { const f32x4 x = DQ(ai, bj, m, n); xv[bj][n] = x; ss += (x[0] * x[0] + x[1] * x[1]) + (x[2] * x[2] + x[3] * x[3]); }
                    ss += __shfl_xor(ss, 16); ss += __shfl_xor(ss, 32);
                    const float rs = 1.0f / sqrtf(ss * (1.0f / 64.0f) + 1e-6f);
                    bf16_t* rowp = out + (row0 + ai * HALF + m * 16) * 512 + t2 * 256 + 64 * wc + 8 * fq;
#pragma unroll
                    for (int bj = 0; bj < 2; ++bj) { const f32x4 v0 = xv[bj][0] * rs * gl[bj][0], v1 = xv[bj][1] * rs * gl[bj][1];
                        u32x4 w; w.x = cvt_pk_bf16(v0[0], v0[1]); w.y = cvt_pk_bf16(v0[2], v0[3]); w.z = cvt_pk_bf16(v1[0], v1[1]); w.w = cvt_pk_bf16(v1[2], v1[3]);
                        __builtin_nontemporal_store(w, (u32x4*)(rowp + 32 * bj)); }
                }
            return 16;
        }
        if (pn == 13) {
            if (wc == 0) {
#pragma unroll
                for (int ai = 0; ai < 2; ++ai)
#pragma unroll
                    for (int m = 0; m < 4; ++m) { const f32x4 v0 = DQ(ai, 0, m, 0), v1 = DQ(ai, 0, m, 1);
                        u32x4 w; w.x = cvt_pk_bf16(v0[0], v0[1]); w.y = cvt_pk_bf16(v0[2], v0[3]); w.z = cvt_pk_bf16(v1[0], v1[1]); w.w = cvt_pk_bf16(v1[2], v1[3]);
                        *(u32x4*)((bf16_t*)(ws + WS_KI) + (row0 + ai * HALF + m * 16) * 32 + 8 * fq) = w; }
            } else if (wc == 1 && fq < 3) {
#pragma unroll
                for (int ai = 0; ai < 2; ++ai)
#pragma unroll
                    for (int m = 0; m < 4; ++m) { const size_t r = row0 + ai * HALF + m * 16;
                        float* dst = (fq == 0) ? ((float*)(ws + WS_WI) + r * 8) : ((float*)(ws + WS_ALR) + r * 16 + 8 * (fq - 1));
                        *(f32x4*)dst = DQ(ai, 0, m, 0); *(f32x4*)(dst + 4) = DQ(ai, 0, m, 1); }
            }
            return wc == 0 ? 8 : (wc == 1 ? 16 : 0);
        }
        if (pn >= 14) {
            unsigned char* gb = ws + (pn < 18 ? WS_GA : WS_GB) + ((pn - 14) & 3) * 256 + 64 * wc + 16 * fq;
#pragma unroll
            for (int ai = 0; ai < 2; ++ai)
#pragma unroll
                for (int m = 0; m < 4; ++m) { u32x4 w;
#pragma unroll
                    for (int bj = 0; bj < 2; ++bj) { const f32x4 v0 = DQ(ai, bj, m, 0), v1 = DQ(ai, bj, m, 1); unsigned b0 = 0u, b1 = 0u;
#pragma unroll
                        for (int j = 0; j < 4; ++j) { b0 = __builtin_amdgcn_cvt_pk_u8_f32(sigmoidf_(v0[j]) * 255.0f, j, b0); b1 = __builtin_amdgcn_cvt_pk_u8_f32(sigmoidf_(v1[j]) * 255.0f, j, b1); }
                        if (bj == 0) { w.x = b0; w.y = b1; } else { w.z = b0; w.w = b1; } }
                    __builtin_nontemporal_store(w, (u32x4*)(gb + (row0 + ai * HALF + m * 16) * (size_t)1024)); }
            return 8;
        }
        const bool act = (pn == 4 || pn == 5);
        const size_t ob = pn == 0 ? WS_QA : (pn == 1 ? WS_KA : (pn < 4 ? WS_VA : (pn < 6 ? WS_RA : (pn < 12 ? WS_VB : WS_QI))));
        const int ld = (pn < 2 || pn == 12) ? 256 : 512, cb = (pn < 2 || pn == 12) ? 0 : ((pn < 4 ? pn - 2 : (pn < 6 ? pn - 4 : pn - 10)) * 256);
        bf16_t* base = (bf16_t*)(ws + ob);
        const int col0 = cb + wc * 32 + 8 * fq;
#pragma unroll
        for (int ai = 0; ai < 2; ++ai)
#pragma unroll
            for (int m = 0; m < 4; ++m) { bf16_t* rowp = base + (row0 + ai * HALF + m * 16) * ld + col0;
#pragma unroll
                for (int bj = 0; bj < 2; ++bj) { f32x4 v0 = DQ(ai, bj, m, 0), v1 = DQ(ai, bj, m, 1);
                    if (act) {
#pragma unroll
                        for (int j = 0; j < 4; ++j) { v0[j] = siluf_(v0[j]); v1[j] = siluf_(v1[j]); } }
                    u32x4 w; w.x = cvt_pk_bf16(v0[0], v0[1]); w.y = cvt_pk_bf16(v0[2], v0[3]); w.z = cvt_pk_bf16(v1[0], v1[1]); w.w = cvt_pk_bf16(v1[2], v1[3]);
                    __builtin_nontemporal_store(w, (u32x4*)(rowp + bj * HALF)); } }
        return 16;
    }
};
struct G1Order {
    static constexpr bool GATHER = false, SPLITB = false;
    int G, c, ns, set, cnt;
    __device__ bool next(int i, Unit& u) const {
        u.sel = 0;
        if (c < ns) return false;
        const long L = (long)i * (G - ns) + (c - ns); if (L >= 256L * cnt) return false;
        int j; tile_of((int)L, 256, cnt, u.pm, j);
        u.pn = g1_tile(set, j); return true;
    }
    __device__ __forceinline__ const char* baseA(const Gemm& g, const Unit& u) const { return (const char*)g.A + (size_t)u.pm * BM * g.lda * 2; }
    __device__ __forceinline__ const char* baseB(const Gemm& g, const Unit& u) const { return (const char*)g.Bt + (size_t)u.pn * BM * g.ldb * 2; }
};
struct PairOrder {
    static constexpr bool GATHER = false, SPLITB = false;
    int nM, nN, nwg, G, c; const bf16_t* Wa; const bf16_t* Wb;
    __device__ bool next(int i, Unit& u) const {
        const long L = (long)(i >> 1) * G + c; if (L >= nwg) return false;
        tile_of((int)L, nM, nN, u.pm, u.pn); u.sel = i & 1; return true;
    }
    __device__ __forceinline__ const char* baseA(const Gemm& g, const Unit& u) const { return (const char*)g.A + ((size_t)u.pm * BM * g.lda + (u.sel ? 512 : 0)) * 2; }
    __device__ __forceinline__ const char* baseB(const Gemm& g, const Unit& u) const { return (const char*)(u.sel ? Wb : Wa) + (size_t)u.pn * BM * g.ldb * 2; }
};
struct PanelX { PG8_LAS float* xl; unsigned* slots; gu32* cnt; float* scale; };
__device__ __forceinline__ void panel_rowmax(const PanelX& P, int pm, int pn, int wr, int wc, int fr, int fq, float (&mx)[8]) {
    const int tid = threadIdx.x;
#pragma unroll
    for (int it = 0; it < 8; ++it) { mx[it] = fmaxf(mx[it], __shfl_xor(mx[it], 16)); mx[it] = fmaxf(mx[it], __shfl_xor(mx[it], 32)); }
    if (fq == 0) {
#pragma unroll
        for (int it = 0; it < 8; ++it) P.xl[wc * 256 + (it >> 2) * HALF + wr * 64 + (it & 3) * 16 + fr] = mx[it]; }
    __syncthreads();
    if (tid < 256) { const float v = fmaxf(fmaxf(P.xl[tid], P.xl[256 + tid]), fmaxf(P.xl[512 + tid], P.xl[768 + tid]));
        __hip_atomic_store(P.slots + (pm * 4 + pn) * 256 + tid, __builtin_bit_cast(unsigned, v), RLX_AGENT); }
    asm volatile("s_waitcnt vmcnt(0)" ::: "memory");
    __syncthreads();
    if (tid == 0) { __hip_atomic_fetch_add(P.cnt + pm, 1u, __ATOMIC_RELEASE, __HIP_MEMORY_SCOPE_AGENT);
        while (__hip_atomic_load(P.cnt + pm, __ATOMIC_ACQUIRE, __HIP_MEMORY_SCOPE_AGENT) < 4u) __builtin_amdgcn_s_sleep(2); }
    __syncthreads();
    if (tid < 256) { unsigned s[4];
#pragma unroll
        for (int j = 0; j < 4; ++j) s[j] = __hip_atomic_load(P.slots + (pm * 4 + j) * 256 + tid, RLX_AGENT);
        const float v = fmaxf(fmaxf(__builtin_bit_cast(float, s[0]), __builtin_bit_cast(float, s[1])), fmaxf(__builtin_bit_cast(float, s[2]), __builtin_bit_cast(float, s[3])));
        P.xl[1024 + tid] = v; if (pn == 0) P.scale[(size_t)pm * 256 + tid] = v * (1.0f / 127.0f); }
    __syncthreads();
#pragma unroll
    for (int it = 0; it < 8; ++it) mx[it] = P.xl[1024 + (it >> 2) * HALF + wr * 64 + (it & 3) * 16 + fr];
}
struct EpiMix {
    static constexpr bool PERM = true, CARRY = true;
    const bf16_t *GA, *GB; unsigned char* M8; PanelX PX;
    static constexpr float GB_TINY = 255.0f / 1099511627776.0f;
    __device__ __forceinline__ int operator()(f32x4 (&acc)[2][2][4][2], const Unit& u, int wr, int wc, int fr, int fq) const {
        { int l; asm volatile("v_mbcnt_lo_u32_b32 %0, -1, 0\n\tv_mbcnt_hi_u32_b32 %0, -1, %0" : "=v"(l)); fr = l & 15; fq = l >> 4; }
        const size_t row0 = (size_t)u.pm * BM + wr * 64 + fr; const int col0 = u.pn * BM + wc * 32 + 8 * fq;
        const unsigned char* ga = (const unsigned char*)GA; const unsigned char* gb = (const unsigned char*)GB;
        float mx[8]; v2u wbb[2][2], wab[2][2];
#pragma unroll
        for (int bj = 0; bj < 2; ++bj) { const size_t off = row0 * 1024 + col0 + bj * HALF; wbb[0][bj] = *(const v2u*)(gb + off); wab[0][bj] = (v2u){0u, 0u}; if (!u.sel) wab[0][bj] = *(const v2u*)(ga + off); }
#pragma unroll
        for (int it = 0; it < 8; ++it) { const int ai = it >> 2, m = it & 3, sl = it & 1;
            if (it + 1 < 8) { const size_t offn = (row0 + ((it + 1) >> 2) * HALF + ((it + 1) & 3) * 16) * 1024 + col0;
#pragma unroll
                for (int bj = 0; bj < 2; ++bj) { wbb[sl ^ 1][bj] = *(const v2u*)(gb + offn + bj * HALF); wab[sl ^ 1][bj] = (v2u){0u, 0u}; if (!u.sel) wab[sl ^ 1][bj] = *(const v2u*)(ga + offn + bj * HALF); } }
            asm volatile("" ::: "memory");
            mx[it] = 0.f;
#pragma unroll
            for (int bj = 0; bj < 2; ++bj) { const v2u wb = wbb[sl][bj]; f32x4 v0 = acc[ai][bj][m][0], v1 = acc[ai][bj][m][1];
                float b[8];
#pragma unroll
                for (int j = 0; j < 4; ++j) { b[j] = fmaxf((float)((wb[0] >> (8 * j)) & 255u), GB_TINY); b[4 + j] = fmaxf((float)((wb[1] >> (8 * j)) & 255u), GB_TINY); }
                if (!u.sel) { const v2u wa = wab[sl][bj];
#pragma unroll
                    for (int j = 0; j < 4; ++j) { v0[j] *= (float)((wa[0] >> (8 * j)) & 255u) * __builtin_amdgcn_rcpf(b[j]); v1[j] *= (float)((wa[1] >> (8 * j)) & 255u) * __builtin_amdgcn_rcpf(b[4 + j]); } }
                else {
#pragma unroll
                    for (int j = 0; j < 4; ++j) { v0[j] *= b[j] * (1.0f / 255.0f); v1[j] *= b[4 + j] * (1.0f / 255.0f); }
                    mx[it] = fmaxf(fmaxf(mx[it], fmaxf(fmaxf(fabsf(v0[0]), fabsf(v0[1])), fmaxf(fabsf(v0[2]), fabsf(v0[3])))), fmaxf(fmaxf(fabsf(v1[0]), fabsf(v1[1])), fmaxf(fabsf(v1[2]), fabsf(v1[3])))); }
                acc[ai][bj][m][0] = v0; acc[ai][bj][m][1] = v1; } }
        if (!u.sel) return 0;
        panel_rowmax(PX, u.pm, u.pn, wr, wc, fr, fq, mx);
        unsigned char* o8 = M8 + row0 * 1024 + u.pn * BM + 64 * wc + 16 * fq;
#pragma unroll
        for (int it = 0; it < 8; ++it) { const int ai = it >> 2, m = it & 3; const float a = mx[it]; const float inv = a > 0.f ? 127.0f / a : 0.f;
            u32x4 w;
#pragma unroll
            for (int bj = 0; bj < 2; ++bj) { const f32x4 v0 = acc[ai][bj][m][0], v1 = acc[ai][bj][m][1]; unsigned b0 = 0u, b1 = 0u;
#pragma unroll
                for (int j = 0; j < 4; ++j) { b0 = __builtin_amdgcn_cvt_pk_u8_f32(__builtin_rintf(__builtin_fmaf(v0[j], inv, 128.0f)), j, b0); b1 = __builtin_amdgcn_cvt_pk_u8_f32(__builtin_rintf(__builtin_fmaf(v1[j], inv, 128.0f)), j, b1); }
                if (bj == 0) { w.x = b0 ^ 0x80808080u; w.y = b1 ^ 0x80808080u; } else { w.z = b0 ^ 0x80808080u; w.w = b1 ^ 0x80808080u; } }
            *(u32x4*)(o8 + (size_t)(ai * HALF + m * 16) * 1024) = w; }
        return 8;
    }
};
struct EpiRes {
    static constexpr bool PERM = true, CARRY = false;
    const float* X; bf16_t* XB; const float *MS, *CSO; PG8_LAS float* xl; unsigned* slots;
    __device__ __forceinline__ int operator()(const f32x4 (&acc)[2][2][4][2], const Unit& u, int wr, int wc, int fr, int fq) const {
        { int l; asm volatile("v_mbcnt_lo_u32_b32 %0, -1, 0\n\tv_mbcnt_hi_u32_b32 %0, -1, %0" : "=v"(l)); fr = l & 15; fq = l >> 4; }
        const size_t row0 = (size_t)u.pm * BM + wr * 64 + fr; const int col0 = u.pn * BM + wc * 32 + 8 * fq;
        f32x4 csc[2][2];
#pragma unroll
        for (int bj = 0; bj < 2; ++bj)
#pragma unroll
            for (int n = 0; n < 2; ++n) csc[bj][n] = *(const f32x4*)(CSO + col0 + bj * HALF + 4 * n);
        f32x4 xb[2][2][2];
#pragma unroll
        for (int bj = 0; bj < 2; ++bj) { const size_t off = row0 * 1024 + col0 + bj * HALF; xb[0][bj][0] = *(const f32x4*)(X + off); xb[0][bj][1] = *(const f32x4*)(X + off + 4); }
#pragma unroll
        for (int it = 0; it < 8; ++it) { const int ai = it >> 2, m = it & 3, sl = it & 1; const size_t off = (row0 + ai * HALF + m * 16) * 1024 + col0;
            if (it + 1 < 8) { const size_t offn = (row0 + ((it + 1) >> 2) * HALF + ((it + 1) & 3) * 16) * 1024 + col0;
#pragma unroll
                for (int bj = 0; bj < 2; ++bj) { xb[sl ^ 1][bj][0] = *(const f32x4*)(X + offn + bj * HALF); xb[sl ^ 1][bj][1] = *(const f32x4*)(X + offn + bj * HALF + 4); } }
            asm volatile("" ::: "memory");
            const float rsc = MS[row0 + ai * HALF + m * 16]; float mx = 0.f;
#pragma unroll
            for (int bj = 0; bj < 2; ++bj) { const f32x4 y0 = xb[sl][bj][0] + __builtin_convertvector(__builtin_bit_cast(i32x4, acc[ai][bj][m][0]), f32x4) * csc[bj][0] * rsc, y1 = xb[sl][bj][1] + __builtin_convertvector(__builtin_bit_cast(i32x4, acc[ai][bj][m][1]), f32x4) * csc[bj][1] * rsc;
                mx = fmaxf(fmaxf(mx, fmaxf(fmaxf(fabsf(y0[0]), fabsf(y0[1])), fmaxf(fabsf(y0[2]), fabsf(y0[3])))), fmaxf(fmaxf(fabsf(y1[0]), fabsf(y1[1])), fmaxf(fabsf(y1[2]), fabsf(y1[3]))));
                u32x4 w; w.x = cvt_pk_bf16(y0[0], y0[1]); w.y = cvt_pk_bf16(y0[2], y0[3]); w.z = cvt_pk_bf16(y1[0], y1[1]); w.w = cvt_pk_bf16(y1[2], y1[3]);
                *(u32x4*)(XB + off + bj * HALF) = w; }
            mx = fmaxf(mx, __shfl_xor(mx, 16)); mx = fmaxf(mx, __shfl_xor(mx, 32));
            if (fq == 0) xl[wc * 256 + ai * HALF + wr * 64 + m * 16 + fr] = __builtin_bit_cast(float, f2bf(mx) << 16);
            asm volatile("" ::: "memory"); }
        __syncthreads();
        { const int tid = threadIdx.x;
          if (tid < 256) { const float v = fmaxf(fmaxf(xl[tid], xl[256 + tid]), fmaxf(xl[512 + tid], xl[768 + tid])); slots[(u.pm * 4 + u.pn) * 256 + tid] = __builtin_bit_cast(unsigned, v); } }
        __syncthreads();
        return 16;
    }
};
}
__device__ __forceinline__ void gla_prep(Frame& F, const Args& A) {
    const int half = F.tid >> 8, dcol = F.tid & 255;
    LAS float* alr_s = (LAS float*)(F.lds) + half * 1024;
    const float* W2 = A.in[IN_WA2]; const float* ALR = WSP(float, WS_ALR); const bf16* KA = WSP(bf16, WS_KA);
    bf16* KDT = WSP(bf16, WS_KDT); float* DEC = WSP(float, WS_DEC);
    float w2[16];
#pragma unroll
    for (int r = 0; r < 16; ++r) w2[r] = W2[r * 256 + dcol];
    const float bb = A.in[IN_BA][dcol];
    for (int it = F.vcu; it < NCHUNK / 2; it += F.G) {
        const int chunk = it * 2 + half; const size_t row0 = (size_t)chunk * CH;
        __syncthreads();
        *(LAS f32x4*)(alr_s + dcol * 4) = *(const f32x4*)(ALR + row0 * 16 + dcol * 4);
        __syncthreads();
        float cum[64]; float run = 0.f;
#pragma unroll
        for (int t = 0; t < 64; ++t) {
            float z = bb;
#pragma unroll
            for (int r4 = 0; r4 < 4; ++r4) { const f32x4 a = *(const LAS f32x4*)(alr_s + t * 16 + r4 * 4); z += a[0] * w2[r4 * 4] + a[1] * w2[r4 * 4 + 1] + a[2] * w2[r4 * 4 + 2] + a[3] * w2[r4 * 4 + 3]; }
            const float ls = fminf(z, 0.f) - 0.6931471805599453f * __builtin_amdgcn_logf(1.0f + __builtin_amdgcn_exp2f(-fabsf(z) * LOG2E));
            run += ls * (1.0f / 16.0f); cum[t] = run;
        }
        const float total = run;
        DEC[(size_t)chunk * 256 + dcol] = __builtin_amdgcn_exp2f(total * LOG2E);
        const int h = dcol >> 6, d = dcol & 63;
        bf16* dst = KDT + (((size_t)chunk * 4 + h) * 64 + d) * 64;
        const bf16* ksrc = KA + row0 * 256 + dcol;
#pragma unroll
        for (int t8 = 0; t8 < 8; ++t8) {
            float kv[8];
#pragma unroll
            for (int j = 0; j < 8; ++j) { const int t = t8 * 8 + j; kv[j] = bf2f(ksrc[(size_t)t * 256]) * __builtin_amdgcn_exp2f((total - cum[t]) * LOG2E); }
            v4u o; o.x = pk2(kv[0], kv[1]); o.y = pk2(kv[2], kv[3]); o.z = pk2(kv[4], kv[5]); o.w = pk2(kv[6], kv[7]);
            *(GAS v4u*)(dst + t8 * 8) = o;
        }
    }
    __syncthreads();
}
namespace gla {
using s16x4 = __attribute__((ext_vector_type(4))) short;
typedef short v4i16_t __attribute__((ext_vector_type(4)));
typedef __attribute__((address_space(3))) const char* lds_cptr;
__device__ __forceinline__ s16x4 vtr(lds_cptr p) { return __builtin_bit_cast(s16x4, __builtin_amdgcn_ds_read_tr16_b64_v4i16((__attribute__((address_space(3))) v4i16_t*)p)); }
__device__ __forceinline__ void glds16(const void* gsrc, unsigned lds_dst) { unsigned keep;
    asm volatile("s_mov_b32 %0, m0\n\ts_mov_b32 m0, %2\n\ts_nop 0\n\tglobal_load_lds_dwordx4 %1, off\n\ts_mov_b32 m0, %0" : "=&s"(keep) : "v"(gsrc), "s"(lds_dst) : "memory"); }
__device__ __forceinline__ unsigned cvtpk(float lo, float hi) { return pg8::cvt_pk_bf16(lo, hi); }
constexpr int L_Q = 0, L_KD = 16384, L_V = 32768, L_R = 65536, L_DEC = 98304, L_OST = 98816, L_RED = 115200, L_END = L_RED + 2048;
struct Ctx { const bf16* KDT; const float* DEC; const bf16* QA; const bf16* VA; const bf16* RA; bf16* OC; };
#define GLA_BAR() asm volatile("s_waitcnt lgkmcnt(0)\n\ts_barrier" ::: "memory")

__device__ __forceinline__ void load_chunk(const Ctx& X, unsigned lds0, int chunk, int h, int ld, int lane, int slot) {
    const size_t row0 = (size_t)chunk * 64;
#pragma unroll
    for (int i = 0; i < 2; ++i) { const int p = 128 * ld + 64 * i + lane, r = p >> 3, cg = (p & 7) ^ (r & 7);
        glds16(X.QA + (row0 + r) * 256 + h * 64 + cg * 8, (unsigned)__builtin_amdgcn_readfirstlane(lds0 + L_Q + slot * 8192 + (128 * ld + 64 * i) * 16));
        glds16(X.KDT + (((size_t)chunk * 4 + h) * 64 + r) * 64 + cg * 8, (unsigned)__builtin_amdgcn_readfirstlane(lds0 + L_KD + slot * 8192 + (128 * ld + 64 * i) * 16)); }
    const size_t voff = (row0 + (lane >> 2)) * 512 + h * 128 + ld * 32 + (lane & 3) * 8;
#pragma unroll
    for (int p = 0; p < 4; ++p) { glds16(X.VA + voff + (size_t)p * 16 * 512, (unsigned)__builtin_amdgcn_readfirstlane(lds0 + L_V + slot * 16384 + ld * 4096 + p * 1024));
                                  glds16(X.RA + voff + (size_t)p * 16 * 512, (unsigned)__builtin_amdgcn_readfirstlane(lds0 + L_R + slot * 16384 + ld * 4096 + p * 1024)); }
}
__device__ __forceinline__ void store_chunk(const Ctx& X, LAS unsigned char* lds, int chunk, int h, int ld, int lane) {
    const size_t row0 = (size_t)chunk * 64; v4u v[4];
#pragma unroll
    for (int p = 0; p < 4; ++p) v[p] = *(const LAS v4u*)(lds + L_OST + ld * 4096 + p * 1024 + lane * 16);
    asm volatile("s_waitcnt lgkmcnt(0)" ::: "memory");
#pragma unroll
    for (int p = 0; p < 4; ++p) *(v4u*)(X.OC + (row0 + 16 * p + (lane >> 2)) * 1024 + h * 128 + ld * 32 + (lane & 3) * 8) = v[p];
}
__device__ __forceinline__ void step_a(LAS unsigned char* lds, int slot, int sl, int lane, f32x16 (&S)[2], f32x16 (&oT)[2]) {
    const int n32 = lane & 31, hi = lane >> 5;
    const LAS float* dsc = (const LAS float*)(lds + L_DEC + slot * 256);
#pragma unroll
    for (int dt = 0; dt < 2; ++dt)
#pragma unroll
        for (int g = 0; g < 4; ++g) { const f32x4 dv = *(const LAS f32x4*)(dsc + 32 * dt + 8 * g + 4 * hi);
#pragma unroll
            for (int j = 0; j < 4; ++j) S[dt][4 * g + j] *= dv[j]; }
    const lds_cptr kdp = (lds_cptr)lds + L_KD + slot * 8192, qp = (lds_cptr)lds + L_Q + slot * 8192;
    const lds_cptr vp = (lds_cptr)lds + L_V + slot * 16384 + sl * 4096 + ((lane >> 4) & 1) * 32 + (lane & 3) * 8 + (8 * hi + ((lane & 15) >> 2)) * 64;
#pragma unroll
    for (int s = 0; s < 4; ++s) { const s16x4 a0 = vtr(vp + s * 1024), a1 = vtr(vp + s * 1024 + 256);
        const bf16x8 vf = (bf16x8){a0[0], a0[1], a0[2], a0[3], a1[0], a1[1], a1[2], a1[3]};
#pragma unroll
        for (int dt = 0; dt < 2; ++dt) { const int d = 32 * dt + n32; const bf16x8 kf = *(const __attribute__((address_space(3))) bf16x8*)(kdp + d * 128 + (((2 * s + hi) ^ (d & 7)) << 4));
            S[dt] = __builtin_amdgcn_mfma_f32_32x32x16_bf16(kf, vf, S[dt], 0, 0, 0); } }
    v4u sa[2][2];
#pragma unroll
    for (int dt = 0; dt < 2; ++dt)
#pragma unroll
        for (int s = 0; s < 2; ++s)
#pragma unroll
            for (int i = 0; i < 4; ++i) sa[dt][s][i] = cvtpk(S[dt][8 * s + 2 * i], S[dt][8 * s + 2 * i + 1]);
#pragma unroll
    for (int tn = 0; tn < 2; ++tn) { const int t = 32 * tn + n32;
#pragma unroll
        for (int r = 0; r < 16; ++r) oT[tn][r] = 0.f;
#pragma unroll
        for (int dt = 0; dt < 2; ++dt)
#pragma unroll
            for (int s = 0; s < 2; ++s) { const int c0 = 4 * dt + 2 * s;
                const v2u q0 = *(const __attribute__((address_space(3))) v2u*)(qp + t * 128 + ((c0 ^ (t & 7)) << 4) + 8 * hi), q1 = *(const __attribute__((address_space(3))) v2u*)(qp + t * 128 + (((c0 + 1) ^ (t & 7)) << 4) + 8 * hi);
                const v4u qq = (v4u){q0[0], q0[1], q1[0], q1[1]};
                oT[tn] = __builtin_amdgcn_mfma_f32_32x32x16_bf16(__builtin_bit_cast(bf16x8, sa[dt][s]), __builtin_bit_cast(bf16x8, qq), oT[tn], 0, 0, 0); } }
    LAS float* red = (LAS float*)(lds + L_RED) + slot * 256;
#pragma unroll
    for (int tn = 0; tn < 2; ++tn) { float ss = 0.f;
#pragma unroll
        for (int r = 0; r < 16; ++r) ss += oT[tn][r] * oT[tn][r];
        { auto rr = __builtin_amdgcn_permlane32_swap(__float_as_uint(ss), __float_as_uint(ss), false, false); ss = __uint_as_float(rr[0]) + __uint_as_float(rr[1]); }
        if (hi == 0) red[sl * 64 + 32 * tn + n32] = ss; }
}
__device__ __forceinline__ void step_b(LAS unsigned char* lds, int slot, int sl, int lane, const f32x16 (&oT)[2], const float (&gg)[16]) {
    const int n32 = lane & 31, hi = lane >> 5;
    const LAS float* red = (const LAS float*)(lds + L_RED) + slot * 256;
#pragma unroll
    for (int tn = 0; tn < 2; ++tn) { const int t = 32 * tn + n32;
        const float tot = (red[t] + red[64 + t]) + (red[128 + t] + red[192 + t]);
        const float rs = 1.0f / sqrtf(tot * (1.0f / 128.0f) + EPS);
        const int toff = sl * 4096 + (t >> 4) * 1024 + (t & 15) * 64 + 8 * hi;
#pragma unroll
        for (int g = 0; g < 4; ++g) { const v2u rw = *(const LAS v2u*)(lds + L_R + slot * 16384 + toff + 16 * g);
            const float y0 = oT[tn][4 * g] * rs * gg[4 * g] * bflo(rw[0]), y1 = oT[tn][4 * g + 1] * rs * gg[4 * g + 1] * bfhi(rw[0]);
            const float y2 = oT[tn][4 * g + 2] * rs * gg[4 * g + 2] * bflo(rw[1]), y3 = oT[tn][4 * g + 3] * rs * gg[4 * g + 3] * bfhi(rw[1]);
            v2u w; w[0] = cvtpk(y0, y1); w[1] = cvtpk(y2, y3); *(LAS v2u*)(lds + L_OST + toff + 16 * g) = w; } }
}
}

__device__ __forceinline__ void gla_scan_mfma(Frame& F, const Args& A) {
    if (F.vcu >= 64) return;
    const gla::Ctx X{WSP(bf16, WS_KDT), WSP(float, WS_DEC), WSP(bf16, WS_QA), WSP(bf16, WS_VA), WSP(bf16, WS_RA), WSP(bf16, WS_OCAT)};
    const int wid = F.wave, lane = F.lane, hi = lane >> 5;
    const int bh = F.vcu, b = bh >> 2, h = bh & 3, c0 = b * NCH;
    const unsigned lds0 = (unsigned)(uintptr_t)F.lds;
    __syncthreads();
    if (wid >= 4) {
        const int ld = wid - 4;
        gla::load_chunk(X, lds0, c0, h, ld, lane, 0);
        float dv = X.DEC[(size_t)c0 * 256 + h * 64 + lane];
        asm volatile("s_waitcnt vmcnt(0)" ::: "memory");
        if (ld == 0) ((LAS float*)(F.lds + gla::L_DEC))[lane] = dv;
        for (int c = 0; c < NCH; ++c) {
            GLA_BAR();
            if (c + 1 < NCH) { gla::load_chunk(X, lds0, c0 + c + 1, h, ld, lane, (c + 1) & 1); dv = X.DEC[(size_t)(c0 + c + 1) * 256 + h * 64 + lane]; }
            if (c > 0) gla::store_chunk(X, F.lds, c0 + c - 1, h, ld, lane);
            GLA_BAR();
            asm volatile("s_waitcnt vmcnt(0)" ::: "memory");
            if (ld == 0 && c + 1 < NCH) ((LAS float*)(F.lds + gla::L_DEC + ((c + 1) & 1) * 256))[lane] = dv;
        }
        GLA_BAR();
        gla::store_chunk(X, F.lds, c0 + NCH - 1, h, ld, lane);
    } else {
        const int sl = wid;
        float gg[16];
#pragma unroll
        for (int r = 0; r < 16; ++r) gg[r] = A.in[IN_GGLA][sl * 32 + (r & 3) + 8 * (r >> 2) + 4 * hi];
        f32x16 S[2], oT[2];
#pragma unroll
        for (int r = 0; r < 16; ++r) { S[0][r] = 0.f; S[1][r] = 0.f; }
        for (int c = 0; c < NCH; ++c) {
            GLA_BAR();
            gla::step_a(F.lds, c & 1, sl, lane, S, oT);
            GLA_BAR();
            gla::step_b(F.lds, c & 1, sl, lane, oT, gg);
        }
        GLA_BAR();
    }
    __syncthreads();
}
__device__ __forceinline__ unsigned f2key(float f) { const unsigned u = __builtin_bit_cast(unsigned, f + 0.0f);     return u ^ ((u >> 31) ? 0xffffffffu : 0x80000000u); }
template <int NREG>
__device__ __forceinline__ unsigned long long radix_select(const unsigned (&key)[NREG], int lane) {
    unsigned prefix = 0u; bool exact = false;
    for (int bit = 31; bit >= 0; --bit) {
        const unsigned cand = prefix | (1u << bit); int cnt = 0;
#pragma unroll
        for (int j = 0; j < NREG; ++j) cnt += __popcll(__ballot(key[j] >= cand));
        if (cnt >= 256) { prefix = cand; if (cnt == 256) { exact = true; break; } }
    }
    int mlo = 0, mhi = 0;
    int cgt = 0;
#pragma unroll
    for (int j = 0; j < NREG; ++j) cgt += __popcll(__ballot(key[j] > prefix));
    int rem = exact ? 0 : 256 - cgt;
#pragma unroll
    for (int j = 0; j < NREG; ++j) {
        const unsigned long long gt = __ballot(exact ? key[j] >= prefix : key[j] > prefix), eq = exact ? 0ull : __ballot(key[j] == prefix);
        unsigned long long w = gt;
        if (eq != 0ull && rem > 0) {
            const int c = __popcll(eq);
            if (c <= rem) { w |= eq; rem -= c; }
            else { const int rank = __popcll(eq & ((1ull << lane) - 1ull)); w |= __ballot(((eq >> lane) & 1ull) && rank < rem); rem = 0; }
        }
        asm volatile("s_nop 4\n\tv_writelane_b32 %0, %2, %4\n\tv_writelane_b32 %1, %3, %4" : "+v"(mlo), "+v"(mhi) : "s"((unsigned)w), "s"((unsigned)(w >> 32)), "i"(j));
    }
    return ((unsigned long long)(unsigned)mhi << 32) | (unsigned)mlo;
}
#define DPP_STEP_U(x, ctrl, rmask) __builtin_amdgcn_update_dpp(0, (int)(x), ctrl, rmask, 0xf, false)
__device__ __forceinline__ unsigned dpp_scan_add(unsigned x) {
    x += (unsigned)DPP_STEP_U(x, 0x111, 0xf); x += (unsigned)DPP_STEP_U(x, 0x112, 0xf); x += (unsigned)DPP_STEP_U(x, 0x114, 0xf); x += (unsigned)DPP_STEP_U(x, 0x118, 0xf);
    x += (unsigned)DPP_STEP_U(x, 0x142, 0xa); x += (unsigned)DPP_STEP_U(x, 0x143, 0xc); return x; }
#define DPP_STEP_F(x, ctrl, rmask) __builtin_bit_cast(float, __builtin_amdgcn_update_dpp((int)0xff800000, __builtin_bit_cast(int, (x)), ctrl, rmask, 0xf, false))
__device__ __forceinline__ float dpp_wave_max(float x) {
    x = fmaxf(x, DPP_STEP_F(x, 0x111, 0xf)); x = fmaxf(x, DPP_STEP_F(x, 0x112, 0xf)); x = fmaxf(x, DPP_STEP_F(x, 0x114, 0xf)); x = fmaxf(x, DPP_STEP_F(x, 0x118, 0xf));
    x = fmaxf(x, DPP_STEP_F(x, 0x142, 0xa)); x = fmaxf(x, DPP_STEP_F(x, 0x143, 0xc));
    return __builtin_bit_cast(float, __builtin_amdgcn_readlane(__builtin_bit_cast(int, x), 63)); }
__device__ __forceinline__ float rl_f(float v, int l) { return __builtin_bit_cast(float, __builtin_amdgcn_readlane(__builtin_bit_cast(int, v), l)); }
__device__ __forceinline__ int rl_i(int v, int l) { return __builtin_amdgcn_readlane(v, l); }
template <int NREG>
__device__ __forceinline__ unsigned long long select_hist(LAS float* sc, int nr_, int lane) {
    const int nr = __builtin_amdgcn_readfirstlane(nr_);
    float s[NREG]; float lo = INFINITY, hi = -INFINITY;
#pragma unroll
    for (int j = 0; j < NREG; ++j) { if (j < NREG - 7 || j < nr) { s[j] = sc[j * 64 + lane]; lo = fminf(lo, s[j]); hi = fmaxf(hi, s[j]); } else s[j] = -INFINITY; }
    hi = dpp_wave_max(hi); lo = -dpp_wave_max(-lo);
    float c1 = 4095.0f / fmaxf(hi - lo, 1e-30f), c0 = -lo * c1;
    LAS unsigned* hist = (LAS unsigned*)sc;
    asm volatile("s_waitcnt lgkmcnt(0)" ::: "memory");
#pragma unroll
    for (int k = 0; k < 16; ++k) *(LAS v4u*)(hist + k * 256 + lane * 4) = (v4u){0u, 0u, 0u, 0u};
    asm volatile("s_waitcnt lgkmcnt(0)" ::: "memory");
#define SEL_BIN(v) ((int)__builtin_amdgcn_fmed3f(__builtin_fmaf((v), c1, c0), 0.0f, 4095.0f))
#pragma unroll
    for (int j = 0; j < NREG; ++j) { if (j < NREG - 7 || j < nr) (void)__hip_atomic_fetch_add(hist + SEL_BIN(s[j]), 1u, __ATOMIC_RELAXED, __HIP_MEMORY_SCOPE_WORKGROUP); }
    asm volatile("s_waitcnt lgkmcnt(0)" ::: "memory");
    unsigned tot = 0u;
#pragma unroll
    for (int k = 0; k < 16; ++k) { const v4u h4 = *(const LAS v4u*)(hist + lane * 64 + k * 4); tot += (h4[0] + h4[1]) + (h4[2] + h4[3]); }
    const unsigned pre = dpp_scan_add(tot); const unsigned all = (unsigned)rl_i((int)pre, 63);
    const unsigned suf = all - pre + tot;
    const unsigned above = suf - tot;
    const unsigned long long m1 = __ballot(above < 256u && suf >= 256u);
    const int Ls = __ffsll((long long)m1) - 1;
    const unsigned aboveL = (unsigned)rl_i((int)above, Ls);
    const unsigned hb = hist[Ls * 64 + lane];
    const unsigned pre2 = dpp_scan_add(hb); const unsigned suf2 = (unsigned)rl_i((int)pre2, 63) - pre2 + hb;
    const unsigned ab2 = aboveL + (suf2 - hb);
    const unsigned long long m2 = __ballot(ab2 < 256u && ab2 + hb >= 256u);
    const int ks = __ffsll((long long)m2) - 1;
    const int bstar = Ls * 64 + ks; const int cab = rl_i((int)ab2, ks); const int nc = rl_i((int)hb, ks); const int need = 256 - cab;
    if (nc > 64) {
        unsigned key[NREG];
#pragma unroll
        for (int j = 0; j < NREG; ++j) key[j] = (s[j] == -INFINITY) ? 0u : f2key(s[j]);
        return radix_select<NREG>(key, lane);
    }
    LAS float* cv = (LAS float*)(hist) ; LAS int* ci = (LAS int*)(hist + 64);
    asm volatile("s_waitcnt lgkmcnt(0)" ::: "memory");
    int base = 0;
    asm volatile("" : "+v"(c0), "+v"(c1));
#pragma unroll
    for (int j = 0; j < NREG; ++j) { if (j < NREG - 7 || j < nr) { const bool inb = SEL_BIN(s[j]) == bstar; const unsigned long long mk = __ballot(inb);
        if (mk) { if (inb) { const int p = base + __popcll(mk & ((1ull << lane) - 1ull)); cv[p] = s[j]; ci[p] = j * 64 + lane; } base += __popcll(mk); } } }
#undef SEL_BIN
    asm volatile("s_waitcnt lgkmcnt(0)" ::: "memory");
    const float myv = lane < nc ? cv[lane] : -INFINITY; const int myi = lane < nc ? ci[lane] : 0x7fffffff;
    int rank = 0;
    for (int k = 0; k < nc; ++k) { const float vk = rl_f(myv, k); const int ik = rl_i(myi, k); rank += (vk > myv || (vk == myv && ik < myi)) ? 1 : 0; }
    const unsigned long long m3 = __ballot(lane < nc && rank == need - 1);
    const int ts = __ffsll((long long)m3) - 1;
    const float vstar = rl_f(myv, ts); const int istar = rl_i(myi, ts);
    const int ties = __popcll(__ballot(lane < nc && myv == vstar));
    int mlo = 0, mhi = 0;
    if (ties == 1) {
#pragma unroll
        for (int j = 0; j < NREG; ++j) { const unsigned long long w = __ballot(s[j] >= vstar);
            asm volatile("s_nop 4\n\tv_writelane_b32 %0, %2, %4\n\tv_writelane_b32 %1, %3, %4" : "+v"(mlo), "+v"(mhi) : "s"((unsigned)w), "s"((unsigned)(w >> 32)), "i"(j)); }
    } else {
#pragma unroll
        for (int j = 0; j < NREG; ++j) { const int idx = j * 64 + lane; const unsigned long long w = __ballot(s[j] > vstar || (s[j] == vstar && idx <= istar));
            asm volatile("s_nop 4\n\tv_writelane_b32 %0, %2, %4\n\tv_writelane_b32 %1, %3, %4" : "+v"(mlo), "+v"(mhi) : "s"((unsigned)w), "s"((unsigned)(w >> 32)), "i"(j)); }
    }
    return ((unsigned long long)(unsigned)mhi << 32) | (unsigned)mlo;
}
__device__ __forceinline__ float dsa_relu(float x) { const int b = __builtin_bit_cast(int, x); return __builtin_bit_cast(float, b > 0 ? b : 0); }
__device__ __forceinline__ void dsa_select_mfma(Frame& F, const Args& A) {
    LAS float* sc = (LAS float*)F.lds;
    const bf16* QI = WSP(bf16, WS_QI); const bf16* KI = WSP(bf16, WS_KI); const float* WI = WSP(float, WS_WI);
    unsigned long long* MASK = WSP(unsigned long long, WS_MASK);
    const int lane = F.lane, n32 = lane & 31, hi = lane >> 5;
    const int qi_m = 2 * ((n32 >> 2) & 1) + (n32 >> 4), hd_m = (n32 & 3) + 4 * ((n32 >> 3) & 1);
    for (int u = F.vcu; u < 8192; u += F.G) {
        const int g = u & 7, rest = u >> 3, b = rest & 15;
        int i = rest >> 4;
        if (F.G == 256) i ^= (u >> 8) & 1;

        const int N = (i + 1) * 64; const size_t seq0 = (size_t)b * SEQ; const size_t q0 = seq0 + (size_t)i * 64 + g * 8;
        if (i < 4) {
            const size_t r = q0 + F.wave; const int nw = N >> 6;
            MASK[r * 64 + lane] = (lane < nw) ? ~0ull : 0ull;
            continue;
        }
        bf16x8 aq[2][2]; f32x4 wv[2][4];
#pragma unroll
        for (int mt = 0; mt < 2; ++mt) {
#pragma unroll
            for (int s = 0; s < 2; ++s) aq[mt][s] = *(const bf16x8*)(QI + (q0 + 4 * mt + qi_m) * 256 + hd_m * 32 + 16 * s + 8 * hi);
#pragma unroll
            for (int c = 0; c < 4; ++c) wv[mt][c] = *(const f32x4*)(WI + (q0 + 4 * mt + 2 * hi) * 8 + 4 * c);
        }
        __syncthreads();
        const int nj = N / 32;
        bf16x8 nb0, nb1;
        { const int key = 32 * F.wave + n32; nb0 = *(const bf16x8*)(KI + (seq0 + key) * 32 + 8 * hi); nb1 = *(const bf16x8*)(KI + (seq0 + key) * 32 + 16 + 8 * hi); }
        for (int j = F.wave; j < nj; j += 8) {
            const int key = 32 * j + n32;
            const bf16x8 bk0 = nb0, bk1 = nb1;
            { const int jn = (j + 8 < nj) ? j + 8 : j; const int kn = 32 * jn + n32; nb0 = *(const bf16x8*)(KI + (seq0 + kn) * 32 + 8 * hi); nb1 = *(const bf16x8*)(KI + (seq0 + kn) * 32 + 16 + 8 * hi); }
            f32x16 a0, a1;
#pragma unroll
            for (int r = 0; r < 16; ++r) { a0[r] = 0.f; a1[r] = 0.f; }
            a0 = __builtin_amdgcn_mfma_f32_32x32x16_bf16(aq[0][0], bk0, a0, 0, 0, 0); a0 = __builtin_amdgcn_mfma_f32_32x32x16_bf16(aq[0][1], bk1, a0, 0, 0, 0);
            a1 = __builtin_amdgcn_mfma_f32_32x32x16_bf16(aq[1][0], bk0, a1, 0, 0, 0); a1 = __builtin_amdgcn_mfma_f32_32x32x16_bf16(aq[1][1], bk1, a1, 0, 0, 0);
            float s00 = 0.f, s01 = 0.f, s10 = 0.f, s11 = 0.f;
#pragma unroll
            for (int r = 0; r < 8; ++r) { s00 += wv[0][r >> 2][r & 3] * dsa_relu(a0[r]); s01 += wv[0][2 + (r >> 2)][r & 3] * dsa_relu(a0[8 + r]);
                                          s10 += wv[1][r >> 2][r & 3] * dsa_relu(a1[r]); s11 += wv[1][2 + (r >> 2)][r & 3] * dsa_relu(a1[8 + r]); }
            sc[(2 * hi) * 4096 + key] = s00 + 0.0f; sc[(2 * hi + 1) * 4096 + key] = s01 + 0.0f; sc[(4 + 2 * hi) * 4096 + key] = s10 + 0.0f; sc[(5 + 2 * hi) * 4096 + key] = s11 + 0.0f;
        }
        __syncthreads();
        unsigned long long w;
        LAS float* my = sc + F.wave * 4096;
        switch ((i + 8) >> 3) {
            case 1: w = select_hist<8>(my, i + 1, lane); break;
            case 2: w = select_hist<16>(my, i + 1, lane); break;
            case 3: w = select_hist<24>(my, i + 1, lane); break;
            case 4: w = select_hist<32>(my, i + 1, lane); break;
            case 5: w = select_hist<40>(my, i + 1, lane); break;
            case 6: w = select_hist<48>(my, i + 1, lane); break;
            case 7: w = select_hist<56>(my, i + 1, lane); break;
            default: w = select_hist<64>(my, i + 1, lane); break;
        }
        MASK[(q0 + F.wave) * 64 + lane] = w;
    }
    __syncthreads();
}

__device__ __forceinline__ int t5_bucket(int rel) {
    const int n = rel < 0 ? -rel : rel;
    const int v = n < 8 ? n : 8 + (n >= 12) + (n >= 16) + (n >= 23) + (n >= 32) + (n >= 46) + (n >= 64) + (n >= 91);
    return (rel > 0 ? 16 : 0) + v;
}
namespace att {
using s16x4 = __attribute__((ext_vector_type(4))) short;
typedef short v4i16_t __attribute__((ext_vector_type(4)));
constexpr int SLOTB = 8192, LDS_K = 0  , LDS_V = 4 * SLOTB  , LDS_TBL = 6 * SLOTB  , LDS_WS = LDS_TBL + 8 * 2048, LDS_OST = LDS_WS + 8 * 64 * 4, LDS_Q = LDS_OST + 8 * 4096  , LDS_END = LDS_Q + 16;
__device__ __forceinline__ int crow(int r, int hi) { return (r & 3) + 8 * (r >> 2) + 4 * hi; }
__device__ __forceinline__ void glds16(const void* gsrc, unsigned lds_dst) { unsigned keep;
    asm volatile("s_mov_b32 %0, m0\n\ts_mov_b32 m0, %2\n\ts_nop 0\n\tglobal_load_lds_dwordx4 %1, off\n\ts_mov_b32 m0, %0" : "=&s"(keep) : "v"(gsrc), "s"(lds_dst) : "memory"); }
__device__ __forceinline__ void gload8(unsigned long long& dst, const void* gsrc) { asm volatile("global_load_dwordx2 %0, %1, off" : "=v"(dst) : "v"(gsrc) : "memory"); }
typedef __attribute__((address_space(3))) const char* lds_cptr;
__device__ __forceinline__ s16x4 vtr(lds_cptr p) { return __builtin_bit_cast(s16x4, __builtin_amdgcn_ds_read_tr16_b64_v4i16((__attribute__((address_space(3))) v4i16_t*)p)); }
__device__ __forceinline__ unsigned cvtpk(float lo, float hi) { return pg8::cvt_pk_bf16(lo, hi); }

__device__ __forceinline__ void tile_qk(f32x16& p0, f32x16& p1, const bf16x8 (&qr)[4], lds_cptr kb, float cinit) {
#pragma unroll
    for (int r = 0; r < 16; ++r) { p0[r] = cinit; p1[r] = cinit; }
#pragma unroll
    for (int d0 = 0; d0 < 4; ++d0) {
        const bf16x8 b0 = *(const __attribute__((address_space(3))) bf16x8*)(kb + d0 * 2048);
        const bf16x8 b1 = *(const __attribute__((address_space(3))) bf16x8*)(kb + d0 * 2048 + 512);
        p0 = __builtin_amdgcn_mfma_f32_32x32x16_bf16(b0, qr[d0], p0, 0, 0, 0);
        p1 = __builtin_amdgcn_mfma_f32_32x32x16_bf16(b1, qr[d0], p1, 0, 0, 0);
    }
}
template <bool NEAR>
__device__ __forceinline__ void tile_sm_pv(f32x16& o0, f32x16& o1, float& l, f32x16& p0, f32x16& p1, lds_cptr vp, unsigned long long wcur, int hi, const LAS float* tb) {
    const unsigned wl = (unsigned)wcur >> (4 * hi), wh = (unsigned)(wcur >> 32) >> (4 * hi);
    float ls = 0.f;
#define ATT_SM_ELEM(r) do { constexpr int bp = ((r) & 3) + 8 * ((r) >> 2); float a = p0[r], b = p1[r]; \
        if (NEAR) { a += tb[bp]; b += tb[32 + bp]; } \
        a = __builtin_amdgcn_exp2f(a); b = __builtin_amdgcn_exp2f(b); \
        int m0, m1; asm("v_bfe_i32 %0, %1, %2, 1" : "=v"(m0) : "v"(wl), "n"(bp)); asm("v_bfe_i32 %0, %1, %2, 1" : "=v"(m1) : "v"(wh), "n"(bp)); \
        a = __builtin_bit_cast(float, __builtin_bit_cast(unsigned, a) & (unsigned)m0); b = __builtin_bit_cast(float, __builtin_bit_cast(unsigned, b) & (unsigned)m1); \
        p0[r] = a; p1[r] = b; ls += a + b; } while (0)
    ATT_SM_ELEM(0); ATT_SM_ELEM(1); ATT_SM_ELEM(2); ATT_SM_ELEM(3); ATT_SM_ELEM(4); ATT_SM_ELEM(5); ATT_SM_ELEM(6); ATT_SM_ELEM(7);
    ATT_SM_ELEM(8); ATT_SM_ELEM(9); ATT_SM_ELEM(10); ATT_SM_ELEM(11); ATT_SM_ELEM(12); ATT_SM_ELEM(13); ATT_SM_ELEM(14); ATT_SM_ELEM(15);
#undef ATT_SM_ELEM
    l += ls;
    v4u pw[4];
#pragma unroll
    for (int i = 0; i < 4; ++i) { pw[0][i] = cvtpk(p0[2 * i], p0[2 * i + 1]); pw[1][i] = cvtpk(p0[8 + 2 * i], p0[9 + 2 * i]); pw[2][i] = cvtpk(p1[2 * i], p1[2 * i + 1]); pw[3][i] = cvtpk(p1[8 + 2 * i], p1[9 + 2 * i]); }
#pragma unroll
    for (int ks = 0; ks < 4; ++ks) {
        const s16x4 a0 = vtr(vp + ks * 1024), a1 = vtr(vp + ks * 1024 + 512), c0 = vtr(vp + 4096 + ks * 1024), c1 = vtr(vp + 4096 + ks * 1024 + 512);
        const bf16x8 v0 = (bf16x8){a0[0], a0[1], a0[2], a0[3], a1[0], a1[1], a1[2], a1[3]}, v1 = (bf16x8){c0[0], c0[1], c0[2], c0[3], c1[0], c1[1], c1[2], c1[3]};
        const bf16x8 pa = __builtin_bit_cast(bf16x8, pw[ks]);
        o0 = __builtin_amdgcn_mfma_f32_32x32x16_bf16(pa, v0, o0, 0, 0, 0);
        o1 = __builtin_amdgcn_mfma_f32_32x32x16_bf16(pa, v1, o1, 0, 0, 0);
    }
}

__device__ __forceinline__ void attn_unit(LAS unsigned char* lds, int b, int h, int qb, float cfar, float cnear, const bf16* QB, const bf16* KB, const bf16* VB, const unsigned long long* MASK, bf16* OC) {
    const int tid = threadIdx.x, lane = tid & 63, r32 = lane & 31, hi = lane >> 5; const int wid = __builtin_amdgcn_readfirstlane(tid >> 6);
    const size_t rowbase = (size_t)b * SEQ; const int q0 = qb * 256; const int myq = q0 + wid * 32 + r32;
    const bf16* Qw = QB + (rowbase + myq) * 512 + h * 64;
    const bf16* ksrc = KB + (rowbase + lane) * 512 + h * 64 + wid * 8;
    const bf16* vsrc = VB + (rowbase + 16 * (wid & 3) + (lane >> 2)) * 512 + h * 64 + (wid >> 2) * 32 + (lane & 3) * 8;
    const unsigned long long* msrc = MASK + (rowbase + myq) * 64;
    const unsigned lds0 = (unsigned)(uintptr_t)lds;
    const unsigned kdst = lds0 + LDS_K + wid * 1024, vdst = lds0 + LDS_V + wid * 1024;
    const lds_cptr l3 = (lds_cptr)lds;
    const lds_cptr kb0 = l3 + LDS_K + hi * 1024 + r32 * 16;
    const lds_cptr vp0 = l3 + LDS_V + ((lane >> 4) & 1) * 32 + (lane & 3) * 8 + (4 * hi + ((lane & 15) >> 2)) * 64;
    const LAS float* tbl = (const LAS float*)(lds + LDS_TBL) + h * 512;
    LAS float* wsf = (LAS float*)(lds + LDS_WS) + wid * 64;
    const int NT = 4 * (qb + 1);
    const int nfar_ = (q0 + 32 * wid - 154 >= 0) ? ((q0 + 32 * wid - 154) >> 6) + 1 : 0; const int nfar = nfar_ < NT ? nfar_ : NT;
    bf16x8 qr[4];
#pragma unroll
    for (int d0 = 0; d0 < 4; ++d0) qr[d0] = *(const bf16x8*)(Qw + d0 * 16 + hi * 8);
    f32x16 o0, o1;
#pragma unroll
    for (int r = 0; r < 16; ++r) { o0[r] = 0.f; o1[r] = 0.f; }
    float l = 0.f;
    unsigned long long wA, wB;
    const unsigned kd0 = (unsigned)__builtin_amdgcn_readfirstlane(kdst), vd0 = (unsigned)__builtin_amdgcn_readfirstlane(vdst);
#define ATT_WAITBAR(w) asm volatile("s_waitcnt vmcnt(0) lgkmcnt(0)\n\ts_barrier" : "+v"(w) :: "memory")
#define ATT_DMA_K(tt) glds16(ksrc + (size_t)(tt) * 64 * 512, kd0 + ((tt) & 3) * SLOTB)
#define ATT_DMA_V(tt) glds16(vsrc + (size_t)(tt) * 64 * 512, vd0 + ((tt) & 1) * SLOTB)
#define ATT_CINIT(tt) (((tt) < nfar) ? cfar : cnear)
#define ATT_SMPV(tt, P0, P1, w) do { if ((tt) < nfar) tile_sm_pv<false>(o0, o1, l, P0, P1, vp0 + ((tt) & 1) * SLOTB, w, hi, tbl); \
        else tile_sm_pv<true>(o0, o1, l, P0, P1, vp0 + ((tt) & 1) * SLOTB, w, hi, tbl + ((tt) * 64 + 4 * hi - myq + 447)); } while (0)
    f32x16 sA0, sA1, sB0, sB1;
    ATT_DMA_K(0); ATT_DMA_V(0); gload8(wA, msrc); ATT_DMA_K(1);
    ATT_WAITBAR(wA);
    tile_qk(sA0, sA1, qr, kb0, ATT_CINIT(0));
    for (int t = 0; t < NT; t += 2) {
        if (t > 0) ATT_WAITBAR(wA);
        if (t + 2 < NT) ATT_DMA_K(t + 2);
        ATT_DMA_V(t + 1); gload8(wB, msrc + (t + 1));
        tile_qk(sB0, sB1, qr, kb0 + ((t + 1) & 3) * SLOTB, ATT_CINIT(t + 1));
        ATT_SMPV(t, sA0, sA1, wA);
        ATT_WAITBAR(wB);
        if (t + 3 < NT) ATT_DMA_K(t + 3);
        if (t + 2 < NT) { ATT_DMA_V(t + 2); gload8(wA, msrc + (t + 2)); tile_qk(sA0, sA1, qr, kb0 + ((t + 2) & 3) * SLOTB, ATT_CINIT(t + 2)); }
        ATT_SMPV(t + 1, sB0, sB1, wB);
    }
#undef ATT_WAITBAR
#undef ATT_DMA_K
#undef ATT_DMA_V
#undef ATT_CINIT
#undef ATT_SMPV
    { auto rr = __builtin_amdgcn_permlane32_swap(__float_as_uint(l), __float_as_uint(l), false, false); l = __uint_as_float(rr[0]) + __uint_as_float(rr[1]); }
    if (hi == 0) wsf[32 + r32] = l; asm volatile("s_waitcnt lgkmcnt(0)" ::: "memory");
    float rli[16];
#pragma unroll
    for (int r = 0; r < 16; ++r) rli[r] = __builtin_amdgcn_rcpf(wsf[32 + crow(r, hi)]);
    bf16* Ow = OC + (rowbase + q0 + wid * 32) * 1024 + 512 + h * 64;
    { LAS bf16* stg = (LAS bf16*)(lds + LDS_OST) + wid * 2048;
#pragma unroll
      for (int r = 0; r < 16; ++r) { const int orow = crow(r, hi); stg[orow * 64 + r32] = (bf16)f2bf(o0[r] * rli[r]); stg[orow * 64 + 32 + r32] = (bf16)f2bf(o1[r] * rli[r]); }
      asm volatile("s_waitcnt lgkmcnt(0)" ::: "memory");
#pragma unroll
      for (int i = 0; i < 4; ++i) { const int row = i * 8 + (lane >> 3), ch = lane & 7; const v4u v = *(const LAS v4u*)(stg + row * 64 + ch * 8); *(v4u*)(Ow + (size_t)row * 1024 + ch * 8) = v; } }
    asm volatile("s_waitcnt lgkmcnt(0)\n\ts_barrier" ::: "memory");
}
}

__device__ __forceinline__ void dsa_attn_mfma(Frame& F, const Args& A) {
    LAS float* tbl = (LAS float*)(F.lds + att::LDS_TBL);
    volatile LAS int* qw = (volatile LAS int*)(F.lds + att::LDS_Q);
    const bf16* QB = WSP(bf16, WS_QB); const bf16* KB = WSP(bf16, WS_KB); const bf16* VB = WSP(bf16, WS_VB);
    const unsigned long long* MASK = WSP(unsigned long long, WS_MASK); bf16* OC = WSP(bf16, WS_OCAT);
    const float* relb = A.in[IN_RELB];
    float mq = 0.f, mk = 0.f, mb = 0.f;
    { mq = fabsf(A.in[IN_GQ][F.lane]); mk = fabsf(A.in[IN_GK][F.lane]); mb = fmaxf(fmaxf(fabsf(relb[F.lane]), fabsf(relb[64 + F.lane])), fmaxf(fabsf(relb[128 + F.lane]), fabsf(relb[192 + F.lane])));
      mq = wave_max(mq); mk = wave_max(mk); mb = wave_max(mb); }
    const float ref = 8.0f * LOG2E * mq * mk + LOG2E * mb;
    __syncthreads();
    for (int i = F.tid; i < 8 * 512; i += 512) { const int hh = i >> 9, j = i & 511; tbl[i] = (j < 511) ? relb[t5_bucket(j - 447) * 8 + hh] * LOG2E : 0.f; }
    __syncthreads();
    gu32* qctr = F.ctl + CW_ATTQ;
    for (;;) {
        if (F.tid == 0) qw[0] = (int)__hip_atomic_fetch_add(qctr, 1u, RLX_AGENT);
        __syncthreads();
        const int u = qw[0];
        __syncthreads();
        if (u >= 2048) break;
        const int qb = 15 - (u >> 7), bh = u & 127, b = bh >> 3, h = bh & 7;
        const float cnear = -ref, cfar = -ref + relb[15 * 8 + h] * LOG2E;
        att::attn_unit(F.lds, b, h, qb, cfar, cnear, QB, KB, VB, MASK, OC);
    }
    __syncthreads();
}
__device__ __forceinline__ void moe_route_mfma(Frame& F, const Args& A) {
    const bf16* XB = WSP(bf16, WS_H2); const bf16* WRH = WSP(bf16, WS_WR); const bf16* WRL = WRH + 64 * D;
    unsigned* ME = WSP(unsigned, WS_META); float* MC = (float*)(F.ws + WS_META + 512 * 1024); float* MRS = WSP(float, WS_MRS);
    const int lane = F.lane, n32 = lane & 31, hi = lane >> 5;
    LAS float* lg = (LAS float*)F.lds + F.wave * 2048;
    LAS int* lcnt = (LAS int*)(F.lds + XTRA_OFF); LAS int* lbase = lcnt + 128; int* POSC = (int*)(F.ws + WS_META + 256 * 1024);
    if (F.tid < 128) lcnt[F.tid] = 0;
    LAS unsigned char* wl = F.lds + RING_OFF; constexpr int WPITCH = 2048;
    for (int tile = F.vcu * NWAVES + F.wave; tile < M / 32; tile += F.G * NWAVES) {
        __syncthreads();
#pragma unroll 4
        for (int i = 0; i < 16; ++i) { const int p = F.tid + 512 * i, row = p >> 7, c16 = p & 127;
            const v4u v = *(const GAS v4u*)((row < 32 ? WRH + (size_t)row * D : WRL + (size_t)(row - 32) * D) + 8 * c16);
            *(LAS v4u*)(wl + row * WPITCH + 16 * (c16 ^ (row & 7))) = v; }
        __syncthreads();
        const size_t t0 = (size_t)tile * 32;
        const bf16* xp = XB + (t0 + n32) * D + 8 * hi;
        const bf16* bh = WRH + (size_t)n32 * D + 8 * hi; const bf16* bl = WRL + (size_t)n32 * D + 8 * hi;
        f32x16 acc0, acc1;
#pragma unroll
        for (int r = 0; r < 16; ++r) { acc0[r] = 0.f; acc1[r] = 0.f; }
        float ss = 0.f;
        float ra; { const unsigned* sl = WSP(const unsigned, WS_SLOT2) + ((t0 + n32) >> 8) * 1024 + ((t0 + n32) & 255);
            ra = fmaxf(fmaxf(__builtin_bit_cast(float, sl[0]), __builtin_bit_cast(float, sl[256])), fmaxf(__builtin_bit_cast(float, sl[512]), __builtin_bit_cast(float, sl[768]))); }
        const float qinv = ra > 0.f ? 127.0f / ra : 0.f;
        if (hi == 0) WSP(float, WS_XS8)[t0 + n32] = ra * (1.0f / 127.0f);
        unsigned char* x8 = F.ws + WS_XB8 + (t0 + n32) * D + 16 * hi; v4u q8;
        v4u xs[4]; bf16x8 wq[4][4];
#define RT_LOAD(sl, s) do { xs[sl] = *(const v4u*)(xp + 16 * (s)); \
                            wq[sl][1] = (bf16x8){0, 0, 0, 0, 0, 0, 0, 0}; wq[sl][3] = (bf16x8){0, 0, 0, 0, 0, 0, 0, 0}; \
                            if (n32 < 4) { wq[sl][1] = *(const bf16x8*)(bh + 32 * D + 16 * (s)); wq[sl][3] = *(const bf16x8*)(bl + 32 * D + 16 * (s)); } } while (0)
        RT_LOAD(0, 0); RT_LOAD(1, 1); RT_LOAD(2, 2);
        for (int s4 = 0; s4 < 64; s4 += 4) {
#pragma unroll
            for (int u4 = 0; u4 < 4; ++u4) { const int s = s4 + u4;
                if (s + 3 < 64) RT_LOAD((u4 + 3) & 3, s + 3);
                asm volatile("" ::: "memory");
                const v4u xw = xs[u4];
                {
                    unsigned b0 = 0u, b1 = 0u;
                    b0 = __builtin_amdgcn_cvt_pk_u8_f32(__builtin_rintf(__builtin_fmaf(bflo(xw[0]), qinv, 128.0f)), 0, b0); b0 = __builtin_amdgcn_cvt_pk_u8_f32(__builtin_rintf(__builtin_fmaf(bfhi(xw[0]), qinv, 128.0f)), 1, b0);
                    b0 = __builtin_amdgcn_cvt_pk_u8_f32(__builtin_rintf(__builtin_fmaf(bflo(xw[1]), qinv, 128.0f)), 2, b0); b0 = __builtin_amdgcn_cvt_pk_u8_f32(__builtin_rintf(__builtin_fmaf(bfhi(xw[1]), qinv, 128.0f)), 3, b0);
                    b1 = __builtin_amdgcn_cvt_pk_u8_f32(__builtin_rintf(__builtin_fmaf(bflo(xw[2]), qinv, 128.0f)), 0, b1); b1 = __builtin_amdgcn_cvt_pk_u8_f32(__builtin_rintf(__builtin_fmaf(bfhi(xw[2]), qinv, 128.0f)), 1, b1);
                    b1 = __builtin_amdgcn_cvt_pk_u8_f32(__builtin_rintf(__builtin_fmaf(bflo(xw[3]), qinv, 128.0f)), 2, b1); b1 = __builtin_amdgcn_cvt_pk_u8_f32(__builtin_rintf(__builtin_fmaf(bfhi(xw[3]), qinv, 128.0f)), 3, b1);
                    if ((u4 & 1) == 0) { q8.x = b0 ^ 0x80808080u; q8.y = b1 ^ 0x80808080u; } else { q8.z = b0 ^ 0x80808080u; q8.w = b1 ^ 0x80808080u; *(v4u*)(x8 + 32 * (s >> 1)) = q8; } }
#pragma unroll
                for (int j = 0; j < 4; ++j) { const float a = bflo(xw[j]), b = bfhi(xw[j]); ss += a * a + b * b; }
                const bf16x8 Ah = __builtin_bit_cast(bf16x8, xw);
                const bf16x8 w0h = *(const LAS bf16x8*)(wl + n32 * WPITCH + 16 * ((2 * s + hi) ^ (n32 & 7))), w0l = *(const LAS bf16x8*)(wl + (32 + n32) * WPITCH + 16 * ((2 * s + hi) ^ (n32 & 7)));
                acc0 = __builtin_amdgcn_mfma_f32_32x32x16_bf16(Ah, w0h, acc0, 0, 0, 0); acc1 = __builtin_amdgcn_mfma_f32_32x32x16_bf16(Ah, wq[u4][1], acc1, 0, 0, 0);
                acc0 = __builtin_amdgcn_mfma_f32_32x32x16_bf16(Ah, w0l, acc0, 0, 0, 0); acc1 = __builtin_amdgcn_mfma_f32_32x32x16_bf16(Ah, wq[u4][3], acc1, 0, 0, 0);
            }
        }
#undef RT_LOAD
        ss += __shfl_xor(ss, 32);
        const float rs = 1.0f / sqrtf(ss * (1.f / D) + EPS);
        __syncthreads();
#pragma unroll
        for (int r = 0; r < 16; ++r) { const int tk = (r & 3) + 8 * (r >> 2) + 4 * hi; lg[tk * 64 + n32] = acc0[r]; lg[tk * 64 + 32 + n32] = acc1[r]; }
        LDS_WAIT(); asm volatile("" ::: "memory");
        if (hi == 0) {
            const size_t r = t0 + n32; const LAS float* my = lg + n32 * 64;
            float gl[4];
#pragma unroll
            for (int c = 0; c < 4; ++c) gl[c] = my[c] * rs + A.in[IN_BRG][c];
            int gs = 0; float gm = gl[0];
#pragma unroll
            for (int c = 1; c < 4; ++c) if (gl[c] > gm) { gm = gl[c]; gs = c; }
            float den = 0.f;
#pragma unroll
            for (int c = 0; c < 4; ++c) den += __expf(gl[c] - gm);
            const float gw = 1.0f / den;
            float el[8];
#pragma unroll
            for (int c = 0; c < 8; ++c) el[c] = my[4 + gs * 8 + c] * rs + A.in[IN_BRE][gs * 8 + c];
            int i0 = 0; float v0 = el[0];
#pragma unroll
            for (int c = 1; c < 8; ++c) if (el[c] > v0) { v0 = el[c]; i0 = c; }
            int i1 = -1; float v1 = -INFINITY;
#pragma unroll
            for (int c = 0; c < 8; ++c) if (c != i0 && el[c] > v1) { v1 = el[c]; i1 = c; }
            const float p1 = 1.0f / (1.0f + __expf(v0 - v1)), p0 = 1.0f - p1;
            const float c0 = p0 * gw, c1 = p1 * gw;
            const int a = i0 < i1 ? i0 : i1, bq = i0 < i1 ? i1 : i0; const float ca = i0 < i1 ? c0 : c1, cb = i0 < i1 ? c1 : c0;
            const int cls = gs * 28 + (a * (15 - a)) / 2 + (bq - a - 1);
            ME[r] = (unsigned)(gs * 8 + a) | ((unsigned)(gs * 8 + bq) << 8) | ((unsigned)cls << 16); MC[r * 2] = ca; MC[r * 2 + 1] = cb; MRS[r] = rs;
            POSC[r] = __hip_atomic_fetch_add(lcnt + cls, 1, __ATOMIC_RELAXED, __HIP_MEMORY_SCOPE_WORKGROUP);
        }
        LDS_WAIT(); asm volatile("" ::: "memory");
    }
    __syncthreads();
    if (F.tid < NCLASS) { const int n = lcnt[F.tid]; lbase[F.tid] = n ? (int)__hip_atomic_fetch_add(F.ctl + CW_CLS + F.tid, (unsigned)n, RLX_AGENT) : 0; }
    __syncthreads();
    for (int tile = F.vcu * NWAVES + F.wave; tile < M / 32; tile += F.G * NWAVES) {
        if (hi == 0) { const size_t r = (size_t)tile * 32 + n32; POSC[r] += lbase[ME[r] >> 16]; } }
    __syncthreads();
}
constexpr size_t WS_TILEE = WS_TOK + 512 * 1024, WS_NT = WS_TOK + 768 * 1024;
__device__ __forceinline__ void moe_assign(Frame& F, const Args& A) {
    LAS int* off_s = (LAS int*)F.lds; LAS int* cnt_s = off_s + 128;
    gu32* cnt = F.ctl + CW_CLS;
    int* TOK = WSP(int, WS_TOK); unsigned* TILEE = WSP(unsigned, WS_TILEE); int* NT = WSP(int, WS_NT); const unsigned* ME = WSP(unsigned, WS_META);
    __syncthreads();
    if (F.tid < NCLASS) cnt_s[F.tid] = (int)__hip_atomic_load(cnt + F.tid, RLX_AGENT);
    __syncthreads();
    if (F.tid == 0) { int o = 0; for (int c = 0; c < NCLASS; ++c) { off_s[c] = o; o += (cnt_s[c] + 255) & ~255; } off_s[NCLASS] = o; }
    __syncthreads();
    for (int r = F.vcu * 512 + F.tid; r < M; r += F.G * 512) { const int cls = (int)(ME[r] >> 16); const int pos = off_s[cls] + WSP(const int, WS_META + 256 * 1024)[r]; TOK[pos] = r; }
    for (int c = F.vcu; c < NCLASS; c += F.G) {
        const int lo = off_s[c] + cnt_s[c], hi = off_s[c + 1];
        for (int p = lo + F.tid; p < hi; p += 512) TOK[p] = -1;
        const int g = c / 28; int pi = c % 28, a = 0; while (pi >= 7 - a) { pi -= 7 - a; ++a; } const int b = a + 1 + pi;
        const unsigned ee = (unsigned)(g * 8 + a) | ((unsigned)(g * 8 + b) << 8);
        for (int t = off_s[c] / 256 + F.tid; t < off_s[c + 1] / 256; t += 512) TILEE[t] = ee;
    }
    if (F.vcu == 0 && F.tid == 0) NT[0] = off_s[NCLASS] / 256;
    __syncthreads();
}
namespace pg8 {
struct MoeUpOrder {
    static constexpr bool GATHER = true, SPLITB = false;
    int nT, G, c; const int* TOK; const unsigned* TILEE; const bf16_t* WGU;
    __device__ bool next(int i, Unit& u) const { const long L = (long)i * G + c; if (L >= 2L * nT) return false; tile_of((int)L, nT, 2, u.pm, u.pn); u.sel = (int)TILEE[u.pm]; return true; }
    __device__ __forceinline__ const char* baseA(const Gemm& g, const Unit&) const { return (const char*)g.A; }
    __device__ __forceinline__ const char* baseB(const Gemm& g, const Unit& u) const { const int e = (u.pn ? (u.sel >> 8) : u.sel) & 255; return (const char*)WGU + (size_t)e * 256 * g.ldb * 2; }
    __device__ __forceinline__ int row(const Unit& u, int r) const { const int t = TOK[u.pm * BM + r]; return t < 0 ? 0 : t; }
};
struct EpiMoeUp {
    static constexpr bool PERM = true, CARRY = false;
    const int* TOK; const float* MC; const float* MRS; bf16_t* HID; const float* XS; const float* CSU;
    __device__ __forceinline__ int operator()(const f32x4 (&acc)[2][2][4][2], const Unit& u, int wr, int wc, int fr, int fq) const {
        { int l; asm volatile("v_mbcnt_lo_u32_b32 %0, -1, 0\n\tv_mbcnt_hi_u32_b32 %0, -1, %0" : "=v"(l)); fr = l & 15; fq = l >> 4; }
        const int pos0 = u.pm * BM + wr * 64 + fr; const int e = (u.pn ? (u.sel >> 8) : u.sel) & 255;
        f32x4 csc[2][2];
#pragma unroll
        for (int bj = 0; bj < 2; ++bj)
#pragma unroll
            for (int n = 0; n < 2; ++n) csc[bj][n] = *(const f32x4*)(CSU + e * 256 + bj * HALF + wc * 32 + 8 * fq + 4 * n);
#pragma unroll
        for (int ai = 0; ai < 2; ++ai)
#pragma unroll
            for (int m = 0; m < 4; ++m) { const int pos = pos0 + ai * HALF + m * 16; const int tok = TOK[pos]; const float cw = tok >= 0 ? MC[(size_t)tok * 2 + u.pn] : 0.f; const float rs = tok >= 0 ? MRS[tok] * XS[tok] : 0.f;
                const f32x4 g0 = __builtin_convertvector(__builtin_bit_cast(i32x4, acc[ai][0][m][0]), f32x4) * csc[0][0], g1 = __builtin_convertvector(__builtin_bit_cast(i32x4, acc[ai][0][m][1]), f32x4) * csc[0][1];
                const f32x4 u0 = __builtin_convertvector(__builtin_bit_cast(i32x4, acc[ai][1][m][0]), f32x4) * csc[1][0], u1 = __builtin_convertvector(__builtin_bit_cast(i32x4, acc[ai][1][m][1]), f32x4) * csc[1][1]; float h[8];
#pragma unroll
                for (int j = 0; j < 4; ++j) { h[j] = cw * siluf_(rs * g0[j]) * (rs * u0[j]); h[4 + j] = cw * siluf_(rs * g1[j]) * (rs * u1[j]); }
                u32x4 w; w.x = cvt_pk_bf16(h[0], h[1]); w.y = cvt_pk_bf16(h[2], h[3]); w.z = cvt_pk_bf16(h[4], h[5]); w.w = cvt_pk_bf16(h[6], h[7]);
                *(u32x4*)(HID + (size_t)pos * 256 + u.pn * 128 + wc * 32 + 8 * fq) = w; }
        return 8;
    }
};
struct MoeDownOrder {
    static constexpr bool GATHER = false, SPLITB = true;
    int nT, G, c; const unsigned* TILEE; const bf16_t* WD;
    __device__ bool next(int i, Unit& u) const { const long L = (long)i * G + c; if (L >= 4L * nT) return false; tile_of((int)L, nT, 4, u.pm, u.pn); u.sel = (int)TILEE[u.pm]; return true; }
    __device__ __forceinline__ const char* baseA(const Gemm& g, const Unit& u) const { return (const char*)g.A + (size_t)u.pm * BM * g.lda * 2; }
    __device__ __forceinline__ const char* baseB(const Gemm&, const Unit& u) const { return (const char*)WD + ((size_t)(u.sel & 255) * 1024 + (size_t)u.pn * BM) * 128 * 2; }
    __device__ __forceinline__ const char* baseB2(const Gemm&, const Unit& u) const { return (const char*)WD + ((size_t)((u.sel >> 8) & 255) * 1024 + (size_t)u.pn * BM) * 128 * 2; }
};
struct EpiMoeDown {
    static constexpr bool PERM = true, CARRY = false;
    const int* TOK; const bf16_t* XB; float* O; float* DUMP;
    __device__ __forceinline__ int operator()(const f32x4 (&acc)[2][2][4][2], const Unit& u, int wr, int wc, int fr, int fq) const {
        { int l; asm volatile("v_mbcnt_lo_u32_b32 %0, -1, 0\n\tv_mbcnt_hi_u32_b32 %0, -1, %0" : "=v"(l)); fr = l & 15; fq = l >> 4; }
        const int* tp = TOK + u.pm * BM + wr * 64 + fr; const int col0 = u.pn * BM + wc * 32 + 8 * fq;
        int tk[8];
#pragma unroll
        for (int it = 0; it < 8; ++it) tk[it] = tp[(it >> 2) * HALF + (it & 3) * 16];
        u32x4 xw[2][2];
#pragma unroll
        for (int bj = 0; bj < 2; ++bj) xw[0][bj] = *(const u32x4*)(XB + (size_t)(tk[0] >= 0 ? tk[0] : 0) * 1024 + col0 + bj * HALF);
#pragma unroll
        for (int it = 0; it < 8; ++it) { const int ai = it >> 2, m = it & 3, sl = it & 1; const int tok = tk[it];
            if (it + 1 < 8) {
#pragma unroll
                for (int bj = 0; bj < 2; ++bj) xw[sl ^ 1][bj] = *(const u32x4*)(XB + (size_t)(tk[it + 1] >= 0 ? tk[it + 1] : 0) * 1024 + col0 + bj * HALF); }
            asm volatile("" ::: "memory");
            float* rowp = (tok >= 0 ? O + (size_t)tok * 1024 : DUMP) + col0;
#pragma unroll
            for (int bj = 0; bj < 2; ++bj) { const u32x4 x = xw[sl][bj]; f32x4 y0 = acc[ai][bj][m][0], y1 = acc[ai][bj][m][1];
                y0[0] += bflo(x.x); y0[1] += bfhi(x.x); y0[2] += bflo(x.y); y0[3] += bfhi(x.y);
                y1[0] += bflo(x.z); y1[1] += bfhi(x.z); y1[2] += bflo(x.w); y1[3] += bfhi(x.w);
                __builtin_nontemporal_store(y0, (f32x4*)(rowp + bj * HALF)); __builtin_nontemporal_store(y1, (f32x4*)(rowp + bj * HALF + 4)); }
            asm volatile("" ::: "memory"); }
        return 32;
    }
};
}
#ifndef MK_SPLIT
#define MK_SPLIT 0
#endif
constexpr int NPHASE = 12;
__global__ void __launch_bounds__(NWAVES * 64, 2) fwd(Args args) {
    extern __shared__ __attribute__((aligned(16))) unsigned char lds[];
    Frame F;
    F.lds = (LAS unsigned char*)lds;
    F.MISC = (volatile LAS unsigned*)(F.lds + MISC_OFF);
    F.tid = threadIdx.x; F.lane = F.tid & 63; F.wave = __builtin_amdgcn_readfirstlane(F.tid >> 6);
    F.G = gridDim.x; { const int bx = blockIdx.x; F.vcu = (F.G % 8 == 0) ? (bx % 8) * (F.G / 8) + bx / 8 : bx; }
    F.ws = args.ws; F.out = args.out; F.ctl = (gu32*)(args.ws + WS_CTL);
    for (int u = F.tid; u < 256; u += NWAVES * 64) ((LAS unsigned*)(F.lds + LDSCTL_OFF))[u] = 0u;
    __syncthreads();
    const int lo = args.ph_lo, hi = args.ph_hi;
    XcdBarrier bar; bar.bar = (unsigned*)(F.ctl + CW_BAR); bar.x = 0; bar.st = nullptr;
    if (hi - lo > 1) { bar = xcd_barrier_post((unsigned*)(F.ctl + CW_BAR), F.MISC + 8);
        if (F.tid == 0) { const unsigned x = xb_xcc_id(); F.MISC[16] = x; F.MISC[17] = __hip_atomic_fetch_add(F.ctl + CW_XRANK + 64 * x, 1u, RLX_AGENT); } }
    int vid = (int)blockIdx.x;
#ifndef ONLY
#define ONLY -1
#endif
#define IN(k) ((ONLY < 0 || ONLY == (k)) && lo <= (k) && (k) < hi)
#define BOTH(k) (IN(k) && IN((k) + 1))
#ifndef PROBE_FLAG
#define PROBE_FLAG 1
#endif
#ifndef REP_PHASE
#define REP_PHASE -1
#endif
#define NREP(k) 1
#define GRID_BAR() xcd_barrier(bar)

    if (IN(0)) _Pragma("unroll") for (int rep_ = 0; rep_ < NREP(0); ++rep_) { p0_prologue(F, args); if (BOTH(0)) GRID_BAR(); }
    if (IN(1)) { p0_quant(F, args); if (BOTH(1)) GRID_BAR(); }
    if (hi - lo > 1 && lo == 0) {
        bool ok = (F.G % 8) == 0;
#pragma unroll
        for (int j = 0; j < 8; ++j) ok = ok && (__hip_atomic_load(F.ctl + CW_XRANK + 64 * j, RLX_AGENT) == (unsigned)(F.G / 8));
        __syncthreads();
        if (ok) vid = (int)__builtin_amdgcn_readfirstlane((int)(F.MISC[17] * 8u + F.MISC[16]));
    }
    if (IN(2)) _Pragma("unroll") for (int rep_ = 0; rep_ < NREP(2); ++rep_) {
        if (G1_NBF > 0) { pg8::Gemm g{WSP(bf16, WS_HN), WSP(bf16, WS_WIN), D, D, D}; pg8::G1Order S{F.G, vid, 0, 0, G1_NBF};
          pg8::EpiG1<false> E{F.ws, args.in[IN_GQ], args.in[IN_GK], nullptr, nullptr};
          pg8::gemm_phase<pg8::EpiG1<false>, pg8::G1Order>(F.lds + RING_OFF, g, S, E); }
        { pg8::Gemm g{WSP(bf16, WS_HN8), WSP(bf16, WS_WIN8), D / 2, D / 2, D / 2}; pg8::G1Order S{F.G, vid, 0, 1, 22 - G1_NBF};
          pg8::EpiG1<true> E{F.ws, args.in[IN_GQ], args.in[IN_GK], WSP(const float, WS_RS8), WSP(const float, WS_CS8)};
          pg8::gemm_phase<pg8::EpiG1<true>, pg8::G1Order, true>(F.lds + RING_OFF, g, S, E); }
        if (BOTH(2)) GRID_BAR();
    }
    if (IN(3)) _Pragma("unroll") for (int rep_ = 0; rep_ < NREP(3); ++rep_) { gla_prep(F, args); }
    if (IN(4)) _Pragma("unroll") for (int rep_ = 0; rep_ < NREP(4); ++rep_) { dsa_select_mfma(F, args); if (BOTH(4)) GRID_BAR(); }
    if (IN(5)) _Pragma("unroll") for (int rep_ = 0; rep_ < NREP(5); ++rep_) { gla_scan_mfma(F, args); dsa_attn_mfma(F, args); if (BOTH(5)) GRID_BAR(); }
    if (IN(6)) _Pragma("unroll") for (int rep_ = 0; rep_ < NREP(6); ++rep_) {
        pg8::Gemm g{WSP(bf16, WS_OCAT), nullptr, 1024, 512, 512};
        pg8::PairOrder S; S.nM = M / 256; S.nN = D / 256; S.nwg = S.nM * S.nN; S.G = F.G; S.c = vid; S.Wa = WSP(bf16, WS_WA); S.Wb = WSP(bf16, WS_WB);
        pg8::EpiMix E{WSP(bf16, WS_GA), WSP(bf16, WS_GB), F.ws + WS_MIX8, pg8::PanelX{(LAS float*)(F.lds + XTRA_OFF), WSP(unsigned, WS_SLOT1), F.ctl + CW_PCNT, WSP(float, WS_MS8)}};
        pg8::gemm_phase<pg8::EpiMix, pg8::PairOrder>(F.lds + RING_OFF, g, S, E);
        if (BOTH(6)) GRID_BAR();
    }
    if (IN(7)) _Pragma("unroll") for (int rep_ = 0; rep_ < NREP(7); ++rep_) {
        pg8::Gemm g{WSP(bf16, WS_MIX8), WSP(bf16, WS_WO8), D / 2, D / 2, D / 2}; pg8::StaticOrder S; S.init(M, D, F.G, vid);
        pg8::EpiRes E{args.in[IN_X], WSP(bf16, WS_H2), WSP(const float, WS_MS8), WSP(const float, WS_CSO), (LAS float*)(F.lds + XTRA_OFF), WSP(unsigned, WS_SLOT2)};
        pg8::gemm_phase<pg8::EpiRes, pg8::StaticOrder, true>(F.lds + RING_OFF, g, S, E);
        if (BOTH(7)) GRID_BAR();
    }
    if (IN(8)) _Pragma("unroll") for (int rep_ = 0; rep_ < NREP(8); ++rep_) { moe_route_mfma(F, args); if (BOTH(8)) GRID_BAR(); }
    if (IN(9)) _Pragma("unroll") for (int rep_ = 0; rep_ < NREP(9); ++rep_) { moe_assign(F, args); if (BOTH(9)) GRID_BAR(); }
    if (IN(10)) _Pragma("unroll") for (int rep_ = 0; rep_ < NREP(10); ++rep_) {
        const int nT = __builtin_amdgcn_readfirstlane(*WSP(const int, WS_NT));
        pg8::Gemm g{WSP(bf16, WS_XB8), nullptr, D / 2, D / 2, D / 2};
        pg8::MoeUpOrder S{nT, F.G, vid, WSP(const int, WS_TOK), WSP(const unsigned, WS_TILEE), WSP(bf16, WS_WGU8)};
        pg8::EpiMoeUp E{WSP(const int, WS_TOK), (const float*)(F.ws + WS_META + 512 * 1024), WSP(const float, WS_MRS), WSP(bf16, WS_HID), WSP(const float, WS_XS8), WSP(const float, WS_CSU)};
        pg8::gemm_phase<pg8::EpiMoeUp, pg8::MoeUpOrder, true>(F.lds + RING_OFF, g, S, E);
        if (BOTH(10)) GRID_BAR();
    }
    if (IN(11)) _Pragma("unroll") for (int rep_ = 0; rep_ < NREP(11); ++rep_) {
        const int nT = __builtin_amdgcn_readfirstlane(*WSP(const int, WS_NT));
        pg8::Gemm g{WSP(bf16, WS_HID), nullptr, 256, 128, 256};
        pg8::MoeDownOrder S{nT, F.G, vid, WSP(const unsigned, WS_TILEE), WSP(bf16, WS_WD)};
        pg8::EpiMoeDown E{WSP(const int, WS_TOK), WSP(bf16, WS_H2), F.out, WSP(float, WS_NT + 4096)};
        pg8::gemm_phase<pg8::EpiMoeDown, pg8::MoeDownOrder>(F.lds + RING_OFF, g, S, E);
    }
#undef IN
#undef BOTH
#undef GRID_BAR
}

extern "C" void kernel_launch(void* const* d_in, const int* in_sizes, int n_in, void* d_out, int out_size, void* d_ws, size_t ws_size, hipStream_t stream) {
    static int grid = 0;
    if (grid == 0) {
        if (n_in != 20 || in_sizes[0] != M * D || out_size != M * D || ws_size < WS_END) { fprintf(stderr, "kernel_launch: unexpected shapes (n_in %d, in0 %d, out %d, ws %zu); nothing launched\n", n_in, n_in > 0 ? in_sizes[0] : -1, out_size, ws_size); grid = -1; return; }
        int dev = 0, cus = 0, per_cu = 0;
        if (hipGetDevice(&dev) != hipSuccess || hipDeviceGetAttribute(&cus, hipDeviceAttributeMultiprocessorCount, dev) != hipSuccess) { grid = -1; return; }
        if (hipFuncSetAttribute((const void*)fwd, hipFuncAttributeMaxDynamicSharedMemorySize, LDS_BYTES) != hipSuccess) { fprintf(stderr, "kernel_launch: hipFuncSetAttribute failed\n"); grid = -1; return; }
        if (hipOccupancyMaxActiveBlocksPerMultiprocessor(&per_cu, (const void*)fwd, NWAVES * 64, LDS_BYTES) != hipSuccess || per_cu < 1) fprintf(stderr, "kernel_launch: occupancy query says %d\n", per_cu);
        (void)hipGetLastError();
        grid = cus;
        if (grid > 256) grid = 256;
        if (grid != 256 || per_cu < 1) { fprintf(stderr, "kernel_launch: needs 256 resident workgroups (the merge epilogue's panel exchange); nothing launched\n"); grid = -1; return; }
    }
    if (grid < 0) return;
    if (hipMemsetAsync((char*)d_ws + WS_CTL, 0, CTL_ZERO_BYTES, stream) != hipSuccess) return;
    Args a{};
    for (int i = 0; i < 20; ++i) a.in[i] = (const float*)d_in[i];
    a.out = (float*)d_out; a.ws = (unsigned char*)d_ws;
#if MK_SPLIT
    for (int p = 0; p < NPHASE; ++p) for (int rep = 0; rep < ((p == REP_PHASE) ? 2 : 1); ++rep) { a.ph_lo = p; a.ph_hi = p + 1; a.flag = rep ? PROBE_FLAG : 0; hipLaunchKernelGGL(fwd, dim3(grid), dim3(NWAVES * 64), LDS_BYTES, stream, a); }
#else
    a.ph_lo = 0; a.ph_hi = NPHASE; hipLaunchKernelGGL(fwd, dim3(grid), dim3(NWAVES * 64), LDS_BYTES, stream, a);
#endif
}
```
